# Optimizing an MI355X kernel written in HIP

```python
import math
import jax, jax.numpy as jnp
from jax import lax
import numpy as np

D_MODEL = 1024
BATCH = 32
SEQ = 2048
DEPTH = 4

N_A_LAYERS = DEPTH // 2
N_B_LAYERS = DEPTH - N_A_LAYERS
D_FF = 4 * D_MODEL

A_HEADS = 4
A_QK_DIM = D_MODEL // (2 * A_HEADS)
A_V_DIM = D_MODEL // A_HEADS
A_CHUNK = 64
A_Q_COLS = A_HEADS * A_QK_DIM
A_V_COLS = A_HEADS * A_V_DIM
A_IN_COLS = 2 * A_Q_COLS + 2 * A_V_COLS + 2 * A_HEADS

B_HEADS = 8
B_HEAD_DIM = D_MODEL // (2 * B_HEADS)
B_V_DIM = 2 * B_HEAD_DIM
B_Q_COLS = B_HEADS * 2 * B_HEAD_DIM
B_K_COLS = B_HEADS * 2 * B_HEAD_DIM
B_KV_COLS = B_K_COLS + B_HEADS * B_V_DIM
Q_BLOCK = 128
ROPE_THETA = 500000.0
ROPE_DIM = B_HEAD_DIM // 4

NORM_EPS = 1e-6
SUBLN_EPS = 1e-5

kernel_name = "yoco_mlstm_diffattn_hybrid"


def lambda_init(layer_number):
    return 0.8 - 0.6 * math.exp(-0.3 * (layer_number - 1))


def rms_norm(x, g, eps=NORM_EPS):
    xf = x.astype(jnp.float32)
    y = xf * lax.rsqrt(jnp.mean(jnp.square(xf), axis=-1, keepdims=True) + eps)
    return (y * g.astype(jnp.float32)).astype(x.dtype)


def modulate(y, shift, scale):
    return y * (1 + scale) + shift


def sq_relu_mlp(y, w_up, w_down):
    return jnp.square(jax.nn.relu(y @ w_up)) @ w_down


def rope_tables(positions):
    inv_freq = jnp.power(ROPE_THETA, -jnp.arange(0, ROPE_DIM, 2, dtype=jnp.float32) / ROPE_DIM)
    ang = positions.astype(jnp.float32)[..., None] * inv_freq
    return jnp.cos(ang), jnp.sin(ang)


def apply_partial_rope(t, cos, sin):
    shape = cos.shape[:2] + (1,) * (t.ndim - 3) + (cos.shape[-1],)
    cos = cos.reshape(shape).astype(t.dtype)
    sin = sin.reshape(shape).astype(t.dtype)
    half = ROPE_DIM // 2
    r1 = t[..., :half]
    r2 = t[..., half:ROPE_DIM]
    return jnp.concatenate([r1 * cos - r2 * sin, r2 * cos + r1 * sin, t[..., ROPE_DIM:]], axis=-1)


def mlstm_chunkwise(q, k, v, i_pre, log_f):
    B, S, H, DK = q.shape
    DV = v.shape[-1]
    L = A_CHUNK
    NC = S // L
    f32 = jnp.float32

    def chunk_vec(t):
        return t.astype(f32).reshape(B, NC, L, H, t.shape[-1]).transpose(1, 0, 3, 2, 4)

    def chunk_gate(t):
        return t.astype(f32).reshape(B, NC, L, H).transpose(1, 0, 3, 2)

    qc, kc, vc = chunk_vec(q), chunk_vec(k), chunk_vec(v)
    ic = chunk_gate(i_pre)
    gc = jnp.cumsum(chunk_gate(log_f), axis=-1)
    causal = jnp.tril(jnp.ones((L, L), dtype=bool))

    def step(carry, xs):
        C, n, m = carry
        qb, kb, vb, ib, gb = xs
        G = gb[..., -1]
        Dm = jnp.where(causal, gb[..., :, None] - gb[..., None, :] + ib[..., None, :], -jnp.inf)
        inter = gb + m[..., None]
        m_row = jnp.maximum(inter, jnp.max(Dm, axis=-1))
        w_intra = jnp.exp(Dm - m_row[..., None])
        w_inter = jnp.exp(inter - m_row)
        s = jnp.einsum('bhld,bhsd->bhls', qb, kb) * w_intra
        num = jnp.einsum('bhls,bhsv->bhlv', s, vb) + w_inter[..., None] * jnp.einsum('bhld,bhdv->bhlv', qb, C)
        den = jnp.sum(s, axis=-1) + w_inter * jnp.einsum('bhld,bhd->bhl', qb, n)
        h = num / jnp.maximum(jnp.abs(den), jnp.exp(-m_row))[..., None]
        a = G[..., None] - gb + ib
        m_new = jnp.maximum(G + m, jnp.max(a, axis=-1))
        w_old = jnp.exp(G + m - m_new)
        w_s = jnp.exp(a - m_new[..., None])
        C_new = w_old[..., None, None] * C + jnp.einsum('bhs,bhsd,bhsv->bhdv', w_s, kb, vb)
        n_new = w_old[..., None] * n + jnp.einsum('bhs,bhsd->bhd', w_s, kb)
        return (C_new, n_new, m_new), h

    init = (jnp.zeros((B, H, DK, DV), f32), jnp.zeros((B, H, DK), f32), jnp.zeros((B, H), f32))
    _, hs = lax.scan(step, init, (qc, kc, vc, ic, gc))
    return hs.transpose(1, 0, 3, 2, 4).reshape(B, S, H, DV).astype(q.dtype)


def mlstm_mixer(y, w_in, b_gates, head_g, w_out):
    B, S, _ = y.shape
    proj = y @ w_in
    o1 = A_Q_COLS
    o2 = o1 + A_Q_COLS
    o3 = o2 + A_V_COLS
    o4 = o3 + A_V_COLS
    o5 = o4 + A_HEADS
    q = proj[..., :o1].reshape(B, S, A_HEADS, A_QK_DIM)
    k = proj[..., o1:o2].reshape(B, S, A_HEADS, A_QK_DIM) * (A_QK_DIM ** -0.5)
    v = proj[..., o2:o3].reshape(B, S, A_HEADS, A_V_DIM)
    o_pre = proj[..., o3:o4]
    i_pre = (proj[..., o4:o5] + b_gates[0]).astype(jnp.float32)
    log_f = jax.nn.log_sigmoid((proj[..., o5:] + b_gates[1]).astype(jnp.float32))
    h = mlstm_chunkwise(q, k, v, i_pre, log_f)
    h = rms_norm(h, head_g.reshape(A_HEADS, A_V_DIM))
    h = h.reshape(B, S, A_V_COLS) * jax.nn.sigmoid(o_pre)
    return h @ w_out


def shared_kv(h, c_act, kv_norm_g, kv_ada_w, kv_ada_b, kv_w, cos, sin):
    B, S, _ = h.shape
    sh, sc = jnp.split((c_act @ kv_ada_w + kv_ada_b)[:, None, :], 2, axis=-1)
    y = modulate(rms_norm(h, kv_norm_g), sh, sc)
    kv = y @ kv_w
    k = kv[..., :B_K_COLS].reshape(B, S, B_HEADS, 2, B_HEAD_DIM)
    k = apply_partial_rope(k, cos, sin).transpose(0, 2, 3, 1, 4)
    v = kv[..., B_K_COLS:].reshape(B, S, B_HEADS, B_V_DIM).transpose(0, 2, 1, 3)
    return k[:, :, 0], k[:, :, 1], v


def diff_attention(y, k1, k2, v, w_q, lam_params, subln_g, w_out, cos, sin, lam_init):
    B, S, _ = y.shape
    q = (y @ w_q).reshape(B, S, B_HEADS, 2, B_HEAD_DIM)
    q = apply_partial_rope(q, cos, sin) * (B_HEAD_DIM ** -0.5)
    q = q.transpose(0, 2, 3, 1, 4)
    q1, q2 = q[:, :, 0], q[:, :, 1]
    lp = lam_params.astype(jnp.float32)
    lam = jnp.exp(jnp.sum(lp[0] * lp[1])) - jnp.exp(jnp.sum(lp[2] * lp[3])) + lam_init
    outs = []
    for blk in range(S // Q_BLOCK):
        q0 = blk * Q_BLOCK
        kv_len = q0 + Q_BLOCK
        mask = jnp.arange(kv_len)[None, :] <= jnp.arange(q0, kv_len)[:, None]
        s1 = jnp.einsum('bhqd,bhkd->bhqk', q1[:, :, q0:kv_len], k1[:, :, :kv_len]).astype(jnp.float32)
        s2 = jnp.einsum('bhqd,bhkd->bhqk', q2[:, :, q0:kv_len], k2[:, :, :kv_len]).astype(jnp.float32)
        p1 = jax.nn.softmax(jnp.where(mask, s1, -jnp.inf), axis=-1)
        p2 = jax.nn.softmax(jnp.where(mask, s2, -jnp.inf), axis=-1)
        a = (p1 - lam * p2).astype(v.dtype)
        outs.append(jnp.einsum('bhqk,bhkv->bhqv', a, v[:, :, :kv_len]))
    o = jnp.concatenate(outs, axis=2)
    o = rms_norm(o, subln_g, SUBLN_EPS) * (1 - lam_init)
    o = o.transpose(0, 2, 1, 3).reshape(B, S, B_HEADS * B_V_DIM)
    return o @ w_out


def setup_inputs(seed: int = 0) -> dict:
    key = jax.random.key(seed)
    ks = jax.random.split(key, 24)
    nrm = jax.random.normal
    f32 = jnp.float32
    x = nrm(ks[0], (BATCH, SEQ, D_MODEL), f32)
    c = nrm(ks[1], (BATCH, D_MODEL), f32)
    positions = (jnp.arange(SEQ, dtype=jnp.int32)[None, :]
                 + jax.random.randint(ks[2], (BATCH, 1), 0, 1024, dtype=jnp.int32))
    ada_w = nrm(ks[3], (DEPTH, D_MODEL, 6 * D_MODEL), f32) * (0.5 * D_MODEL ** -0.5)
    ada_b = 0.02 * nrm(ks[4], (DEPTH, 6 * D_MODEL), f32)
    norm_mix_g = 1.0 + 0.02 * nrm(ks[5], (DEPTH, D_MODEL), f32)
    norm_mlp_g = 1.0 + 0.02 * nrm(ks[6], (DEPTH, D_MODEL), f32)
    mlp_w_up = nrm(ks[7], (DEPTH, D_MODEL, D_FF), f32) * D_MODEL ** -0.5
    mlp_w_down = nrm(ks[8], (DEPTH, D_FF, D_MODEL), f32) * D_FF ** -0.5
    mlstm_w_in = nrm(ks[9], (N_A_LAYERS, D_MODEL, A_IN_COLS), f32) * D_MODEL ** -0.5
    b_i = 0.1 * nrm(ks[10], (N_A_LAYERS, A_HEADS), f32)
    b_f = jnp.linspace(3.0, 6.0, A_HEADS, dtype=f32)[None, :] + 0.1 * nrm(ks[11], (N_A_LAYERS, A_HEADS), f32)
    mlstm_b_gates = jnp.stack([b_i, b_f], axis=1)
    mlstm_head_g = 1.0 + 0.02 * nrm(ks[12], (N_A_LAYERS, A_V_COLS), f32)
    mlstm_w_out = nrm(ks[13], (N_A_LAYERS, A_V_COLS, D_MODEL), f32) * A_V_COLS ** -0.5
    kv_norm_g = 1.0 + 0.02 * nrm(ks[14], (D_MODEL,), f32)
    kv_ada_w = nrm(ks[15], (D_MODEL, 2 * D_MODEL), f32) * (0.5 * D_MODEL ** -0.5)
    kv_ada_b = 0.02 * nrm(ks[16], (2 * D_MODEL,), f32)
    kv_w = nrm(ks[17], (D_MODEL, B_KV_COLS), f32) * D_MODEL ** -0.5
    diff_w_q = nrm(ks[18], (N_B_LAYERS, D_MODEL, B_Q_COLS), f32) * D_MODEL ** -0.5
    diff_lambda = 0.1 * nrm(ks[19], (N_B_LAYERS, 4, B_HEAD_DIM), f32)
    diff_subln_g = 1.0 + 0.02 * nrm(ks[20], (N_B_LAYERS, B_V_DIM), f32)
    diff_w_out = nrm(ks[21], (N_B_LAYERS, B_HEADS * B_V_DIM, D_MODEL), f32) * (B_HEADS * B_V_DIM) ** -0.5
    final_norm_g = 1.0 + 0.02 * nrm(ks[22], (D_MODEL,), f32)
    return {"x": x, "c": c, "positions": positions,
            "ada_w": ada_w, "ada_b": ada_b,
            "norm_mix_g": norm_mix_g, "norm_mlp_g": norm_mlp_g,
            "mlp_w_up": mlp_w_up, "mlp_w_down": mlp_w_down,
            "mlstm_w_in": mlstm_w_in, "mlstm_b_gates": mlstm_b_gates,
            "mlstm_head_g": mlstm_head_g, "mlstm_w_out": mlstm_w_out,
            "kv_norm_g": kv_norm_g, "kv_ada_w": kv_ada_w, "kv_ada_b": kv_ada_b, "kv_w": kv_w,
            "diff_w_q": diff_w_q, "diff_lambda": diff_lambda,
            "diff_subln_g": diff_subln_g, "diff_w_out": diff_w_out,
            "final_norm_g": final_norm_g}


def reference(x, c, positions, ada_w, ada_b, norm_mix_g, norm_mlp_g, mlp_w_up, mlp_w_down,
              mlstm_w_in, mlstm_b_gates, mlstm_head_g, mlstm_w_out,
              kv_norm_g, kv_ada_w, kv_ada_b, kv_w,
              diff_w_q, diff_lambda, diff_subln_g, diff_w_out, final_norm_g):
    c_act = jax.nn.silu(c)
    cos, sin = rope_tables(positions)
    k1 = k2 = v = None
    for layer in range(DEPTH):
        mod = (c_act @ ada_w[layer] + ada_b[layer])[:, None, :]
        sh1, sc1, g1, sh2, sc2, g2 = jnp.split(mod, 6, axis=-1)
        y = modulate(rms_norm(x, norm_mix_g[layer]), sh1, sc1)
        if layer < N_A_LAYERS:
            mix = mlstm_mixer(y, mlstm_w_in[layer], mlstm_b_gates[layer],
                              mlstm_head_g[layer], mlstm_w_out[layer])
        else:
            j = layer - N_A_LAYERS
            mix = diff_attention(y, k1, k2, v, diff_w_q[j], diff_lambda[j], diff_subln_g[j],
                                 diff_w_out[j], cos, sin, lambda_init(layer + 1))
        x = x + g1 * mix
        y = modulate(rms_norm(x, norm_mlp_g[layer]), sh2, sc2)
        x = x + g2 * sq_relu_mlp(y, mlp_w_up[layer], mlp_w_down[layer])
        if layer == N_A_LAYERS - 1:
            k1, k2, v = shared_kv(x, c_act, kv_norm_g, kv_ada_w, kv_ada_b, kv_w, cos, sin)
    return rms_norm(x, final_norm_g)
```

```cpp
#include <hip/hip_runtime.h>
#include <hip/hip_bf16.h>
#include <cstdio>
#include <cstdint>
#include <cmath>
namespace pg8 {
#define PG8_LAS __attribute__((address_space(3)))
typedef unsigned short bf16_t;
typedef short bf16x8 __attribute__((ext_vector_type(8)));
typedef float f32x4 __attribute__((ext_vector_type(4)));
typedef unsigned u32x4 __attribute__((ext_vector_type(4)));
constexpr int BM = 256, BK = 64, HALF = 128, HTB = HALF * BK * 2  , STAGE_BYTES = 8 * HTB, NXCD = 8, WGM = 8;

__host__ __device__ __forceinline__ int lds_byte(int r, int c) { const int st = (r >> 4) * 2 + (c >> 5), rr = r & 15, cc = c & 31, ob = rr * 64 + cc * 2; return st * 1024 + (ob ^ (((ob >> 9) & 1) << 5)); }
__host__ __device__ __forceinline__ void stage_rc(int b, int& R, int& C) { const int st = b / 1024, sb = b % 1024, swz = sb ^ (((sb >> 9) & 1) << 5); R = (st >> 1) * 16 + swz / 64; C = (st & 1) * 32 + (swz % 64) / 2; }
__host__ __device__ __forceinline__ int perm32(int rho) { const int n = rho >> 4, i = rho & 15; return 8 * (i >> 2) + 4 * n + (i & 3); }

struct Unit { int pm, pn; };
struct Gemm { const bf16_t* A; const bf16_t* Bt; int M, N, K; };

struct StaticOrder {
    int nM, nN, nwg, G, c;
    __host__ __device__ void init(int M, int N, int G_, int c_) { nM = M / BM; nN = N / BM; nwg = nM * nN; G = G_; c = c_; }
    __host__ __device__ bool next(int i, Unit& u) const {
        const long L = (long)i * G + c; if (L >= nwg) return false;
        int wgid = (int)L; { const int q = nwg / NXCD, r = nwg % NXCD, xcd = wgid % NXCD, off = wgid / NXCD; wgid = (xcd < r ? xcd * (q + 1) : r * (q + 1) + (xcd - r) * q) + off; }
        const int nig = WGM * nN, gid = wgid / nig, fm = gid * WGM, gsz = (nM - fm) < WGM ? (nM - fm) : WGM;
        u.pm = fm + ((wgid % nig) % gsz); u.pn = (wgid % nig) / gsz; return true;
    }
    __device__ __forceinline__ void a_ready(const Unit&) const {}
    __device__ __forceinline__ void done(const Unit&) const {}
};

__device__ __forceinline__ unsigned cvt_pk_bf16(float lo, float hi) { unsigned r; asm volatile("v_cvt_pk_bf16_f32 %0, %1, %2" : "=v"(r) : "v"(lo), "v"(hi)); return r; }
typedef float f32x2 __attribute__((ext_vector_type(2)));
__device__ __forceinline__ float rstd_row(const float* p) {
    const f32x4 a = *(const f32x4*)(p), b = *(const f32x4*)(p + 4), c = *(const f32x4*)(p + 8), d = *(const f32x4*)(p + 12);
    const float s = (((a[0] + a[1]) + (a[2] + a[3])) + ((b[0] + b[1]) + (b[2] + b[3]))) + (((c[0] + c[1]) + (c[2] + c[3])) + ((d[0] + d[1]) + (d[2] + d[3])));
    return rsqrtf(s * (1.0f / 1024.0f) + 1e-6f);
}
template <int MODE> struct EpiLin {
    static constexpr bool PERM = true, AFTER_DRAIN = false;
    bf16_t* O; int ldo; const float* ssq; const float* bias; int ldbias; int row_off; const float* rope; int rope_pn_lim; float scale;
    __device__ __forceinline__ void operator()(const f32x4 (&acc)[2][2][4][2], const Unit& u, int wr, int wc, int fr, int fq) const {
        const int lrow0 = u.pm * BM + wr * 64 + fr, grow0 = row_off + lrow0;
        const int b = (row_off + u.pm * BM) >> 11;
        const int col0 = u.pn * BM + wc * 32 + 8 * fq;
        f32x4 bv[2][2];
#pragma unroll
        for (int bj = 0; bj < 2; ++bj)
#pragma unroll
            for (int n = 0; n < 2; ++n) bv[bj][n] = *(const f32x4*)(bias + (size_t)b * ldbias + col0 + bj * HALF + 4 * n);
        float sc = scale;
        if (MODE == 0) sc = (u.pn == 2 || u.pn == 3) ? 0.08838834764831845f : 1.0f;
        const bool do_rope = (MODE == 2) && (u.pn < rope_pn_lim) && ((wc & 1) == 0);
#pragma unroll
        for (int ai = 0; ai < 2; ++ai)
#pragma unroll
            for (int m = 0; m < 4; ++m) {
                const int lrow = lrow0 + ai * HALF + m * 16, grow = grow0 + ai * HALF + m * 16;
                const float rs = rstd_row(ssq + (size_t)grow * 16);
                f32x4 cs0 = {1.f, 1.f, 1.f, 1.f}, cs1 = cs0, sn0 = {0.f, 0.f, 0.f, 0.f}, sn1 = sn0;
                if (MODE == 2) { if (do_rope) { const float* rp = rope + (size_t)grow * 16; cs0 = *(const f32x4*)(rp); cs1 = *(const f32x4*)(rp + 4); sn0 = *(const f32x4*)(rp + 8); sn1 = *(const f32x4*)(rp + 12); } }
                bf16_t* rowp = O + (size_t)lrow * ldo + col0;
#pragma unroll
                for (int bj = 0; bj < 2; ++bj) {
                    f32x4 v0 = acc[ai][bj][m][0] * rs + bv[bj][0], v1 = acc[ai][bj][m][1] * rs + bv[bj][1];
                    if (MODE == 1) {
#pragma unroll
                        for (int e = 0; e < 4; ++e) { const float a0 = fmaxf(v0[e], 0.f), a1 = fmaxf(v1[e], 0.f); v0[e] = a0 * a0; v1[e] = a1 * a1; }
                    }
                    if (MODE == 2) {
                        if (do_rope) {
                            f32x4 o0, o1;
#pragma unroll
                            for (int e = 0; e < 4; ++e) { o0[e] = __shfl_xor(v0[e], 16); o1[e] = __shfl_xor(v1[e], 16); }
                            if (fq == 0) { v0 = v0 * cs0 - o0 * sn0; v1 = v1 * cs1 - o1 * sn1; }
                            else if (fq == 1) { v0 = v0 * cs0 + o0 * sn0; v1 = v1 * cs1 + o1 * sn1; }
                        }
                    }
                    if (MODE != 1) { v0 = v0 * sc; v1 = v1 * sc; }
                    u32x4 w; w.x = cvt_pk_bf16(v0[0], v0[1]); w.y = cvt_pk_bf16(v0[2], v0[3]); w.z = cvt_pk_bf16(v1[0], v1[1]); w.w = cvt_pk_bf16(v1[2], v1[3]);
                    *(u32x4*)(rowp + bj * HALF) = w;
                }
            }
    }
};
struct EpiRes {
    static constexpr bool PERM = false, AFTER_DRAIN = false;
    float* X; bf16_t* XG; bf16_t* XG2; float* ssq; const float* gate; int ldgate; const float* gm; const float* gm2; int row_off;
    __device__ __forceinline__ void operator()(const f32x4 (&acc)[2][2][4][2], const Unit& u, int wr, int wc, int fr, int fq) const {
        typedef unsigned u32x2v __attribute__((ext_vector_type(2)));
        const int grow0 = row_off + u.pm * BM + wr * 64 + fr;
        const int b = (row_off + u.pm * BM) >> 11;
        const int col0 = u.pn * BM + wc * 32 + 4 * fq;
        float ss[2][4];
#pragma unroll
        for (int ai = 0; ai < 2; ++ai)
#pragma unroll
            for (int m = 0; m < 4; ++m) ss[ai][m] = 0.f;
#pragma unroll
        for (int bj = 0; bj < 2; ++bj)
#pragma unroll
            for (int n = 0; n < 2; ++n) { const int c = col0 + bj * HALF + n * 16;
                const f32x4 gv = *(const f32x4*)(gate + (size_t)b * ldgate + c);
                const f32x4 mv = gm ? *(const f32x4*)(gm + (size_t)b * 1024 + c) : (f32x4){0.f, 0.f, 0.f, 0.f};
                const f32x4 mv2 = gm2 ? *(const f32x4*)(gm2 + (size_t)b * 1024 + c) : (f32x4){0.f, 0.f, 0.f, 0.f};
#pragma unroll
                for (int ai = 0; ai < 2; ++ai)
#pragma unroll
                    for (int m = 0; m < 4; ++m) { const size_t off = (size_t)(grow0 + ai * HALF + m * 16) * 1024 + c;
                        f32x4 x = *(const f32x4*)(X + off); x = x + gv * acc[ai][bj][m][n]; *(f32x4*)(X + off) = x;
                        ss[ai][m] += (x[0] * x[0] + x[1] * x[1]) + (x[2] * x[2] + x[3] * x[3]);
                        if (gm) { const f32x4 y = x * mv; u32x2v w; w.x = cvt_pk_bf16(y[0], y[1]); w.y = cvt_pk_bf16(y[2], y[3]); *(u32x2v*)(XG + off) = w; }
                        if (gm2) { const f32x4 y = x * mv2; u32x2v w; w.x = cvt_pk_bf16(y[0], y[1]); w.y = cvt_pk_bf16(y[2], y[3]); *(u32x2v*)(XG2 + off) = w; } }
                asm volatile("" ::: "memory"); }
#pragma unroll
        for (int ai = 0; ai < 2; ++ai)
#pragma unroll
            for (int m = 0; m < 4; ++m) { float t = ss[ai][m]; t += __shfl_xor(t, 16); t += __shfl_xor(t, 32);
                if (fq == 0) ssq[(size_t)(grow0 + ai * HALF + m * 16) * 16 + u.pn * 4 + wc] = t; }
    }
};

template <class Epi, class Sched, bool ALIGN_EPI = false, bool SP2 = false>
__device__ __forceinline__ void gemm_phase(PG8_LAS unsigned char* lds, const Gemm g, const Sched& S, const Epi& E) {
    int tid_ = threadIdx.x; asm volatile("" : "+v"(tid_));
    const int tid = tid_, wid = __builtin_amdgcn_readfirstlane(tid >> 6), lane = tid & 63, wr = wid >> 2, wc = wid & 3, fr = lane & 15, fq = lane >> 4;
    const int K = g.K, nt = K / BK;
    unsigned voffA[2], voffB[2];
#pragma unroll
    for (int i = 0; i < 2; ++i) { int R, C; stage_rc(tid * 16 + i * 8192, R, C); const int Rb = Epi::PERM ? ((R & ~31) + perm32(R & 31)) : R;
        voffA[i] = (unsigned)(R * K + C) * 2u; voffB[i] = (unsigned)(Rb * K + C) * 2u; }
    const size_t kstep = (size_t)(BK * 2);
    const size_t hstep = (size_t)HALF * K * 2;
    const size_t tstep = 2 * hstep;
    const unsigned ldsw = (unsigned)wid * 1024u;
    const int aoff = lds_byte(wr * 64 + fr, fq * 8), boff = lds_byte(wc * 32 + fr, fq * 8);
#define PG8_SA(b, h) (((b) * 2 + (h)) * HTB)
#define PG8_SB(b, h) ((4 + (b) * 2 + (h)) * HTB)
#define PG8_STAGE(bufoff, gbase, voff) do { _Pragma("unroll") for (int _i = 0; _i < 2; ++_i) \
        __builtin_amdgcn_global_load_lds((const unsigned*)((const char*)(gbase) + (voff)[_i]), (PG8_LAS unsigned*)(lds + (bufoff) + ldsw + _i * 8192), 16, 0, 0); } while (0)
#define PG8_LDA(dst, b, h) do { _Pragma("unroll") for (int m = 0; m < 4; ++m) _Pragma("unroll") for (int k = 0; k < 2; ++k) dst[m][k] = *(const PG8_LAS bf16x8*)(lds + PG8_SA(b, h) + aoff + m * 2048 + k * 1024); } while (0)
#define PG8_LDB(dst, b, h) do { _Pragma("unroll") for (int n = 0; n < 2; ++n) _Pragma("unroll") for (int k = 0; k < 2; ++k) dst[n][k] = *(const PG8_LAS bf16x8*)(lds + PG8_SB(b, h) + boff + n * 2048 + k * 1024); } while (0)
#define PG8_MMA(ai, bj, At, Bt) do { __builtin_amdgcn_s_setprio(1); _Pragma("unroll") for (int m = 0; m < 4; ++m) _Pragma("unroll") for (int n = 0; n < 2; ++n) _Pragma("unroll") for (int k = 0; k < 2; ++k) \
        acc[ai][bj][m][n] = __builtin_amdgcn_mfma_f32_16x16x32_bf16(Bt[n][k], At[m][k], acc[ai][bj][m][n], 0, 0, 0); __builtin_amdgcn_s_setprio(0); } while (0)
#define PG8_WAIT_V(n) asm volatile("s_waitcnt vmcnt(" #n ")" ::: "memory")
#define PG8_WAIT_L(n) asm volatile("s_waitcnt lgkmcnt(" #n ")" ::: "memory")
#define PG8_BAR __builtin_amdgcn_s_barrier()
#define PG8_SCHED __builtin_amdgcn_sched_barrier(0)
    Unit cur, nxt; int ui = 0;
    if (!S.next(0, cur)) return;
    f32x4 acc[2][2][4][2];
#pragma unroll
    for (int a = 0; a < 2; ++a)
#pragma unroll
        for (int b = 0; b < 2; ++b)
#pragma unroll
            for (int m = 0; m < 4; ++m)
#pragma unroll
                for (int n = 0; n < 2; ++n) acc[a][b][m][n] = (f32x4){0.f, 0.f, 0.f, 0.f};
    bf16x8 At[4][2], B0[2][2], B1[2][2];
    const char* cA = (const char*)g.A + (size_t)cur.pm * tstep; const char* cB = (const char*)g.Bt + (size_t)cur.pn * tstep;
    S.a_ready(cur);
    if constexpr (SP2) {
        PG8_STAGE(PG8_SB(0, 0), cB, voffB); PG8_STAGE(PG8_SB(0, 1), cB + hstep, voffB); PG8_STAGE(PG8_SA(0, 0), cA, voffA); PG8_STAGE(PG8_SA(0, 1), cA + hstep, voffA);
        if (wr == 1) PG8_BAR;
        PG8_WAIT_V(2); PG8_BAR;
        PG8_STAGE(PG8_SB(1, 0), cB + kstep, voffB); PG8_STAGE(PG8_SA(1, 0), cA + kstep, voffA); PG8_STAGE(PG8_SB(1, 1), cB + hstep + kstep, voffB);
        PG8_WAIT_V(6); PG8_BAR;
    } else {
        PG8_STAGE(PG8_SB(0, 0), cB, voffB); PG8_STAGE(PG8_SA(0, 0), cA, voffA); PG8_STAGE(PG8_SB(0, 1), cB + hstep, voffB); PG8_STAGE(PG8_SA(0, 1), cA + hstep, voffA);
        if (wr == 1) PG8_BAR;
        PG8_WAIT_V(4); PG8_BAR;
        PG8_STAGE(PG8_SB(1, 0), cB + kstep, voffB); PG8_STAGE(PG8_SA(1, 0), cA + kstep, voffA); PG8_STAGE(PG8_SB(1, 1), cB + hstep + kstep, voffB);
        PG8_WAIT_V(6); PG8_BAR;
    }
    for (;;) {
        const bool has_next = S.next(ui + 1, nxt);
        const char* nA = has_next ? (const char*)g.A + (size_t)nxt.pm * tstep : cA; const char* nB = has_next ? (const char*)g.Bt + (size_t)nxt.pn * tstep : cB;
        for (int t = 0; t < nt; t += 2) {
            const bool last = (t == nt - 2);
            const char* a1 = cA + (size_t)(t + 1) * kstep;
            const char* a2 = last ? nA : cA + (size_t)(t + 2) * kstep; const char* b2 = last ? nB : cB + (size_t)(t + 2) * kstep;
            const char* a3 = a2 + kstep; const char* b3 = b2 + kstep;
            if (last && has_next) S.a_ready(nxt);
            if constexpr (SP2) {
            PG8_LDB(B0, 0, 0); PG8_LDB(B1, 0, 1); PG8_SCHED; PG8_LDA(At, 0, 0); PG8_STAGE(PG8_SA(1, 1), a1 + hstep, voffA);
            PG8_WAIT_V(8); PG8_WAIT_L(0); PG8_BAR; PG8_MMA(0, 0, At, B0); PG8_MMA(0, 1, At, B1); PG8_BAR; PG8_SCHED;
            PG8_LDA(At, 0, 1); PG8_STAGE(PG8_SB(0, 0), b2, voffB); PG8_STAGE(PG8_SB(0, 1), b2 + hstep, voffB); PG8_STAGE(PG8_SA(0, 0), a2, voffA);
            PG8_WAIT_V(8); PG8_WAIT_L(0); PG8_BAR; PG8_MMA(1, 0, At, B0); PG8_MMA(1, 1, At, B1); PG8_BAR; PG8_SCHED;
            PG8_LDB(B0, 1, 0); PG8_LDB(B1, 1, 1); PG8_SCHED; PG8_LDA(At, 1, 0); PG8_STAGE(PG8_SA(0, 1), a2 + hstep, voffA);
            PG8_WAIT_V(8); PG8_WAIT_L(0); PG8_BAR; PG8_MMA(0, 0, At, B0); PG8_MMA(0, 1, At, B1); PG8_BAR; PG8_SCHED;
            PG8_LDA(At, 1, 1); PG8_STAGE(PG8_SB(1, 0), b3, voffB); PG8_STAGE(PG8_SB(1, 1), b3 + hstep, voffB); PG8_STAGE(PG8_SA(1, 0), a3, voffA);
            PG8_WAIT_V(8); PG8_WAIT_L(0); PG8_BAR; PG8_MMA(1, 0, At, B0); PG8_MMA(1, 1, At, B1); PG8_BAR; PG8_SCHED;
            } else {
            PG8_LDB(B0, 0, 0); PG8_SCHED; PG8_LDA(At, 0, 0); PG8_STAGE(PG8_SA(1, 1), a1 + hstep, voffA);
            PG8_WAIT_L(8); PG8_BAR; PG8_WAIT_L(0); PG8_MMA(0, 0, At, B0); PG8_BAR; PG8_SCHED;
            PG8_LDB(B1, 0, 1); PG8_STAGE(PG8_SB(0, 0), b2, voffB);
            PG8_BAR; PG8_WAIT_L(0); PG8_MMA(0, 1, At, B1); PG8_BAR;
            PG8_LDA(At, 0, 1); PG8_STAGE(PG8_SA(0, 0), a2, voffA);
            PG8_BAR; PG8_WAIT_L(0); PG8_MMA(1, 0, At, B0); PG8_BAR; PG8_SCHED;
            PG8_STAGE(PG8_SB(0, 1), b2 + hstep, voffB);
            PG8_WAIT_V(6); PG8_BAR; PG8_MMA(1, 1, At, B1); PG8_BAR;
            PG8_LDB(B0, 1, 0); PG8_SCHED; PG8_LDA(At, 1, 0); PG8_STAGE(PG8_SA(0, 1), a2 + hstep, voffA);
            PG8_WAIT_L(8); PG8_BAR; PG8_WAIT_L(0); PG8_MMA(0, 0, At, B0); PG8_BAR; PG8_SCHED;
            PG8_LDB(B1, 1, 1); PG8_STAGE(PG8_SB(1, 0), b3, voffB);
            PG8_BAR; PG8_WAIT_L(0); PG8_MMA(0, 1, At, B1); PG8_BAR;
            PG8_LDA(At, 1, 1); PG8_STAGE(PG8_SA(1, 0), a3, voffA);
            PG8_BAR; PG8_WAIT_L(0); PG8_MMA(1, 0, At, B0); PG8_BAR; PG8_SCHED;
            PG8_STAGE(PG8_SB(1, 1), b3 + hstep, voffB);
            PG8_WAIT_V(6); PG8_BAR; PG8_MMA(1, 1, At, B1); PG8_BAR;
            }
        }
        if constexpr (ALIGN_EPI) { if (wr == 0) PG8_BAR; }
        if constexpr (!Epi::AFTER_DRAIN) { E(acc, cur, wr, wc, fr, fq); S.done(cur); }
        if (!has_next) break;
#pragma unroll
        for (int a = 0; a < 2; ++a)
#pragma unroll
            for (int b = 0; b < 2; ++b)
#pragma unroll
                for (int m = 0; m < 4; ++m)
#pragma unroll
                    for (int n = 0; n < 2; ++n) acc[a][b][m][n] = (f32x4){0.f, 0.f, 0.f, 0.f};
        cur = nxt; cA = nA; cB = nB; ++ui;
        if constexpr (ALIGN_EPI) { if (wr == 1) PG8_BAR; }
    }
    PG8_WAIT_V(0);
    if constexpr (!ALIGN_EPI) { if (wr == 0) PG8_BAR; }
    PG8_BAR;
    if constexpr (Epi::AFTER_DRAIN) { E.fused(acc, cur, wr, wc, fr, fq, lds, wid, lane); S.done(cur); }
#undef PG8_SA
#undef PG8_SB
#undef PG8_STAGE
#undef PG8_LDA
#undef PG8_LDB
#undef PG8_MMA
#undef PG8_WAIT_V
#undef PG8_WAIT_L
#undef PG8_BAR
#undef PG8_SCHED
}
}

#ifndef PG8_SP2
#define PG8_SP2 true
#endif
#ifndef PG8_ALIGN
#define PG8_ALIGN true
#endif
#include <hip/hip_bf16.h>
#include <cmath>
namespace attn_body {
using bf16=__hip_bfloat16;
using bf16x8=__attribute__((ext_vector_type(8)))short;
using s16x4=__attribute__((ext_vector_type(4)))short;
using f32x16=__attribute__((ext_vector_type(16)))float;
using u32x4=__attribute__((ext_vector_type(4)))unsigned;
constexpr int SEQ=2048,D=64; constexpr int PQ=1024,PK=2048,PV=2048,PO=2048;
constexpr int NW=8,QBLK=32,QB=QBLK*NW,KVBLK=64,NQB=SEQ/QB;
constexpr int ATTN_UNIT_ROWS=QB;
__device__ __forceinline__ int crow(int r,int hi){return (r&3)+8*(r>>2)+4*hi;}
#define SBAR() __builtin_amdgcn_sched_barrier(0)
__device__ __forceinline__ void cmask(f32x16&p0,f32x16&p1,int jb,int qrel,int hi){
  const float NEG=-INFINITY; int kb=64*jb+4*hi;
  #pragma unroll
  for(int r=0;r<16;++r){int kv=kb+(r&3)+8*(r>>2); if(kv>qrel)p0[r]=NEG; if(kv+32>qrel)p1[r]=NEG;}
}

constexpr int NSLOT=3, SLOTB=8192;
constexpr int LDS_K=0, LDS_V=NSLOT*SLOTB, LDS_WS=2*NSLOT*SLOTB, LDS_OST=LDS_WS+NW*64*4, LDS_BYTES=LDS_OST+NW*4096;
constexpr float C2=0.125f*1.4426950408889634f;
__device__ __forceinline__ void glds16(const void*gsrc,unsigned lds_dst){unsigned keep;
  asm volatile("s_mov_b32 %0, m0\n\ts_mov_b32 m0, %2\n\ts_nop 0\n\tglobal_load_lds_dwordx4 %1, off\n\ts_mov_b32 m0, %0":"=&s"(keep):"v"(gsrc),"s"(lds_dst):"memory");}
__device__ __forceinline__ float max3f(float a,float b,float c){float r;asm("v_max3_f32 %0, %1, %2, %3":"=v"(r):"v"(a),"v"(b),"v"(c));return r;}
__device__ __forceinline__ float max2f(float a,float b){float r;asm("v_max_f32_e32 %0, %1, %2":"=v"(r):"v"(a),"v"(b));return r;}
__device__ __forceinline__ float fadd_s(float a,float b){float r;asm("v_add_f32_e32 %0, %1, %2":"=v"(r):"v"(a),"v"(b));return r;}
__device__ __forceinline__ float fsub_s(float a,float b){float r;asm("v_sub_f32_e32 %0, %1, %2":"=v"(r):"v"(a),"v"(b));return r;}
typedef float f32x2_t __attribute__((ext_vector_type(2))); typedef __bf16 bf16x2_t __attribute__((ext_vector_type(2)));
__device__ __forceinline__ unsigned cvtpk_s(float lo,float hi){f32x2_t v={lo,hi};bf16x2_t b=__builtin_convertvector(v,bf16x2_t);return __builtin_bit_cast(unsigned,b);}
#define WAIT_BAR(N) asm volatile("s_waitcnt vmcnt(" #N ") lgkmcnt(0)\n\ts_barrier":::"memory")

__device__ __forceinline__ void qkt(f32x16&p0,f32x16&p1,const char*Kslot,const bf16x8*qr,const f32x16&negm,int r32,int hi){
  const char*kb=Kslot+hi*1024+r32*16;
  #pragma unroll
  for(int d0=0;d0<4;++d0){
    const bf16x8 b0=*reinterpret_cast<const bf16x8*>(kb+d0*2048);
    const bf16x8 b1=*reinterpret_cast<const bf16x8*>(kb+d0*2048+512);
    if(d0==0){p0=__builtin_amdgcn_mfma_f32_32x32x16_bf16(b0,qr[0],negm,0,0,0);p1=__builtin_amdgcn_mfma_f32_32x32x16_bf16(b1,qr[0],negm,0,0,0);}
    else{p0=__builtin_amdgcn_mfma_f32_32x32x16_bf16(b0,qr[d0],p0,0,0,0);p1=__builtin_amdgcn_mfma_f32_32x32x16_bf16(b1,qr[d0],p1,0,0,0);}}
}
typedef __attribute__((address_space(3))) const char* lds_cptr;
typedef short v4i16_t __attribute__((ext_vector_type(4)));
__device__ __forceinline__ void kload8(bf16x8*kf,lds_cptr kp){
  kf[0]=*(const __attribute__((address_space(3))) bf16x8*)(kp);      kf[1]=*(const __attribute__((address_space(3))) bf16x8*)(kp+512);
  kf[2]=*(const __attribute__((address_space(3))) bf16x8*)(kp+2048); kf[3]=*(const __attribute__((address_space(3))) bf16x8*)(kp+2560);
  kf[4]=*(const __attribute__((address_space(3))) bf16x8*)(kp+4096); kf[5]=*(const __attribute__((address_space(3))) bf16x8*)(kp+4608);
  kf[6]=*(const __attribute__((address_space(3))) bf16x8*)(kp+6144); kf[7]=*(const __attribute__((address_space(3))) bf16x8*)(kp+6656);
}
__device__ __forceinline__ void kload2(bf16x8*kf,lds_cptr kp,int j){ kf[2*j]=*(const __attribute__((address_space(3))) bf16x8*)(kp+j*2048); kf[2*j+1]=*(const __attribute__((address_space(3))) bf16x8*)(kp+j*2048+512); }
__device__ __forceinline__ s16x4 vtr(lds_cptr p){ return __builtin_bit_cast(s16x4,__builtin_amdgcn_ds_read_tr16_b64_v4i16((__attribute__((address_space(3))) v4i16_t*)p)); }
__device__ __forceinline__ float rowmax(const f32x16&p0,const f32x16&p1){
  float a=max3f(p0[0],p0[1],p1[0]),b=max3f(p0[2],p0[3],p1[1]);a=max3f(a,p1[2],p1[3]);
  #pragma unroll
  for(int r=4;r<16;r+=4){a=max3f(a,p0[r],p0[r+1]);b=max3f(b,p0[r+2],p0[r+3]);a=max3f(a,p1[r],p1[r+1]);b=max3f(b,p1[r+2],p1[r+3]);}
  const float m=max2f(a,b);
  auto rr=__builtin_amdgcn_permlane32_swap(__float_as_uint(m),__float_as_uint(m),false,false);
  return max2f(__uint_as_float(rr[0]),__uint_as_float(rr[1]));
}
__device__ __forceinline__ void pv(f32x16*o,int vb,bf16x8 pa0,bf16x8 pa1,bf16x8 pa2,bf16x8 pa3){
  #pragma unroll
  for(int d0=0;d0<2;++d0){s16x4 lo[4],hi[4];
    #pragma unroll
    for(int ks=0;ks<4;++ks){
      asm volatile("ds_read_b64_tr_b16 %0,%1 offset:%c2":"=&v"(lo[ks]):"v"(vb),"i"(d0*4096+ks*1024):"memory");
      asm volatile("ds_read_b64_tr_b16 %0,%1 offset:%c2":"=&v"(hi[ks]):"v"(vb),"i"(d0*4096+ks*1024+512):"memory");}
    asm volatile("s_waitcnt lgkmcnt(0)":::"memory");SBAR();
    #define PK(k) (bf16x8){lo[k][0],lo[k][1],lo[k][2],lo[k][3],hi[k][0],hi[k][1],hi[k][2],hi[k][3]}
    o[d0]=__builtin_amdgcn_mfma_f32_32x32x16_bf16(pa0,PK(0),o[d0],0,0,0);
    o[d0]=__builtin_amdgcn_mfma_f32_32x32x16_bf16(pa1,PK(1),o[d0],0,0,0);
    o[d0]=__builtin_amdgcn_mfma_f32_32x32x16_bf16(pa2,PK(2),o[d0],0,0,0);
    o[d0]=__builtin_amdgcn_mfma_f32_32x32x16_bf16(pa3,PK(3),o[d0],0,0,0);
    #undef PK
  }
}

#ifndef ATTN_STORE16
#define ATTN_STORE16(p,v) (*(u32x4*)(p)=(v))
#endif
template<int THRL> __device__ __forceinline__ void attn_unit(int b,int qb,const bf16*Q,const bf16*__restrict__ K,const bf16*__restrict__ V,bf16*O,char*shm){
  int tid_=threadIdx.x; asm volatile("":"+v"(tid_));
  const int tid=tid_,lane=tid&63,r32=lane&31,hi=lane>>5; const int wid=__builtin_amdgcn_readfirstlane(tid>>6);
  const long rowbase=(long)b*SEQ; const int q0=qb*QB;
  const bf16*Qw=Q+(rowbase+q0+wid*QBLK)*PQ;
  const bf16*Kh=K+rowbase*PK,*Vh=V+rowbase*PV;
  const unsigned lds0=(unsigned)(uintptr_t)shm;
  float*wsf=(float*)(shm+LDS_WS)+wid*64;
  const bf16*ksrc=Kh+(long)lane*PK+wid*8;
  const bf16*vsrc=Vh+(long)(16*(wid&3)+(lane>>2))*PV+(wid>>2)*32+(lane&3)*8;
  const unsigned kdst=lds0+LDS_K+wid*1024, vdst=lds0+LDS_V+wid*1024;
  #define DMA_K(t,slot) glds16(ksrc+(long)(t)*KVBLK*PK,(unsigned)__builtin_amdgcn_readfirstlane(kdst+(slot)))
  #define DMA_V(t,slot) glds16(vsrc+(long)(t)*KVBLK*PV,(unsigned)__builtin_amdgcn_readfirstlane(vdst+(slot)))
  const int vb0=(int)(lds0+LDS_V)+((lane>>4)&1)*32+(lane&3)*8+(4*hi+((lane&15)>>2))*64;
  const char*Kbase=shm+LDS_K; bf16x8 kf[8];
  const lds_cptr shm3=(lds_cptr)shm; const lds_cptr kp0=shm3+LDS_K+hi*1024+r32*16; const lds_cptr vp0=shm3+LDS_V+((lane>>4)&1)*32+(lane&3)*8+(4*hi+((lane&15)>>2))*64;
  const int NT=(q0+QB)/KVBLK;
  DMA_K(0,0);DMA_V(0,0);DMA_K(1,SLOTB);
  bf16x8 qr[4];
  #pragma unroll
  for(int d0=0;d0<4;++d0)qr[d0]=*reinterpret_cast<const bf16x8*>(&Qw[(long)r32*PQ+d0*16+hi*8]);
  float mhat=0.f,l_reg=0.f;f32x16 o[2];o[0]=f32x16{};o[1]=f32x16{};f32x16 negm=f32x16{};asm volatile("":"+v"(negm));
  const int qrel=wid*QBLK+r32;
  #define CMASK(P0,P1,t) do{int jb_=(t)-(NT-4); if(jb_>=0)cmask(P0,P1,jb_,qrel,hi);}while(0)
  bool resc=false;
  #define START(P0,P1) do{ const float rm=rowmax(P0,P1); resc=false; \
    { const float dl=rm; mhat=fadd_s(mhat,dl); \
      _Pragma("unroll") for(int r=0;r<16;++r){P0[r]=fsub_s(P0[r],dl);P1[r]=fsub_s(P1[r],dl);} \
      _Pragma("unroll") for(int r=0;r<16;++r)negm[r]=-mhat; asm volatile("":"+v"(negm)); } \
    _Pragma("unroll") for(int r=0;r<16;++r)P0[r]=__builtin_amdgcn_exp2f(P0[r]); }while(0)
  #define RESC() do{ if(resc){ asm volatile("s_waitcnt lgkmcnt(0)":::"memory"); \
      _Pragma("unroll") for(int d_=0;d_<2;++d_) _Pragma("unroll") for(int r=0;r<16;++r)o[d_][r]*=wsf[crow(r,hi)]; } }while(0)
  f32x16 pA0,pA1,pB0,pB1;
  int sl_prev=0,sl_cur=0,sl_next=SLOTB;
  #define ROT() do{sl_prev=sl_cur;sl_cur=sl_next;sl_next=(sl_next==(NSLOT-1)*SLOTB)?0:sl_next+SLOTB;}while(0)
  DMA_K(2,2*SLOTB);
  WAIT_BAR(3);
  qkt(pA0,pA1,Kbase,qr,negm,r32,hi);asm volatile("s_nop 15\n\ts_nop 7":"+v"(pA0),"+v"(pA1));CMASK(pA0,pA1,0);
  START(pA0,pA1);
  _Pragma("unroll") for(int r=0;r<16;++r)pA1[r]=__builtin_amdgcn_exp2f(pA1[r]);
  WAIT_BAR(0);
  DMA_K(3,0);DMA_V(1,SLOTB);
  ROT();
  kload8(kf,kp0+sl_cur);
  WAIT_BAR(2);
  s16x4 vlo[8],vhi[8]; u32x4 pw0,pw1,pw2,pw3;
  #define PKW(P,B) cvtpk_s(P[B],P[B+1])
  #define PAF(k) __builtin_bit_cast(bf16x8,pw##k)
  #define VFR(i) (bf16x8){vlo[i][0],vlo[i][1],vlo[i][2],vlo[i][3],vhi[i][0],vhi[i][1],vhi[i][2],vhi[i][3]}
  #define PIN(x) asm volatile("":"+v"(x))
  #define MX3(a,b,c) __builtin_fmaxf(__builtin_fmaxf((a),(b)),(c))
  #define GAPA(MF,A0,A1,A2,A3,W0,W1,PW) do{ MF; sacc+=A0; sacc+=A1; sacc+=A2; sacc+=A3; PIN(sacc); W0; W1; PIN(PW); SBAR(); }while(0)
  #define EX(v) __builtin_amdgcn_exp2f(v)
  #define GAPB(MF,X,B) do{ MF; X[B]=EX(X[B]); X[B+1]=EX(X[B+1]); X[B+2]=EX(X[B+2]); X[B+3]=EX(X[B+3]); PIN(X); SBAR(); }while(0)
  #define VRD(i) do{ vlo[i]=vtr(vp_+(((i)>>2)*4096+((i)&3)*1024)); vhi[i]=vtr(vp_+(((i)>>2)*4096+((i)&3)*1024+512)); }while(0)
  #define KRD(G,j) do{ if(G){ kload2(kf,kp0+sl_next,j); SBAR(); } }while(0)
  #define STEP(C0,C1,P0,P1,t,GK,GV,GL) do{ SBAR(); \
    const lds_cptr vp_=vp0+sl_prev; \
    VRD(0); SBAR(); float sacc=(P0[0]+P0[1]); \
    GAPA(C0=__builtin_amdgcn_mfma_f32_32x32x16_bf16(kf[0],qr[0],negm,0,0,0), P0[2],P0[3],P0[4],P0[5],     pw0[0]=PKW(P0,0), pw0[1]=PKW(P0,2), pw0); \
    VRD(4); SBAR(); GAPA(C1=__builtin_amdgcn_mfma_f32_32x32x16_bf16(kf[1],qr[0],negm,0,0,0), P0[6],P0[7],P0[8],P0[9],     pw0[2]=PKW(P0,4), pw0[3]=PKW(P0,6), pw0); \
    VRD(1); SBAR(); GAPA(C0=__builtin_amdgcn_mfma_f32_32x32x16_bf16(kf[2],qr[1],C0,0,0,0),   P0[10],P0[11],P0[12],P0[13], pw1[0]=PKW(P0,8), pw1[1]=PKW(P0,10), pw1); \
    VRD(5); SBAR(); GAPA(C1=__builtin_amdgcn_mfma_f32_32x32x16_bf16(kf[3],qr[1],C1,0,0,0),   P0[14],P0[15],P1[0],P1[1],   pw1[2]=PKW(P0,12),pw1[3]=PKW(P0,14), pw1); \
    VRD(2); SBAR(); GAPA(C0=__builtin_amdgcn_mfma_f32_32x32x16_bf16(kf[4],qr[2],C0,0,0,0),   P1[2],P1[3],P1[4],P1[5],     pw2[0]=PKW(P1,0), pw2[1]=PKW(P1,2), pw2); \
    VRD(6); SBAR(); GAPA(C1=__builtin_amdgcn_mfma_f32_32x32x16_bf16(kf[5],qr[2],C1,0,0,0),   P1[6],P1[7],P1[8],P1[9],     pw2[2]=PKW(P1,4), pw2[3]=PKW(P1,6), pw2); \
    VRD(3); SBAR(); GAPA(C0=__builtin_amdgcn_mfma_f32_32x32x16_bf16(kf[6],qr[3],C0,0,0,0),   P1[10],P1[11],P1[12],P1[13], pw3[0]=PKW(P1,8), pw3[1]=PKW(P1,10), pw3); \
    VRD(7); SBAR(); GAPA(C1=__builtin_amdgcn_mfma_f32_32x32x16_bf16(kf[7],qr[3],C1,0,0,0),   P1[14],P1[15],0.f,0.f,       pw3[2]=PKW(P1,12),pw3[3]=PKW(P1,14), pw3); \
    l_reg+=sacc; \
    if(GK){DMA_K((t)+3,sl_cur);} if(GV){DMA_V((t)+1,sl_next);} \
    CMASK(C0,C1,t); \
    { float a=MX3(C0[0],C0[1],C1[0]),b=MX3(C0[2],C0[3],C1[1]); a=MX3(a,C1[2],C1[3]); \
      _Pragma("unroll") for(int r=4;r<16;r+=4){a=MX3(a,C0[r],C0[r+1]);b=MX3(b,C0[r+2],C0[r+3]);a=MX3(a,C1[r],C1[r+1]);b=MX3(b,C1[r+2],C1[r+3]);} \
      float rm=__builtin_fmaxf(a,b); { auto rr=__builtin_amdgcn_permlane32_swap(__float_as_uint(rm),__float_as_uint(rm),false,false); rm=__builtin_fmaxf(__uint_as_float(rr[0]),__uint_as_float(rr[1])); } \
      resc=false; \
      if(__builtin_expect(__any(rm>(float)THRL),0)){ const float dl=__builtin_fmaxf(rm,0.f); mhat+=dl; \
        _Pragma("unroll") for(int r=0;r<16;++r){C0[r]-=dl;C1[r]-=dl;} \
        _Pragma("unroll") for(int r=0;r<16;++r)negm[r]=-mhat; asm volatile("":"+v"(negm)); \
        const float f=__builtin_amdgcn_exp2f(-dl); l_reg*=f; if(hi==0)wsf[r32]=f; resc=true; } } \
    SBAR(); \
    GAPB(o[0]=__builtin_amdgcn_mfma_f32_32x32x16_bf16(PAF(0),VFR(0),o[0],0,0,0), C0,0); \
    GAPB(o[1]=__builtin_amdgcn_mfma_f32_32x32x16_bf16(PAF(0),VFR(4),o[1],0,0,0), C0,4); \
    KRD(GL,0); GAPB(o[0]=__builtin_amdgcn_mfma_f32_32x32x16_bf16(PAF(1),VFR(1),o[0],0,0,0), C0,8); \
    KRD(GL,1); GAPB(o[1]=__builtin_amdgcn_mfma_f32_32x32x16_bf16(PAF(1),VFR(5),o[1],0,0,0), C0,12); \
    KRD(GL,2); GAPB(o[0]=__builtin_amdgcn_mfma_f32_32x32x16_bf16(PAF(2),VFR(2),o[0],0,0,0), C1,0); \
    KRD(GL,3); GAPB(o[1]=__builtin_amdgcn_mfma_f32_32x32x16_bf16(PAF(2),VFR(6),o[1],0,0,0), C1,4); \
    GAPB(o[0]=__builtin_amdgcn_mfma_f32_32x32x16_bf16(PAF(3),VFR(3),o[0],0,0,0), C1,8); \
    GAPB(o[1]=__builtin_amdgcn_mfma_f32_32x32x16_bf16(PAF(3),VFR(7),o[1],0,0,0), C1,12); \
    }while(0)
  int t=1;
  #undef CMASK
  #define CMASK(P0,P1,t) do{}while(0)
  for(;t+5<NT;t+=2){
    STEP(pB0,pB1,pA0,pA1,t,true,true,true);     WAIT_BAR(2); RESC(); ROT();
    STEP(pA0,pA1,pB0,pB1,t+1,true,true,true);   WAIT_BAR(2); RESC(); ROT();
  }
  #undef CMASK
  #define CMASK(P0,P1,t) do{int jb_=(t)-(NT-4); if(jb_>=0)cmask(P0,P1,jb_,qrel,hi);}while(0)
  #define ENDW(tt) do{ if((tt)+3<NT){WAIT_BAR(2);} else if((tt)+2<NT){WAIT_BAR(1);} else {WAIT_BAR(0);} }while(0)
  for(;t+1<NT;t+=2){
    STEP(pB0,pB1,pA0,pA1,t,(t+3<NT),(t+1<NT),(t+1<NT));       ENDW(t);   RESC(); ROT();
    STEP(pA0,pA1,pB0,pB1,t+1,(t+4<NT),(t+2<NT),(t+2<NT));     ENDW(t+1); RESC(); ROT();
  }
  STEP(pB0,pB1,pA0,pA1,NT-1,false,false,false); RESC();
  { float sacc=pB0[0]+pB0[1]; _Pragma("unroll") for(int r=2;r<16;++r)sacc+=pB0[r]; _Pragma("unroll") for(int r=0;r<16;++r)sacc+=pB1[r]; l_reg+=sacc;
    pw0=(u32x4){PKW(pB0,0),PKW(pB0,2),PKW(pB0,4),PKW(pB0,6)};pw1=(u32x4){PKW(pB0,8),PKW(pB0,10),PKW(pB0,12),PKW(pB0,14)};pw2=(u32x4){PKW(pB1,0),PKW(pB1,2),PKW(pB1,4),PKW(pB1,6)};pw3=(u32x4){PKW(pB1,8),PKW(pB1,10),PKW(pB1,12),PKW(pB1,14)};
    SBAR(); pv(o,vb0+sl_cur,PAF(0),PAF(1),PAF(2),PAF(3)); }
  #undef PKW
  #undef PAF
  #undef VFR
  #undef PIN
  #undef MX3
  #undef GAPA
  #undef GAPB
  #undef EX
  #undef VRD
  #undef KRD
  #undef STEP
  #undef ENDW
  {auto rr=__builtin_amdgcn_permlane32_swap(__float_as_uint(l_reg),__float_as_uint(l_reg),false,false);l_reg=__uint_as_float(rr[0])+__uint_as_float(rr[1]);}
  if(hi==0)wsf[32+r32]=l_reg;asm volatile("s_waitcnt lgkmcnt(0)":::"memory");
  float rli[16];
  #pragma unroll
  for(int r=0;r<16;++r)rli[r]=__builtin_amdgcn_rcpf(wsf[32+crow(r,hi)]);
  bf16*Ow=O+(rowbase+q0+wid*QBLK)*PO;
  { bf16*stg=(bf16*)(shm+LDS_OST)+wid*2048;
    #pragma unroll
    for(int r=0;r<16;++r){const int orow=crow(r,hi);
      #pragma unroll
      for(int d0=0;d0<2;++d0)stg[orow*64+d0*32+r32]=__float2bfloat16(o[d0][r]*rli[r]);}
    asm volatile("s_waitcnt lgkmcnt(0)":::"memory");
    #pragma unroll
    for(int i=0;i<4;++i){const int row=i*8+(lane>>3),ch=lane&7; const u32x4 v=*(const u32x4*)(stg+row*64+ch*8); ATTN_STORE16(Ow+(long)row*PO+ch*8,v);} }
  asm volatile("s_waitcnt lgkmcnt(0)\n\ts_barrier":::"memory");
  #undef DMA_K
  #undef DMA_V
  #undef CMASK
  #undef START
  #undef RESC
  #undef ROT
}
constexpr int ATTN_LDS_BYTES=LDS_BYTES;
#undef SBAR
#undef WAIT_BAR
}
constexpr int NWAVES = 8;
constexpr int BATCH = 32, SEQ = 2048, D = 1024, FF = 4096, M = BATCH * SEQ, MH = M / 2;
constexpr int A_IN = 3080, A_INP = 3072;
constexpr size_t MiB = 1u << 20;
constexpr size_t WS_CTL = 0, CTL_ZERO_BYTES = 1 * MiB;
constexpr size_t WS_MODS = 1 * MiB;
constexpr size_t WS_KVMOD = 4 * MiB;
constexpr size_t WS_GM_MIX = WS_KVMOD + 256 * 1024;
constexpr size_t WS_GM_MLP = WS_GM_MIX + 512 * 1024;
constexpr size_t WS_GM_KV = WS_GM_MLP + 512 * 1024;
constexpr size_t WS_B_IN = 6 * MiB;
constexpr size_t WS_B_UP = 7 * MiB;
constexpr size_t WS_B_KV = 9 * MiB;
constexpr size_t WS_B_Q = WS_B_KV + 256 * 1024;
constexpr size_t WS_WG = WS_B_Q + 256 * 1024;
constexpr size_t WS_LAM = WS_WG + 64 * 1024;
constexpr size_t WS_ROPE = 10 * MiB;
constexpr size_t WS_GATES = 14 * MiB;
constexpr size_t WS_SSQ = 16 * MiB;
constexpr size_t WS_WUP = 20 * MiB, WS_WDN = 52 * MiB, WS_WIN = 84 * MiB, WS_WMO = 96 * MiB, WS_WKV = 100 * MiB, WS_WQ = 104 * MiB, WS_WDO = 108 * MiB;
constexpr size_t WS_XG = 112 * MiB;
constexpr size_t WS_HN = 240 * MiB;
constexpr size_t WS_H = 368 * MiB;
constexpr size_t WS_KV = 624 * MiB;
constexpr size_t WS_Q = 880 * MiB;
constexpr size_t WS_END = 1008 * MiB;
constexpr size_t WS_QKVO = WS_H;
constexpr size_t WS_O = WS_H;
static_assert(WS_QKVO + (size_t)M * 3072 * 2 <= WS_Q && WS_O + (size_t)M * 2048 * 2 <= WS_KV && WS_H + (size_t)MH * FF * 2 <= WS_KV && WS_Q + (size_t)M * 1024 * 2 <= WS_END, "d_ws map");
constexpr int CW_TMO = 0, CW_CODE = 1, CW_DIAG = 8;
constexpr int CW_BAR = 4096;
constexpr int RING_OFF = 0, RING_BYTES = 131072;
constexpr int LDSCTL_OFF = RING_BYTES, MISC_OFF = LDSCTL_OFF + 320;
constexpr int GATE_OFF = LDSCTL_OFF + 1024;
constexpr int LDS_BYTES = 147456;
static_assert(GATE_OFF + 1024 <= LDS_BYTES, "LDS map");

#define GAS __attribute__((address_space(1)))
#define LAS __attribute__((address_space(3)))
typedef unsigned short bf16;
typedef unsigned v4u __attribute__((ext_vector_type(4)));
typedef float f32x4 __attribute__((ext_vector_type(4)));
typedef short bf16x8 __attribute__((ext_vector_type(8)));
typedef GAS unsigned gu32;
typedef GAS unsigned long long gu64;
#define RLX_AGENT __ATOMIC_RELAXED, __HIP_MEMORY_SCOPE_AGENT
#define LDS_WAIT() asm volatile("s_waitcnt lgkmcnt(0)" ::: "memory")
#define VM_WAIT() asm volatile("s_waitcnt vmcnt(0)" ::: "memory")
__device__ __forceinline__ unsigned long long rt() { return __builtin_amdgcn_s_memrealtime(); }
__device__ __forceinline__ unsigned f2bf(float f) { unsigned u = __builtin_bit_cast(unsigned, f); return (u + 0x7fffu + ((u >> 16) & 1u)) >> 16; }
__device__ __forceinline__ unsigned pk2(float lo, float hi) { return f2bf(lo) | (f2bf(hi) << 16); }

#define XB_TMO      128
#define XB_XCNT(j)  (256  + 64 * (j))
#define XB_XSUB(j)  (1280 + 64 * (j))
#define XB_XGEN(j)  (2304 + 64 * (j))
#define XB_TOP      3328
#define XB_TOPGEN   3392
#define XCD_BAR_WORDS 3456
#define XB_SPIN_CAP (1u << 18)

__device__ __forceinline__ unsigned xb_ld(unsigned* p)              { return __hip_atomic_load(p, __ATOMIC_RELAXED, __HIP_MEMORY_SCOPE_AGENT); }
__device__ __forceinline__ unsigned xb_add(unsigned* p, unsigned v) { return __hip_atomic_fetch_add(p, v, __ATOMIC_RELAXED, __HIP_MEMORY_SCOPE_AGENT); }
__device__ __forceinline__ unsigned xb_xcc_id() { return (unsigned)__builtin_amdgcn_s_getreg((3 << 11) | 20) & 0xFu; }
#define XB_SPIN(cond, bar) do { unsigned _sp = 0; while (cond) { __builtin_amdgcn_s_sleep(1); \
    if ((++_sp & 255u) == 0u) { if (xb_ld(&(bar)[XB_TMO])) break; if (_sp > XB_SPIN_CAP) { atomicAdd(&(bar)[XB_TMO], 1u); break; } } } } while (0)

struct XcdBarrier {
    unsigned* bar; unsigned x;
    volatile LAS unsigned* st;
};

__device__ __forceinline__ XcdBarrier xcd_barrier_post(unsigned* bar, volatile LAS unsigned* st) {
    XcdBarrier b; b.bar = bar; b.x = xb_xcc_id(); b.st = st;
    if (threadIdx.x == 0) (void)xb_add(&bar[XB_XCNT(b.x)], 1u);
    return b;
}
__device__ __forceinline__ void xcd_barrier_complete(unsigned* bar, unsigned x, unsigned& nloc, unsigned& nx) {
    const unsigned G = gridDim.x * gridDim.y * gridDim.z;
    unsigned sum, cnt, mine, sp = 0u;
    for (;;) {
        sum = 0u; cnt = 0u; mine = 0u;
#pragma unroll
        for (unsigned j = 0; j < 16; ++j) { const unsigned c = xb_ld(&bar[XB_XCNT(j)]); sum += c; cnt += (c > 0u) ? 1u : 0u; mine = (j == x) ? c : mine; }
        if (sum == G) break;
        __builtin_amdgcn_s_sleep(1);
        if ((++sp & 255u) == 0u) { if (xb_ld(&bar[XB_TMO])) break; if (sp > XB_SPIN_CAP) { atomicAdd(&bar[XB_TMO], 1u); break; } }
    }
    nloc = mine > 0u ? mine : 1u; nx = cnt > 0u ? cnt : 1u;
}

__device__ __forceinline__ void xcd_barrier(const XcdBarrier& b) {
    asm volatile("s_waitcnt vmcnt(0)" ::: "memory");
    __syncthreads();
    if (threadIdx.x == 0) {
        unsigned* bar = b.bar;
        __builtin_amdgcn_s_waitcnt(0);
        unsigned nloc = b.st[0], nx = b.st[1];
        if (nloc == 0u) { xcd_barrier_complete(bar, b.x, nloc, nx); b.st[0] = nloc; b.st[1] = nx; }
        const unsigned old = xb_add(&bar[XB_XSUB(b.x)], 1u);
        const unsigned gen = old / nloc;
        if (old + 1u == (gen + 1u) * nloc) {
            __builtin_amdgcn_fence(__ATOMIC_RELEASE, "agent");
            asm volatile("s_waitcnt vmcnt(0)" ::: "memory");
            const unsigned og = xb_add(&bar[XB_TOP], 1u);
            const unsigned tg = og / nx;
            if (og + 1u == (tg + 1u) * nx) xb_add(&bar[XB_TOPGEN], 1u);
            else XB_SPIN(xb_ld(&bar[XB_TOPGEN]) == tg, bar);
            __builtin_amdgcn_fence(__ATOMIC_ACQUIRE, "agent");
            xb_add(&bar[XB_XGEN(b.x)], 1u);
            asm volatile("s_waitcnt vmcnt(0)" ::: "memory");
        } else {
            XB_SPIN(xb_ld(&bar[XB_XGEN(b.x)]) == gen, bar);
            __builtin_amdgcn_fence(__ATOMIC_ACQUIRE, "agent");
            asm volatile("s_waitcnt vmcnt(0)" ::: "memory");
        }
    }
    __syncthreads();
}


#ifndef PH_MASK
#define PH_MASK 0xffff
#endif
#define PHM(b) ((PH_MASK >> (b)) & 1)
struct Frame {
    LAS unsigned char* lds;
    volatile LAS unsigned* MISC;
    gu32* ctl;
    int tid, lane, wave;
    int vcu, G;
    unsigned char* ws;
};
__device__ __forceinline__ const void* ld_arg(int i) {
    const void* ka = (const void*)__builtin_amdgcn_kernarg_segment_ptr(); unsigned long long p;
    asm volatile("s_load_dwordx2 %0, %1, %2\n\ts_waitcnt lgkmcnt(0)" : "=s"(p) : "s"(ka), "s"(i * 8) : "memory");
    return (const void*)p;
}
#define INF(i) ((const float*)(const GAS float*)ld_arg(i))
#define WSF(off) ((float*)(F.ws + (off)))
#define WSB(off) ((bf16*)(F.ws + (off)))
__device__ __forceinline__ float wave_sum(float v) {
#pragma unroll
    for (int o = 1; o < 64; o <<= 1) v += __shfl_xor(v, o);
    return v;
}
__device__ __forceinline__ float bflo(unsigned w) { return __uint_as_float(w << 16); }
__device__ __forceinline__ float bfhi(unsigned w) { return __uint_as_float(w & 0xffff0000u); }
typedef unsigned u32x2 __attribute__((ext_vector_type(2)));

template <bool SILU>
__device__ __forceinline__ void small_gemm_unit(Frame& F, const float* A, int lda, const float* W, int ldw, int N, int n0, const float* bias, float* out, int ldo) {
    LAS float* As = (LAS float*)(F.lds + RING_OFF);
    for (int i = F.tid; i < 8192; i += NWAVES * 64) { const int b = i >> 8, k4 = (i & 255) * 4;
        f32x4 v = *(const f32x4*)(A + (size_t)b * lda + k4);
        if (SILU) {
#pragma unroll
            for (int e = 0; e < 4; ++e) v[e] = v[e] / (1.0f + expf(-v[e])); }
        *(LAS f32x4*)(As + b * 1024 + k4) = v; }
    __syncthreads();
    const int col = n0 + F.lane; const bool ok = col < N;
    const float* wp = W + (size_t)(F.wave * 128) * ldw + (ok ? col : n0);
    float acc[32];
#pragma unroll
    for (int b = 0; b < 32; ++b) acc[b] = 0.f;
#pragma unroll 2
    for (int kk = 0; kk < 128; kk += 4) {
        const float w0 = wp[(size_t)(kk + 0) * ldw], w1 = wp[(size_t)(kk + 1) * ldw], w2 = wp[(size_t)(kk + 2) * ldw], w3 = wp[(size_t)(kk + 3) * ldw];
        const LAS float* ap = As + F.wave * 128 + kk;
#pragma unroll
        for (int b = 0; b < 32; ++b) { const f32x4 a = *(const LAS f32x4*)(ap + b * 1024); acc[b] += (a[0] * w0 + a[1] * w1) + (a[2] * w2 + a[3] * w3); }
    }
    __syncthreads();
    LAS float* red = As;
#pragma unroll
    for (int b = 0; b < 32; ++b) red[(F.wave * 32 + b) * 64 + F.lane] = acc[b];
    __syncthreads();
#pragma unroll
    for (int j = 0; j < 4; ++j) { const int o = F.tid + 512 * j, b = o >> 6, cc = o & 63; float s = 0.f;
#pragma unroll
        for (int w = 0; w < 8; ++w) s += red[(w * 32 + b) * 64 + cc];
        const int n = n0 + cc; if (n < N) out[(size_t)b * ldo + n] = s + (bias ? bias[n] : 0.f); }
    __syncthreads();
}
__device__ __forceinline__ void p0_transpose_item(const float* W, int ldw, int K, int ncols, bf16* WT, LAS float* scr, int item, int lane) {
    const int nblk = ncols / 32, kb = item / nblk, nb = item % nblk, k0 = 64 * kb, n0 = 32 * nb;
#pragma unroll 8
    for (int i = 0; i < 32; ++i) { const int kk = 2 * i + (lane >> 5); scr[kk * 33 + (lane & 31)] = W[(size_t)(k0 + kk) * ldw + n0 + (lane & 31)]; }
    LDS_WAIT(); asm volatile("" ::: "memory");
    const int c = lane & 7;
#pragma unroll
    for (int j = 0; j < 4; ++j) { const int n = (lane >> 3) + 8 * j; const LAS float* s = scr + (8 * c) * 33 + n;
        v4u o; o.x = pk2(s[0 * 33], s[1 * 33]); o.y = pk2(s[2 * 33], s[3 * 33]); o.z = pk2(s[4 * 33], s[5 * 33]); o.w = pk2(s[6 * 33], s[7 * 33]);
        *(GAS v4u*)(WT + (size_t)(n0 + n) * K + k0 + 8 * c) = o; }
    LDS_WAIT(); asm volatile("" ::: "memory");
}
__device__ __forceinline__ void sincos_d(double a, double& s, double& c) {
    const double k = rint(a * 0.63661977236758134308);
    const double r = fma(-k, 6.123233995736766e-17, fma(-k, 1.5707963267948966, a));
    const int q = ((int)k) & 3;
    const double r2 = r * r;
    double sp = 1.0 / 6227020800.0; sp = sp * r2 - 1.0 / 39916800.0; sp = sp * r2 + 1.0 / 362880.0; sp = sp * r2 - 1.0 / 5040.0; sp = sp * r2 + 1.0 / 120.0; sp = sp * r2 - 1.0 / 6.0; sp = sp * r2 + 1.0;
    const double sr = r * sp;
    double cp = -1.0 / 87178291200.0; cp = cp * r2 + 1.0 / 479001600.0; cp = cp * r2 - 1.0 / 3628800.0; cp = cp * r2 + 1.0 / 40320.0; cp = cp * r2 - 1.0 / 720.0; cp = cp * r2 + 1.0 / 24.0; cp = cp * r2 - 0.5; cp = cp * r2 + 1.0;
    const double cr = cp;
    s = (q == 0) ? sr : (q == 1) ? cr : (q == 2) ? -sr : -cr;
    c = (q == 0) ? cr : (q == 1) ? -sr : (q == 2) ? -cr : sr;
}
__device__ __forceinline__ void p0a(Frame& F) {
    const float* in_c = INF(1); const float* in_ada_w = INF(3); const float* in_ada_b = INF(4); const float* in_kv_ada_w = INF(14); const float* in_kv_ada_b = INF(15); const float* in_w_up = INF(7); const float* in_w_down = INF(8); const float* in_w_in = INF(9); const float* in_w_mo = INF(12); const float* in_kv_w = INF(16); const float* in_w_q = INF(17); const float* in_w_do = INF(20); const int* in_pos = (const int*)(const GAS int*)ld_arg(2); const float* in_lam_p = INF(18);
    for (int u = F.vcu; u < 416; u += F.G) {
        const float *W, *bias; float* out; int ld, n0;
        if (u < 384) { const int l = u / 96, ch = u % 96; W = in_ada_w + (size_t)l * 1024 * 6144; bias = in_ada_b + l * 6144; out = WSF(WS_MODS) + (size_t)l * 32 * 6144; ld = 6144; n0 = ch * 64; }
        else { W = in_kv_ada_w; bias = in_kv_ada_b; out = WSF(WS_KVMOD); ld = 2048; n0 = (u - 384) * 64; }
        small_gemm_unit<true>(F, in_c, 1024, W, ld, ld, n0, bias, out, ld);
    }
    LAS float* scr = (LAS float*)(F.lds + RING_OFF + F.wave * 16384);
    const int gw = F.vcu * NWAVES + F.wave, NGW = F.G * NWAVES;
    for (int it = gw; it < 23552; it += NGW) {
        const float* W; bf16* WT; int ldw, K, nc, r = it;
        if (r < 8192) { const int l = r >> 11; r &= 2047; W = in_w_up + (size_t)l * D * FF; WT = WSB(WS_WUP) + (size_t)l * D * FF; ldw = FF; K = D; nc = FF; }
        else if (r < 16384) { r -= 8192; const int l = r >> 11; r &= 2047; W = in_w_down + (size_t)l * D * FF; WT = WSB(WS_WDN) + (size_t)l * D * FF; ldw = D; K = FF; nc = D; }
        else if (r < 19456) { r -= 16384; const int l = r / 1536; r -= l * 1536; W = in_w_in + (size_t)l * D * A_IN; WT = WSB(WS_WIN) + (size_t)l * D * A_INP; ldw = A_IN; K = D; nc = A_INP; }
        else if (r < 20480) { r -= 19456; const int l = r >> 9; r &= 511; W = in_w_mo + (size_t)l * D * D; WT = WSB(WS_WMO) + (size_t)l * D * D; ldw = D; K = D; nc = D; }
        else if (r < 21504) { r -= 20480; W = in_kv_w; WT = WSB(WS_WKV); ldw = 2048; K = D; nc = 2048; }
        else if (r < 22528) { r -= 21504; const int l = r >> 9; r &= 511; W = in_w_q + (size_t)l * D * D; WT = WSB(WS_WQ) + (size_t)l * D * D; ldw = D; K = D; nc = D; }
        else { r -= 22528; const int l = r >> 9; r &= 511; W = in_w_do + (size_t)l * D * D; WT = WSB(WS_WDO) + (size_t)l * D * D; ldw = D; K = D; nc = D; }
        p0_transpose_item(W, ldw, K, nc, WT, scr, r, F.lane);
    }
    const int gt = F.vcu * (NWAVES * 64) + F.tid, NGT = F.G * NWAVES * 64;
    for (int i = gt; i < 2 * 8 * 1024; i += NGT) { const int l = i >> 13, j = (i >> 10) & 7, k = i & 1023; WSF(WS_WG)[i] = in_w_in[(size_t)l * D * A_IN + (size_t)k * A_IN + A_INP + j]; }
    for (int i = gt; i < M * 8; i += NGT) { const int m = i >> 3, j = i & 7;
        const float inv = (j == 0) ? 1.0f : (j == 1) ? 0.1939227432012558f : (j == 2) ? 0.03760603070259094f : (j == 3) ? 0.007292664609849453f : (j == 4) ? 0.0014142135623842478f
                        : (j == 5) ? 0.00027424818836152554f : (j == 6) ? 5.318296098266728e-05f : 1.0313386155758053e-05f;
        const float ang = (float)in_pos[m] * inv; double s, c; sincos_d((double)ang, s, c);
        WSF(WS_ROPE)[(size_t)m * 16 + j] = (float)c; WSF(WS_ROPE)[(size_t)m * 16 + 8 + j] = (float)s; }
    if (blockIdx.x == 0 && F.tid < 2) { const float* lp = in_lam_p + F.tid * 256; float s1 = 0.f, s2 = 0.f;
        for (int i = 0; i < 64; ++i) { s1 += lp[i] * lp[64 + i]; s2 += lp[128 + i] * lp[192 + i]; }
        WSF(WS_LAM)[F.tid] = expf(s1) - expf(s2) + (F.tid == 0 ? 0.4707130183435842f : 0.5560582041556406f); }
}
__device__ __forceinline__ void p0b(Frame& F) {
    const float* in_w_in = INF(9); const float* in_w_up = INF(7); const float* in_kv_w = INF(16); const float* in_w_q = INF(17); const float* in_norm_mix_g = INF(5); const float* in_norm_mlp_g = INF(6); const float* in_kv_norm_g = INF(13); const float* in_x = INF(0); float* in_out = (float*)(GAS float*)ld_arg(22);
    for (int u = F.vcu; u < 418; u += F.G) {
        const float *A, *W; float* out; int lda, ld, n0;
        if (u < 98) { const int l = u / 49, ch = u % 49; A = WSF(WS_MODS) + (size_t)l * 32 * 6144; lda = 6144; W = in_w_in + (size_t)l * D * A_IN; ld = A_IN; out = WSF(WS_B_IN) + (size_t)l * 32 * A_IN; n0 = ch * 64; }
        else if (u < 354) { const int l = (u - 98) >> 6, ch = (u - 98) & 63; A = WSF(WS_MODS) + (size_t)l * 32 * 6144 + 3072; lda = 6144; W = in_w_up + (size_t)l * D * FF; ld = FF; out = WSF(WS_B_UP) + (size_t)l * 32 * FF; n0 = ch * 64; }
        else if (u < 386) { A = WSF(WS_KVMOD); lda = 2048; W = in_kv_w; ld = 2048; out = WSF(WS_B_KV); n0 = (u - 354) * 64; }
        else { const int j = (u - 386) >> 4, ch = (u - 386) & 15; A = WSF(WS_MODS) + (size_t)(2 + j) * 32 * 6144; lda = 6144; W = in_w_q + (size_t)j * D * D; ld = D; out = WSF(WS_B_Q) + (size_t)j * 32 * D; n0 = ch * 64; }
        small_gemm_unit<false>(F, A, lda, W, ld, ld, n0, nullptr, out, ld);
    }
    const int gt = F.vcu * (NWAVES * 64) + F.tid, NGT = F.G * NWAVES * 64;
    for (int i = gt; i < 4 * 32 * 1024; i += NGT) { const int l = i >> 15, b = (i >> 10) & 31, k = i & 1023;
        WSF(WS_GM_MIX)[i] = in_norm_mix_g[l * 1024 + k] * (1.0f + WSF(WS_MODS)[(size_t)l * 32 * 6144 + (size_t)b * 6144 + 1024 + k]);
        WSF(WS_GM_MLP)[i] = in_norm_mlp_g[l * 1024 + k] * (1.0f + WSF(WS_MODS)[(size_t)l * 32 * 6144 + (size_t)b * 6144 + 4096 + k]); }
    for (int i = gt; i < 32 * 1024; i += NGT) { const int b = i >> 10, k = i & 1023; WSF(WS_GM_KV)[i] = in_kv_norm_g[k] * (1.0f + WSF(WS_KVMOD)[(size_t)b * 2048 + 1024 + k]); }
    const int gw = F.vcu * NWAVES + F.wave, NGW = F.G * NWAVES;
    for (int m = gw; m < M; m += NGW) { const int b = m >> 11;
        const float* xr = in_x + (size_t)m * D; float* orow = in_out + (size_t)m * D; bf16* gr = WSB(WS_XG) + (size_t)m * D; float ss = 0.f;
#pragma unroll
        for (int j = 0; j < 4; ++j) { const int c = 4 * F.lane + 256 * j; const f32x4 v = *(const f32x4*)(xr + c); *(f32x4*)(orow + c) = v;
            ss += (v[0] * v[0] + v[1] * v[1]) + (v[2] * v[2] + v[3] * v[3]);
            const f32x4 g = *(const f32x4*)(in_norm_mix_g + c), s = *(const f32x4*)(WSF(WS_MODS) + (size_t)b * 6144 + 1024 + c);
            u32x2 w; w.x = pk2(v[0] * (g[0] * (1.0f + s[0])), v[1] * (g[1] * (1.0f + s[1]))); w.y = pk2(v[2] * (g[2] * (1.0f + s[2])), v[3] * (g[3] * (1.0f + s[3]))); *(u32x2*)(gr + c) = w; }
        ss = wave_sum(ss);
        if (F.lane < 16) WSF(WS_SSQ)[(size_t)m * 16 + F.lane] = (F.lane == 0) ? ss : 0.f; }
}
__device__ __forceinline__ void gates_phase(Frame& F, int l) {
    const float* in_b_gates = INF(10);
    LAS float* wg = (LAS float*)(F.lds + RING_OFF);
    const float* WGl = WSF(WS_WG) + l * 8192;
    for (int i = F.tid; i < 2048; i += NWAVES * 64) *(LAS f32x4*)(wg + 4 * i) = *(const f32x4*)(WGl + 4 * i);
    __syncthreads();
    const float* bg = in_b_gates + l * 8;
    const float* bin = WSF(WS_B_IN) + (size_t)l * 32 * A_IN;
    const int gw = F.vcu * NWAVES + F.wave, NGW = F.G * NWAVES;
    for (int m = gw; m < M; m += NGW) {
        const bf16* xr = WSB(WS_XG) + (size_t)m * D; float d[8];
#pragma unroll
        for (int j = 0; j < 8; ++j) d[j] = 0.f;
#pragma unroll
        for (int jj = 0; jj < 4; ++jj) { const int c = 4 * F.lane + 256 * jj; const u32x2 w = *(const u32x2*)(xr + c);
            const float x0 = bflo(w.x), x1 = bfhi(w.x), x2 = bflo(w.y), x3 = bfhi(w.y);
#pragma unroll
            for (int j = 0; j < 8; ++j) { const f32x4 g = *(const LAS f32x4*)(wg + j * 1024 + c); d[j] += (x0 * g[0] + x1 * g[1]) + (x2 * g[2] + x3 * g[3]); } }
#pragma unroll
        for (int j = 0; j < 8; ++j) d[j] = wave_sum(d[j]);
        float sp = (F.lane < 16) ? WSF(WS_SSQ)[(size_t)m * 16 + F.lane] : 0.f; sp = wave_sum(sp);
        const float rstd = rsqrtf(sp * (1.0f / 1024.0f) + 1e-6f);
        if (F.lane < 8) { float ds = d[0];
#pragma unroll
            for (int j = 1; j < 8; ++j) ds = (F.lane == j) ? d[j] : ds;
            const float pre = rstd * ds + bin[(size_t)(m >> 11) * A_IN + A_INP + F.lane] + bg[F.lane];
            const float ls = fminf(pre, 0.f) - log1pf(expf(-fabsf(pre)));
            WSF(WS_GATES)[(size_t)m * 8 + F.lane] = (F.lane < 4) ? pre : ls; }
    }
    __syncthreads();
}
__device__ __forceinline__ void mlstm_simple_phase(Frame& F, int l) {
    const float* in_head_g = INF(11);
    LAS unsigned short* qs = (LAS unsigned short*)(F.lds + RING_OFF);
    LAS unsigned short* ks = (LAS unsigned short*)(F.lds + RING_OFF + 16384);
    LAS unsigned short* vs = (LAS unsigned short*)(F.lds + RING_OFF + 32768);
    LAS float* hs = (LAS float*)(F.lds + RING_OFF + 65536);
    LAS float* gi = (LAS float*)(F.lds + GATE_OFF); LAS float* gf = gi + 64;
    const float* hg = in_head_g + l * 1024;
    const int dvl = F.lane & 31, half = F.lane >> 5;
    for (int u = F.vcu; u < 128; u += F.G) {
        const int b = u >> 2, h = u & 3; const size_t rowbase = (size_t)b * SEQ;
        float C[64];
#pragma unroll
        for (int j = 0; j < 64; ++j) C[j] = 0.f;
        float n0 = 0.f, n1 = 0.f, mst = 0.f;
        for (int c = 0; c < 32; ++c) {
            const size_t row0 = rowbase + (size_t)c * 64;
#pragma unroll
            for (int ii = 0; ii < 2; ++ii) { const int i = F.tid + 512 * ii, r = i >> 4, ch = i & 15; const bf16* src = WSB(WS_QKVO) + (row0 + r) * 3072 + h * 128 + ch * 8;
                *(LAS v4u*)(qs + r * 128 + ch * 8) = *(const v4u*)(src); *(LAS v4u*)(ks + r * 128 + ch * 8) = *(const v4u*)(src + 512); }
#pragma unroll
            for (int ii = 0; ii < 4; ++ii) { const int i = F.tid + 512 * ii, r = i >> 5, ch = i & 31; *(LAS v4u*)(vs + r * 256 + ch * 8) = *(const v4u*)(WSB(WS_QKVO) + (row0 + r) * 3072 + 1024 + h * 256 + ch * 8); }
            if (F.tid < 64) gi[F.tid] = WSF(WS_GATES)[(row0 + F.tid) * 8 + h];
            else if (F.tid < 128) gf[F.tid - 64] = WSF(WS_GATES)[(row0 + F.tid - 64) * 8 + 4 + h];
            __syncthreads();
            for (int t = 0; t < 64; ++t) {
                const float it = gi[t], lf = gf[t];
                const float mnew = fmaxf(lf + mst, it), fw = expf(lf + mst - mnew), iw = expf(it - mnew); mst = mnew;
                const float vt = __uint_as_float((unsigned)vs[t * 256 + 32 * F.wave + dvl] << 16), ivt = iw * vt;
                float acc = 0.f;
#pragma unroll
                for (int j8 = 0; j8 < 8; ++j8) {
                    const v4u kq = *(const LAS v4u*)(ks + t * 128 + 64 * half + 8 * j8), qq = *(const LAS v4u*)(qs + t * 128 + 64 * half + 8 * j8);
#pragma unroll
                    for (int e = 0; e < 4; ++e) { const unsigned kw = kq[e], qw = qq[e];
                        C[8 * j8 + 2 * e] = fw * C[8 * j8 + 2 * e] + ivt * bflo(kw); acc += bflo(qw) * C[8 * j8 + 2 * e];
                        C[8 * j8 + 2 * e + 1] = fw * C[8 * j8 + 2 * e + 1] + ivt * bfhi(kw); acc += bfhi(qw) * C[8 * j8 + 2 * e + 1]; }
                }
                acc += __shfl_xor(acc, 32);
                const float kl0 = __uint_as_float((unsigned)ks[t * 128 + F.lane] << 16), kl1 = __uint_as_float((unsigned)ks[t * 128 + 64 + F.lane] << 16);
                const float ql0 = __uint_as_float((unsigned)qs[t * 128 + F.lane] << 16), ql1 = __uint_as_float((unsigned)qs[t * 128 + 64 + F.lane] << 16);
                n0 = fw * n0 + iw * kl0; n1 = fw * n1 + iw * kl1;
                const float qn = wave_sum(ql0 * n0 + ql1 * n1);
                const float den = fmaxf(fabsf(qn), expf(-mnew));
                if (half == 0) hs[t * 256 + 32 * F.wave + dvl] = acc / den;
            }
            __syncthreads();
            {
                const int t = F.tid >> 3, seg = F.tid & 7; const LAS float* hp = hs + t * 256 + 32 * seg; f32x4 hv[8]; float ss = 0.f;
#pragma unroll
                for (int i = 0; i < 8; ++i) { hv[i] = *(const LAS f32x4*)(hp + 4 * i); ss += (hv[i][0] * hv[i][0] + hv[i][1] * hv[i][1]) + (hv[i][2] * hv[i][2] + hv[i][3] * hv[i][3]); }
                ss += __shfl_xor(ss, 1); ss += __shfl_xor(ss, 2); ss += __shfl_xor(ss, 4);
                const float rstd = rsqrtf(ss * (1.0f / 256.0f) + 1e-6f);
                const bf16* op = WSB(WS_QKVO) + (row0 + t) * 3072 + 2048 + h * 256 + 32 * seg; bf16* dst = WSB(WS_HN) + (row0 + t) * 1024 + h * 256 + 32 * seg; const float* gp = hg + h * 256 + 32 * seg;
#pragma unroll
                for (int i = 0; i < 4; ++i) { const v4u ow = *(const v4u*)(op + 8 * i); v4u r;
#pragma unroll
                    for (int e = 0; e < 4; ++e) { const float o0 = bflo(ow[e]), o1 = bfhi(ow[e]);
                        const float h0 = hv[2 * i + (e >> 1)][2 * (e & 1)], h1 = hv[2 * i + (e >> 1)][2 * (e & 1) + 1];
                        const float y0 = h0 * rstd * gp[8 * i + 2 * e] / (1.0f + expf(-o0)), y1 = h1 * rstd * gp[8 * i + 2 * e + 1] / (1.0f + expf(-o1));
                        r[e] = pk2(y0, y1); }
                    *(v4u*)(dst + 8 * i) = r; }
            }
            __syncthreads();
        }
    }
}
__device__ __forceinline__ void combine_phase(Frame& F, int j) {
    const float* in_subln_g = INF(19);
    const float lam = WSF(WS_LAM)[j], post = 1.0f - (j == 0 ? 0.4707130183435842f : 0.5560582041556406f);
    const float* sg = in_subln_g + j * 128 + 16 * (F.lane & 7);
    const int gw = F.vcu * NWAVES + F.wave, NGW = F.G * NWAVES;
    for (int m = gw; m < M; m += NGW) {
        const bf16* o1 = WSB(WS_O) + (size_t)m * 2048 + 16 * F.lane; const bf16* o2 = o1 + 1024;
        const v4u a0 = *(const v4u*)(o1), a1 = *(const v4u*)(o1 + 8), b0 = *(const v4u*)(o2), b1 = *(const v4u*)(o2 + 8);
        float o[16]; float ss = 0.f;
#pragma unroll
        for (int e = 0; e < 4; ++e) { o[2 * e] = bflo(a0[e]) - lam * bflo(b0[e]); o[2 * e + 1] = bfhi(a0[e]) - lam * bfhi(b0[e]); o[8 + 2 * e] = bflo(a1[e]) - lam * bflo(b1[e]); o[8 + 2 * e + 1] = bfhi(a1[e]) - lam * bfhi(b1[e]); }
#pragma unroll
        for (int i = 0; i < 16; ++i) ss += o[i] * o[i];
        ss += __shfl_xor(ss, 1); ss += __shfl_xor(ss, 2); ss += __shfl_xor(ss, 4);
        const float rstd = rsqrtf(ss * (1.0f / 128.0f) + 1e-5f) * post;
        v4u r0, r1;
#pragma unroll
        for (int e = 0; e < 4; ++e) { r0[e] = pk2(o[2 * e] * rstd * sg[2 * e], o[2 * e + 1] * rstd * sg[2 * e + 1]); r1[e] = pk2(o[8 + 2 * e] * rstd * sg[8 + 2 * e], o[8 + 2 * e + 1] * rstd * sg[8 + 2 * e + 1]); }
        bf16* dst = WSB(WS_HN) + (size_t)m * 1024 + 16 * F.lane; *(v4u*)(dst) = r0; *(v4u*)(dst + 8) = r1;
    }
}
__device__ __forceinline__ void final_phase(Frame& F, float fill) {
    const float* in_final_g = INF(21); float* in_out = (float*)(GAS float*)ld_arg(22);
    const int gw = F.vcu * NWAVES + F.wave, NGW = F.G * NWAVES;
    for (int m = gw; m < M; m += NGW) {
        float sp = (F.lane < 16) ? WSF(WS_SSQ)[(size_t)m * 16 + F.lane] : 0.f; sp = wave_sum(sp);
        const float rstd = rsqrtf(sp * (1.0f / 1024.0f) + 1e-6f);
        float* xr = in_out + (size_t)m * D;
#pragma unroll
        for (int j = 0; j < 4; ++j) { const int c = 4 * F.lane + 256 * j; f32x4 v = *(const f32x4*)(xr + c); const f32x4 g = *(const f32x4*)(in_final_g + c);
            v = v * rstd * g; if (fill != 0.f) v = (f32x4){fill, fill, fill, fill}; *(f32x4*)(xr + c) = v; }
    }
}

#define IN(k) (lo <= (k) && (k) < hi)
#define SEAM(k) do { if ((k) + 1 < hi) xcd_barrier(bar); } while (0)
template <int l> __device__ __forceinline__ void layer_phases(Frame& F, const XcdBarrier& bar, const int lo, const int hi, unsigned char* lds, float* in_out) {
        const int pb = 2 + 10 * l;
        if constexpr (l < 2) {
            if (IN(pb + 0)) {
                if (PHM(2)) gates_phase(F, l);
                pg8::Gemm g{WSB(WS_XG), WSB(WS_WIN) + (size_t)l * D * A_INP, M, A_INP, D}; pg8::StaticOrder S; S.init(M, A_INP, F.G, (int)blockIdx.x);
                pg8::EpiLin<0> E{WSB(WS_QKVO), A_INP, WSF(WS_SSQ), WSF(WS_B_IN) + (size_t)l * 32 * A_IN, A_IN, 0, nullptr, 0, 1.0f};
                if (PHM(3)) pg8::gemm_phase<pg8::EpiLin<0>, pg8::StaticOrder, PG8_ALIGN, PG8_SP2>(F.lds + RING_OFF, g, S, E);
                SEAM(pb + 0);
            }
            if (IN(pb + 1)) { if (PHM(4)) mlstm_simple_phase(F, l); SEAM(pb + 1); }
        } else {
            const int j = l - 2;
            if (IN(pb + 0)) {
                pg8::Gemm g{WSB(WS_XG), WSB(WS_WQ) + (size_t)j * D * D, M, D, D}; pg8::StaticOrder S; S.init(M, D, F.G, (int)blockIdx.x);
                pg8::EpiLin<2> E{WSB(WS_Q), D, WSF(WS_SSQ), WSF(WS_B_Q) + (size_t)j * 32 * D, D, 0, WSF(WS_ROPE), 4, attn_body::C2};
                if (PHM(5)) pg8::gemm_phase<pg8::EpiLin<2>, pg8::StaticOrder, PG8_ALIGN, PG8_SP2>(F.lds + RING_OFF, g, S, E);
                SEAM(pb + 0);
            }
            if (IN(pb + 1)) {
                for (int i = 0;; ++i) { const int item = (i >> 3) * F.G + F.vcu; if (item >= 1024) break;
                    const int qb = 7 - (i & 7), b = item >> 5, vh = item & 31, h = vh >> 2, comp = (vh >> 1) & 1, vhalf = vh & 1;
                    if (PHM(6)) attn_body::attn_unit<8>(b, qb, (const attn_body::bf16*)WSB(WS_Q) + (h * 128 + comp * 64), (const attn_body::bf16*)WSB(WS_KV) + (h * 128 + comp * 64),
                                            (const attn_body::bf16*)WSB(WS_KV) + (1024 + h * 128 + vhalf * 64), (attn_body::bf16*)WSB(WS_O) + (comp * 1024 + h * 128 + vhalf * 64), (char*)lds + RING_OFF); }
                SEAM(pb + 1);
            }
            if (IN(pb + 2)) { if (PHM(7)) combine_phase(F, j); SEAM(pb + 2); }
        }
        if (IN(pb + 3)) {
            const bf16* W = (l < 2) ? WSB(WS_WMO) + (size_t)l * D * D : WSB(WS_WDO) + (size_t)(l - 2) * D * D;
            pg8::Gemm g{WSB(WS_HN), W, M, D, D}; pg8::StaticOrder S; S.init(M, D, F.G, (int)blockIdx.x);
            pg8::EpiRes E{in_out, WSB(WS_XG), nullptr, WSF(WS_SSQ), WSF(WS_MODS) + (size_t)l * 32 * 6144 + 2048, 6144, WSF(WS_GM_MLP) + (size_t)l * 32 * 1024, nullptr, 0};
            if (PHM(8)) pg8::gemm_phase<pg8::EpiRes, pg8::StaticOrder, PG8_ALIGN, PG8_SP2>(F.lds + RING_OFF, g, S, E);
            SEAM(pb + 3);
        }
#pragma unroll 1
        for (int hm = 0; hm < 2; ++hm) {
            if (IN(pb + 4 + 2 * hm)) {
                pg8::Gemm g{WSB(WS_XG) + (size_t)hm * MH * D, WSB(WS_WUP) + (size_t)l * D * FF, MH, FF, D}; pg8::StaticOrder S; S.init(MH, FF, F.G, (int)blockIdx.x);
                pg8::EpiLin<1> E{WSB(WS_H), FF, WSF(WS_SSQ), WSF(WS_B_UP) + (size_t)l * 32 * FF, FF, hm * MH, nullptr, 0, 1.0f};
                if (PHM(9)) pg8::gemm_phase<pg8::EpiLin<1>, pg8::StaticOrder, PG8_ALIGN, PG8_SP2>(F.lds + RING_OFF, g, S, E);
                SEAM(pb + 4 + 2 * hm);
            }
            if (IN(pb + 5 + 2 * hm)) {
                pg8::Gemm g{WSB(WS_H), WSB(WS_WDN) + (size_t)l * D * FF, MH, D, FF}; pg8::StaticOrder S; S.init(MH, D, F.G, (int)blockIdx.x);
                pg8::EpiRes E{in_out, WSB(WS_XG), (l == 1) ? WSB(WS_HN) : nullptr, WSF(WS_SSQ), WSF(WS_MODS) + (size_t)l * 32 * 6144 + 5120, 6144,
                              (l < 3) ? WSF(WS_GM_MIX) + (size_t)(l + 1) * 32 * 1024 : nullptr, (l == 1) ? WSF(WS_GM_KV) : nullptr, hm * MH};
                if (PHM(10)) pg8::gemm_phase<pg8::EpiRes, pg8::StaticOrder, PG8_ALIGN, PG8_SP2>(F.lds + RING_OFF, g, S, E);
                SEAM(pb + 5 + 2 * hm);
            }
        }
        if constexpr (l == 1) if (IN(pb + 8)) {
            pg8::Gemm g{WSB(WS_HN), WSB(WS_WKV), M, 2048, D}; pg8::StaticOrder S; S.init(M, 2048, F.G, (int)blockIdx.x);
            pg8::EpiLin<2> E{WSB(WS_KV), 2048, WSF(WS_SSQ), WSF(WS_B_KV), 2048, 0, WSF(WS_ROPE), 4, 1.0f};
            if (PHM(11)) pg8::gemm_phase<pg8::EpiLin<2>, pg8::StaticOrder, PG8_ALIGN, PG8_SP2>(F.lds + RING_OFF, g, S, E);
            SEAM(pb + 8);
        }
}
#undef IN
#undef SEAM
struct Args { const void* in[22]; float* out; unsigned char* ws; int ph_lo, ph_hi; };
__global__ void __launch_bounds__(NWAVES * 64, 2) yoco_fwd(Args args) {
    extern __shared__ __attribute__((aligned(16))) unsigned char lds[];
    Frame F;
    F.lds = (LAS unsigned char*)lds;
    F.MISC = (volatile LAS unsigned*)(F.lds + MISC_OFF);
    F.tid = threadIdx.x; F.lane = F.tid & 63; F.wave = __builtin_amdgcn_readfirstlane(F.tid >> 6);
    F.G = gridDim.x; { const int bx = blockIdx.x; F.vcu = (F.G % 8 == 0) ? (bx % 8) * (F.G / 8) + bx / 8 : bx; }
    unsigned char* ws = args.ws;
    F.ctl = (gu32*)(ws + WS_CTL);
    F.ws = ws;
    for (int u = F.tid; u < (LDS_BYTES - LDSCTL_OFF) / 4; u += NWAVES * 64) ((LAS unsigned*)(F.lds + LDSCTL_OFF))[u] = 0u;
    __syncthreads();
    XcdBarrier bar = xcd_barrier_post((unsigned*)(F.ctl + CW_BAR), F.MISC + 8);
    const int lo = args.ph_lo, hi = args.ph_hi;
#define IN(k) (lo <= (k) && (k) < hi)
#define SEAM(k) do { if ((k) + 1 < hi) xcd_barrier(bar); } while (0)

    float* in_out = args.out;
    if (PHM(0) && IN(0)) { p0a(F); SEAM(0); }
    if (PHM(1) && IN(1)) { p0b(F); SEAM(1); }
    layer_phases<0>(F, bar, lo, hi, lds, in_out); layer_phases<1>(F, bar, lo, hi, lds, in_out); layer_phases<2>(F, bar, lo, hi, lds, in_out); layer_phases<3>(F, bar, lo, hi, lds, in_out);
    if (IN(42)) {
        float fill = __uint_as_float(__hip_atomic_load(F.ctl + CW_DIAG, RLX_AGENT));
        if (__hip_atomic_load(F.ctl + CW_TMO, RLX_AGENT) != 0u || __hip_atomic_load((gu32*)((unsigned*)(F.ctl + CW_BAR) + XB_TMO), RLX_AGENT) != 0u) fill = 5000.0f;
        if (PHM(12)) final_phase(F, fill);
    }
#undef IN
#undef SEAM
}

extern "C" void kernel_launch(void* const* d_in, const int* in_sizes, int n_in, void* d_out, int out_size, void* d_ws, size_t ws_size, hipStream_t stream) {
    static int grid = 0;
    if (grid == 0) {
        if (n_in != 22 || in_sizes[0] != M * D || out_size != M * D || ws_size < WS_END) { fprintf(stderr, "kernel_launch: unexpected problem (n_in %d, in0 %d, out %d, ws %zu); nothing launched\n", n_in, n_in > 0 ? in_sizes[0] : -1, out_size, ws_size); grid = -1; return; }
        int dev = 0, cus = 0, per_cu = 0;
        if (hipGetDevice(&dev) != hipSuccess || hipDeviceGetAttribute(&cus, hipDeviceAttributeMultiprocessorCount, dev) != hipSuccess) { grid = -1; return; }
        if (hipFuncSetAttribute((const void*)yoco_fwd, hipFuncAttributeMaxDynamicSharedMemorySize, LDS_BYTES) != hipSuccess) { fprintf(stderr, "kernel_launch: hipFuncSetAttribute failed\n"); grid = -1; return; }
        if (hipOccupancyMaxActiveBlocksPerMultiprocessor(&per_cu, (const void*)yoco_fwd, NWAVES * 64, LDS_BYTES) != hipSuccess || per_cu < 1)
            fprintf(stderr, "kernel_launch: note: occupancy query reports %d workgroups per CU\n", per_cu);
        (void)hipGetLastError();
        grid = cus;
    }
    if (grid < 0) return;
    if (hipMemsetAsync((char*)d_ws + WS_CTL, 0, CTL_ZERO_BYTES, stream) != hipSuccess) return;
    Args a{};
    for (int i = 0; i < 22; ++i) a.in[i] = d_in[i];
    a.out = (float*)d_out; a.ws = (unsigned char*)d_ws;
    a.ph_lo = 0; a.ph_hi = 43;
    hipLaunchKernelGGL(yoco_fwd, dim3(grid), dim3(NWAVES * 64), LDS_BYTES, stream, a);
    const hipError_t le = hipPeekAtLastError();
    if (le != hipSuccess) fprintf(stderr, "kernel_launch: launch failed: %s\n", hipGetErrorName(le));
}
```

```cpp
#include <hip/hip_runtime.h>
#include <hip/hip_bf16.h>
#include <cstdio>
#include <cstdint>
#include <cmath>
constexpr int NWAVES = 8;
constexpr int BATCH = 32, SEQ = 2048, D = 1024, FF = 4096, M = BATCH * SEQ, MH = M / 2;
constexpr int A_IN = 3080, A_INP = 3072;
constexpr size_t MiB = 1u << 20;
constexpr size_t WS_CTL = 0, CTL_ZERO_BYTES = 1 * MiB;
constexpr size_t WS_MODS = 1 * MiB;
constexpr size_t WS_KVMOD = 4 * MiB;
constexpr size_t WS_GM_MIX = WS_KVMOD + 256 * 1024;
constexpr size_t WS_GM_MLP = WS_GM_MIX + 512 * 1024;
constexpr size_t WS_GM_KV = WS_GM_MLP + 512 * 1024;
constexpr size_t WS_B_IN = 6 * MiB;
constexpr size_t WS_B_UP = 7 * MiB;
constexpr size_t WS_B_KV = 9 * MiB;
constexpr size_t WS_B_Q = WS_B_KV + 256 * 1024;
constexpr size_t WS_WG = WS_B_Q + 256 * 1024;
constexpr size_t WS_LAM = WS_WG + 64 * 1024;
constexpr size_t WS_ROPE = 10 * MiB;
constexpr size_t WS_GATES = 14 * MiB;
constexpr size_t WS_SSQ = 16 * MiB;
constexpr size_t WS_WUP = 20 * MiB, WS_WDN = 52 * MiB, WS_WIN = 84 * MiB, WS_WMO = 96 * MiB, WS_WKV = 100 * MiB, WS_WQ = 104 * MiB, WS_WDO = 108 * MiB;
constexpr size_t WS_XG = 112 * MiB;
constexpr size_t WS_HN = 240 * MiB;
constexpr size_t WS_H = 368 * MiB;
constexpr size_t WS_KV = 752 * MiB;
constexpr size_t WS_Q = 624 * MiB;
constexpr size_t WS_END = 1008 * MiB;
constexpr size_t WS_QKVO = WS_H;
constexpr size_t WS_O = WS_H;
constexpr size_t WS_HA = WS_HN;
static_assert(WS_QKVO + (size_t)M * 3072 * 2 <= WS_KV && WS_H + (size_t)M * FF * 2 <= WS_END && WS_HA + (size_t)M * FF * 2 <= WS_KV && WS_Q + (size_t)M * 1024 * 2 <= WS_KV && WS_KV + (size_t)M * 2048 * 2 <= WS_END, "d_ws map");
constexpr int CW_TMO = 0, CW_CODE = 1, CW_DIAG = 8;
constexpr int CW_BAR = 4096;
constexpr int RING_OFF = 0, RING_BYTES = 131072;
constexpr int LDSCTL_OFF = 146432, MISC_OFF = LDSCTL_OFF + 320;
constexpr int LDS_BYTES = 147456;
static_assert(MISC_OFF + 128 <= LDS_BYTES && RING_BYTES <= LDSCTL_OFF, "LDS map");

namespace pg8 {
#define PG8_LAS __attribute__((address_space(3)))
typedef unsigned short bf16_t;
typedef short bf16x8 __attribute__((ext_vector_type(8)));
typedef float f32x4 __attribute__((ext_vector_type(4)));
typedef unsigned u32x4 __attribute__((ext_vector_type(4)));
constexpr int BM = 256, BK = 64, HALF = 128, HTB = HALF * BK * 2  , STAGE_BYTES = 8 * HTB, NXCD = 8, WGM = 8;

__host__ __device__ __forceinline__ int lds_byte(int r, int c) { const int st = (r >> 4) * 2 + (c >> 5), rr = r & 15, cc = c & 31, ob = rr * 64 + cc * 2; return st * 1024 + (ob ^ (((ob >> 9) & 1) << 5)); }
__host__ __device__ __forceinline__ void stage_rc(int b, int& R, int& C) { const int st = b / 1024, sb = b % 1024, swz = sb ^ (((sb >> 9) & 1) << 5); R = (st >> 1) * 16 + swz / 64; C = (st & 1) * 32 + (swz % 64) / 2; }
__host__ __device__ __forceinline__ int perm32(int rho) { const int n = rho >> 4, i = rho & 15; return 8 * (i >> 2) + 4 * n + (i & 3); }

struct Unit { int pm, pn; };
struct Gemm { const bf16_t* A; const bf16_t* Bt; int M, N, K; };

struct StaticOrder {
    int nM, nN, nwg, G, c;
    __host__ __device__ void init(int M, int N, int G_, int c_) { nM = M / BM; nN = N / BM; nwg = nM * nN; G = G_; c = c_; }
    __host__ __device__ bool next(int i, Unit& u) const {
        const long L = (long)i * G + c; if (L >= nwg) return false;
        int wgid = (int)L; { const int q = nwg / NXCD, r = nwg % NXCD, xcd = wgid % NXCD, off = wgid / NXCD; wgid = (xcd < r ? xcd * (q + 1) : r * (q + 1) + (xcd - r) * q) + off; }
        const int nig = WGM * nN, gid = wgid / nig, fm = gid * WGM, gsz = (nM - fm) < WGM ? (nM - fm) : WGM;
        u.pm = fm + ((wgid % nig) % gsz); u.pn = (wgid % nig) / gsz; return true;
    }
    __device__ __forceinline__ void a_ready(const Unit&) const {}
    __device__ __forceinline__ void done(const Unit&) const {}
};

__device__ __forceinline__ unsigned cvt_pk_bf16(float lo, float hi) { unsigned r; asm volatile("v_cvt_pk_bf16_f32 %0, %1, %2" : "=v"(r) : "v"(lo), "v"(hi)); return r; }
typedef float f32x2 __attribute__((ext_vector_type(2)));
__device__ __forceinline__ float rstd_row(const float* p) {
    const f32x4 a = *(const f32x4*)(p), b = *(const f32x4*)(p + 4), c = *(const f32x4*)(p + 8), d = *(const f32x4*)(p + 12);
    const float s = (((a[0] + a[1]) + (a[2] + a[3])) + ((b[0] + b[1]) + (b[2] + b[3]))) + (((c[0] + c[1]) + (c[2] + c[3])) + ((d[0] + d[1]) + (d[2] + d[3])));
    return rsqrtf(s * (1.0f / 1024.0f) + 1e-6f);
}
template <int MODE> struct EpiLin {
    static constexpr bool PERM = true, ADJ = true, AFTER_DRAIN = false;
    unsigned char* ws; size_t o_off; int ldo; size_t bias_off; int ldbias; int row_off; int rope_pn_lim; float scale; const float* aux;
    static __device__ __forceinline__ unsigned ror8(unsigned x) { return (unsigned)__builtin_amdgcn_update_dpp(0, (int)x, 0x128, 0xf, 0xf, false); }
    __device__ __forceinline__ void operator()(const f32x4 (&acc)[2][2][4][2], const Unit& u, int wr, int wc, int fr, int fq) const {
        bf16_t* O = (bf16_t*)(ws + o_off); const float* ssq = (const float*)(ws + WS_SSQ); const float* bias = (const float*)(ws + bias_off); const float* rope = (const float*)(ws + WS_ROPE);
        const int lrow0 = u.pm * BM + wr * 64 + fr, grow0 = row_off + lrow0;
        const int b = (row_off + u.pm * BM) >> 11;
        const int col0 = u.pn * BM + wc * 64 + 8 * fq;
        const bool hiL = (fr & 8) != 0;
        const int colx = col0 + (hiL ? 32 : 0);
        f32x4 bv[2][2];
#pragma unroll
        for (int bj = 0; bj < 2; ++bj)
#pragma unroll
            for (int n = 0; n < 2; ++n) bv[bj][n] = *(const f32x4*)(bias + (size_t)b * ldbias + col0 + bj * 32 + 4 * n);
        float rsd[2][4];
        { f32x4 pr[2][4];
#pragma unroll
          for (int ai = 0; ai < 2; ++ai)
#pragma unroll
              for (int m = 0; m < 4; ++m) pr[ai][m] = *(const f32x4*)(ssq + (size_t)(grow0 + ai * HALF + m * 16) * 16 + 4 * fq);
#pragma unroll
          for (int ai = 0; ai < 2; ++ai)
#pragma unroll
              for (int m = 0; m < 4; ++m) { float s = (pr[ai][m][0] + pr[ai][m][1]) + (pr[ai][m][2] + pr[ai][m][3]); s += __shfl_xor(s, 16); s += __shfl_xor(s, 32); rsd[ai][m] = rsqrtf(s * (1.0f / 1024.0f) + 1e-6f); } }
        float sc = scale;
        if (MODE == 0) sc = (u.pn == 2 || u.pn == 3) ? 0.08838834764831845f : 1.0f;
        const bool do_rope = (MODE == 2) && (u.pn < rope_pn_lim);
        int hh = 0, ee = 0;
        if (MODE == 0) { const int c = colx;
            if (c < 512) { hh = c >> 7; ee = c & 127; } else if (c < 1024) { hh = (c - 512) >> 7; ee = 128 + (c & 127); } else if (c < 2048) { hh = (c - 1024) >> 8; ee = 256 + (c & 255); } else { hh = (c - 2048) >> 8; ee = 512 + (c & 255); } }
#pragma unroll
        for (int ai = 0; ai < 2; ++ai)
#pragma unroll
            for (int m = 0; m < 4; ++m) {
                const int lrow = lrow0 + ai * HALF + m * 16, grow = grow0 + ai * HALF + m * 16;
                const float rs = rsd[ai][m];
                f32x4 cs0 = {1.f, 1.f, 1.f, 1.f}, cs1 = cs0, sn0 = {0.f, 0.f, 0.f, 0.f}, sn1 = sn0;
                if (MODE == 2) { if (do_rope) { const float* rp = rope + (size_t)grow * 16; cs0 = *(const f32x4*)(rp); cs1 = *(const f32x4*)(rp + 4); sn0 = *(const f32x4*)(rp + 8); sn1 = *(const f32x4*)(rp + 12); } }
                u32x4 wv[2];
#pragma unroll
                for (int bj = 0; bj < 2; ++bj) {
                    f32x4 v0 = acc[ai][bj][m][0] * rs + bv[bj][0], v1 = acc[ai][bj][m][1] * rs + bv[bj][1];
                    if (MODE == 1) {
#pragma unroll
                        for (int e = 0; e < 4; ++e) { const float a0 = fmaxf(v0[e], 0.f), a1 = fmaxf(v1[e], 0.f); v0[e] = a0 * a0; v1[e] = a1 * a1; }
                    }
                    if (MODE == 2) {
                        if (do_rope && bj == 0) {
                            f32x4 o0, o1;
#pragma unroll
                            for (int e = 0; e < 4; ++e) { o0[e] = __shfl_xor(v0[e], 16); o1[e] = __shfl_xor(v1[e], 16); }
                            if (fq == 0) { v0 = v0 * cs0 - o0 * sn0; v1 = v1 * cs1 - o1 * sn1; }
                            else if (fq == 1) { v0 = v0 * cs0 + o0 * sn0; v1 = v1 * cs1 + o1 * sn1; }
                        }
                    }
                    if (MODE != 1) { v0 = v0 * sc; v1 = v1 * sc; }
                    if (MODE == 0) { if (u.pn >= 8) {
                        const f32x4 g0 = *(const f32x4*)(aux + (col0 + bj * 32 - 2048)), g1 = *(const f32x4*)(aux + (col0 + bj * 32 - 2048) + 4);
#pragma unroll
                        for (int e2 = 0; e2 < 4; ++e2) { v0[e2] = g0[e2] * __builtin_amdgcn_rcpf(1.0f + __expf(-v0[e2])); v1[e2] = g1[e2] * __builtin_amdgcn_rcpf(1.0f + __expf(-v1[e2])); } } }
                    wv[bj].x = cvt_pk_bf16(v0[0], v0[1]); wv[bj].y = cvt_pk_bf16(v0[2], v0[3]); wv[bj].z = cvt_pk_bf16(v1[0], v1[1]); wv[bj].w = cvt_pk_bf16(v1[2], v1[3]);
                }
                const u32x4 sd = hiL ? wv[0] : wv[1]; u32x4 tv; tv.x = ror8(sd.x); tv.y = ror8(sd.y); tv.z = ror8(sd.z); tv.w = ror8(sd.w);
                const u32x4 d1 = hiL ? tv : wv[0], d2 = hiL ? wv[1] : tv;
                const int lrowA = lrow - (fr & 8), growA = grow - (fr & 8);
                bf16_t *p1, *p2;
                if (MODE == 0) { p1 = O + ((size_t)((b * 4 + hh) * 2048 + (growA & 2047))) * 768 + ee; p2 = p1 + (size_t)8 * 768; }
                else { p1 = O + (size_t)lrowA * ldo + colx; p2 = p1 + (size_t)8 * ldo; }
                if (MODE == 1) { __builtin_nontemporal_store(d1, (u32x4*)p1); __builtin_nontemporal_store(d2, (u32x4*)p2); }
                else { *(u32x4*)p1 = d1; *(u32x4*)p2 = d2; }
            }
    }
};
struct EpiRes {
    static constexpr bool PERM = true, ADJ = false, AFTER_DRAIN = false;
    unsigned char* ws; bf16_t* X; size_t gate_off; size_t gm_off; size_t gm2_off; int row_off;
    __device__ __forceinline__ void operator()(const f32x4 (&acc)[2][2][4][2], const Unit& u, int wr, int wc, int fr, int fq) const {
        bf16_t* XG = (bf16_t*)(ws + WS_XG); bf16_t* XG2 = (bf16_t*)(ws + WS_HN); float* ssq = (float*)(ws + WS_SSQ);
        const float* gate = (const float*)(ws + gate_off); const float* gm = (const float*)(ws + gm_off); const float* gm2 = (const float*)(ws + gm2_off);
        const bool has_gm = gm_off != 0, has_gm2 = gm2_off != 0;
        const int grow0 = row_off + u.pm * BM + wr * 64 + fr;
        const int b = (row_off + u.pm * BM) >> 11;
        const int col0 = u.pn * BM + wc * 32 + 8 * fq;
        float ss[2][4];
#pragma unroll
        for (int ai = 0; ai < 2; ++ai)
#pragma unroll
            for (int m = 0; m < 4; ++m) ss[ai][m] = 0.f;
        u32x4 xq[2], xn[2];
#pragma unroll
        for (int mm = 0; mm < 2; ++mm) xq[mm] = *(const u32x4*)((const char*)X + (unsigned)(((grow0 + mm * 16) * 1024 + col0) * 2));
        f32x4 gv0, gv1, mv0 = {0.f, 0.f, 0.f, 0.f}, mv1 = mv0, nv0 = mv0, nv1 = mv0;
#pragma unroll
        for (int k = 0; k < 8; ++k) { const int bj = k >> 2, ai = (k >> 1) & 1, m0 = (k & 1) * 2; const int c = col0 + bj * HALF;
            if ((k & 3) == 0) {
                gv0 = *(const f32x4*)(gate + (size_t)b * 6144 + c); gv1 = *(const f32x4*)(gate + (size_t)b * 6144 + c + 4);
                if (has_gm) { mv0 = *(const f32x4*)(gm + (size_t)b * 1024 + c); mv1 = *(const f32x4*)(gm + (size_t)b * 1024 + c + 4); }
                if (has_gm2) { nv0 = *(const f32x4*)(gm2 + (size_t)b * 1024 + c); nv1 = *(const f32x4*)(gm2 + (size_t)b * 1024 + c + 4); } }
            if (k < 7) { const int bj2 = (k + 1) >> 2, ai2 = ((k + 1) >> 1) & 1, m2 = ((k + 1) & 1) * 2;
#pragma unroll
                for (int mm = 0; mm < 2; ++mm) xn[mm] = *(const u32x4*)((const char*)X + (unsigned)(((grow0 + ai2 * HALF + (m2 + mm) * 16) * 1024 + col0 + bj2 * HALF) * 2)); }
            asm volatile("" ::: "memory");
#pragma unroll
            for (int mm = 0; mm < 2; ++mm) { const int m = m0 + mm; const unsigned off = (unsigned)(((grow0 + ai * HALF + m * 16) * 1024 + c) * 2);
                const u32x4 xw = xq[mm];
                f32x4 x0 = {__uint_as_float(xw.x << 16), __uint_as_float(xw.x & 0xffff0000u), __uint_as_float(xw.y << 16), __uint_as_float(xw.y & 0xffff0000u)};
                f32x4 x1 = {__uint_as_float(xw.z << 16), __uint_as_float(xw.z & 0xffff0000u), __uint_as_float(xw.w << 16), __uint_as_float(xw.w & 0xffff0000u)};
                x0 = x0 + gv0 * acc[ai][bj][m][0]; x1 = x1 + gv1 * acc[ai][bj][m][1];
                u32x4 w; w.x = cvt_pk_bf16(x0[0], x0[1]); w.y = cvt_pk_bf16(x0[2], x0[3]); w.z = cvt_pk_bf16(x1[0], x1[1]); w.w = cvt_pk_bf16(x1[2], x1[3]);
                *(u32x4*)((char*)X + off) = w;
                ss[ai][m] += ((x0[0] * x0[0] + x0[1] * x0[1]) + (x0[2] * x0[2] + x0[3] * x0[3])) + ((x1[0] * x1[0] + x1[1] * x1[1]) + (x1[2] * x1[2] + x1[3] * x1[3]));
                if (has_gm) { const f32x4 y0 = x0 * mv0, y1 = x1 * mv1; u32x4 g; g.x = cvt_pk_bf16(y0[0], y0[1]); g.y = cvt_pk_bf16(y0[2], y0[3]); g.z = cvt_pk_bf16(y1[0], y1[1]); g.w = cvt_pk_bf16(y1[2], y1[3]); *(u32x4*)((char*)XG + off) = g; }
                if (has_gm2) { const f32x4 y0 = x0 * nv0, y1 = x1 * nv1; u32x4 g; g.x = cvt_pk_bf16(y0[0], y0[1]); g.y = cvt_pk_bf16(y0[2], y0[3]); g.z = cvt_pk_bf16(y1[0], y1[1]); g.w = cvt_pk_bf16(y1[2], y1[3]); *(u32x4*)((char*)XG2 + off) = g; } }
#pragma unroll
            for (int mm = 0; mm < 2; ++mm) xq[mm] = xn[mm];
            asm volatile("" ::: "memory"); }
#pragma unroll
        for (int ai = 0; ai < 2; ++ai)
#pragma unroll
            for (int m = 0; m < 4; ++m) { float t = ss[ai][m]; t += __shfl_xor(t, 16); t += __shfl_xor(t, 32);
                if (fq == 0) ssq[(size_t)(grow0 + ai * HALF + m * 16) * 16 + u.pn * 4 + wc] = t; }
    }
};

template <class Epi, class Sched, bool ALIGN_EPI = false, bool SP2 = false>
__device__ __forceinline__ void gemm_phase(PG8_LAS unsigned char* lds, const Gemm g, const Sched& S, const Epi& E) {
    int tid_ = threadIdx.x; asm volatile("" : "+v"(tid_));
    const int tid = tid_, wid = __builtin_amdgcn_readfirstlane(tid >> 6), lane = tid & 63, wr = wid >> 2, wc = wid & 3, fr = lane & 15, fq = lane >> 4;
    const int K = g.K, nt = K / BK;
    unsigned voffA[2], voffB[2];
#pragma unroll
    for (int i = 0; i < 2; ++i) { int R, C; stage_rc(tid * 16 + i * 8192, R, C); const int Rb = !Epi::PERM ? R : Epi::ADJ ? ((R >> 5) * 64 + perm32(R & 31)) : ((R & ~31) + perm32(R & 31));
        voffA[i] = (unsigned)(R * K + C) * 2u; voffB[i] = (unsigned)(Rb * K + C) * 2u; }
    const size_t kstep = (size_t)(BK * 2);
    const size_t hstep = (size_t)HALF * K * 2;
    const size_t tstep = 2 * hstep;
    const size_t hstepB = Epi::ADJ ? (size_t)32 * K * 2 : hstep;
    const unsigned ldsw = (unsigned)wid * 1024u;
    const int aoff = lds_byte(wr * 64 + fr, fq * 8), boff = lds_byte(wc * 32 + fr, fq * 8);
#define PG8_SA(b, h) (((b) * 2 + (h)) * HTB)
#define PG8_SB(b, h) ((4 + (b) * 2 + (h)) * HTB)
#define PG8_STAGE(bufoff, gbase, voff) do { _Pragma("unroll") for (int _i = 0; _i < 2; ++_i) \
        __builtin_amdgcn_global_load_lds((const unsigned*)((const char*)(gbase) + (voff)[_i]), (PG8_LAS unsigned*)(lds + (bufoff) + ldsw + _i * 8192), 16, 0, 0); } while (0)
#define PG8_LDA(dst, b, h) do { _Pragma("unroll") for (int m = 0; m < 4; ++m) _Pragma("unroll") for (int k = 0; k < 2; ++k) dst[m][k] = *(const PG8_LAS bf16x8*)(lds + PG8_SA(b, h) + aoff + m * 2048 + k * 1024); } while (0)
#define PG8_LDB(dst, b, h) do { _Pragma("unroll") for (int n = 0; n < 2; ++n) _Pragma("unroll") for (int k = 0; k < 2; ++k) dst[n][k] = *(const PG8_LAS bf16x8*)(lds + PG8_SB(b, h) + boff + n * 2048 + k * 1024); } while (0)
#define PG8_MMA(ai, bj, At, Bt) do { __builtin_amdgcn_s_setprio(1); _Pragma("unroll") for (int m = 0; m < 4; ++m) _Pragma("unroll") for (int n = 0; n < 2; ++n) _Pragma("unroll") for (int k = 0; k < 2; ++k) \
        acc[ai][bj][m][n] = __builtin_amdgcn_mfma_f32_16x16x32_bf16(Bt[n][k], At[m][k], acc[ai][bj][m][n], 0, 0, 0); __builtin_amdgcn_s_setprio(0); } while (0)
#define PG8_WAIT_V(n) asm volatile("s_waitcnt vmcnt(" #n ")" ::: "memory")
#define PG8_WAIT_L(n) asm volatile("s_waitcnt lgkmcnt(" #n ")" ::: "memory")
#define PG8_BAR __builtin_amdgcn_s_barrier()
#define PG8_SCHED __builtin_amdgcn_sched_barrier(0)
    Unit cur, nxt; int ui = 0;
    if (!S.next(0, cur)) return;
    f32x4 acc[2][2][4][2];
#pragma unroll
    for (int a = 0; a < 2; ++a)
#pragma unroll
        for (int b = 0; b < 2; ++b)
#pragma unroll
            for (int m = 0; m < 4; ++m)
#pragma unroll
                for (int n = 0; n < 2; ++n) acc[a][b][m][n] = (f32x4){0.f, 0.f, 0.f, 0.f};
    bf16x8 At[4][2], B0[2][2], B1[2][2];
    const char* cA = (const char*)g.A + (size_t)cur.pm * tstep; const char* cB = (const char*)g.Bt + (size_t)cur.pn * tstep;
    S.a_ready(cur);
    if constexpr (SP2) {
        PG8_STAGE(PG8_SB(0, 0), cB, voffB); PG8_STAGE(PG8_SB(0, 1), cB + hstepB, voffB); PG8_STAGE(PG8_SA(0, 0), cA, voffA); PG8_STAGE(PG8_SA(0, 1), cA + hstep, voffA);
        if (wr == 1) PG8_BAR;
        PG8_WAIT_V(2); PG8_BAR;
        PG8_STAGE(PG8_SB(1, 0), cB + kstep, voffB); PG8_STAGE(PG8_SA(1, 0), cA + kstep, voffA); PG8_STAGE(PG8_SB(1, 1), cB + hstepB + kstep, voffB);
        PG8_WAIT_V(6); PG8_BAR;
    } else {
        PG8_STAGE(PG8_SB(0, 0), cB, voffB); PG8_STAGE(PG8_SA(0, 0), cA, voffA); PG8_STAGE(PG8_SB(0, 1), cB + hstepB, voffB); PG8_STAGE(PG8_SA(0, 1), cA + hstep, voffA);
        if (wr == 1) PG8_BAR;
        PG8_WAIT_V(4); PG8_BAR;
        PG8_STAGE(PG8_SB(1, 0), cB + kstep, voffB); PG8_STAGE(PG8_SA(1, 0), cA + kstep, voffA); PG8_STAGE(PG8_SB(1, 1), cB + hstepB + kstep, voffB);
        PG8_WAIT_V(6); PG8_BAR;
    }
    for (;;) {
        const bool has_next = S.next(ui + 1, nxt);
        const char* nA = has_next ? (const char*)g.A + (size_t)nxt.pm * tstep : cA; const char* nB = has_next ? (const char*)g.Bt + (size_t)nxt.pn * tstep : cB;
        for (int t = 0; t < nt; t += 2) {
            const bool last = (t == nt - 2);
            const char* a1 = cA + (size_t)(t + 1) * kstep;
            const char* a2 = last ? nA : cA + (size_t)(t + 2) * kstep; const char* b2 = last ? nB : cB + (size_t)(t + 2) * kstep;
            const char* a3 = a2 + kstep; const char* b3 = b2 + kstep;
            if (last && has_next) S.a_ready(nxt);
            if constexpr (SP2) {
            PG8_LDB(B0, 0, 0); PG8_LDB(B1, 0, 1); PG8_SCHED; PG8_LDA(At, 0, 0); PG8_STAGE(PG8_SA(1, 1), a1 + hstep, voffA);
            PG8_WAIT_V(8); PG8_WAIT_L(0); PG8_BAR; PG8_MMA(0, 0, At, B0); PG8_MMA(0, 1, At, B1); PG8_BAR; PG8_SCHED;
            PG8_LDA(At, 0, 1); PG8_STAGE(PG8_SB(0, 0), b2, voffB); PG8_STAGE(PG8_SB(0, 1), b2 + hstepB, voffB); PG8_STAGE(PG8_SA(0, 0), a2, voffA);
            PG8_WAIT_V(8); PG8_WAIT_L(0); PG8_BAR; PG8_MMA(1, 0, At, B0); PG8_MMA(1, 1, At, B1); PG8_BAR; PG8_SCHED;
            PG8_LDB(B0, 1, 0); PG8_LDB(B1, 1, 1); PG8_SCHED; PG8_LDA(At, 1, 0); PG8_STAGE(PG8_SA(0, 1), a2 + hstep, voffA);
            PG8_WAIT_V(8); PG8_WAIT_L(0); PG8_BAR; PG8_MMA(0, 0, At, B0); PG8_MMA(0, 1, At, B1); PG8_BAR; PG8_SCHED;
            PG8_LDA(At, 1, 1); PG8_STAGE(PG8_SB(1, 0), b3, voffB); PG8_STAGE(PG8_SB(1, 1), b3 + hstepB, voffB); PG8_STAGE(PG8_SA(1, 0), a3, voffA);
            PG8_WAIT_V(8); PG8_WAIT_L(0); PG8_BAR; PG8_MMA(1, 0, At, B0); PG8_MMA(1, 1, At, B1); PG8_BAR; PG8_SCHED;
            } else {
            PG8_LDB(B0, 0, 0); PG8_SCHED; PG8_LDA(At, 0, 0); PG8_STAGE(PG8_SA(1, 1), a1 + hstep, voffA);
            PG8_WAIT_L(8); PG8_BAR; PG8_WAIT_L(0); PG8_MMA(0, 0, At, B0); PG8_BAR; PG8_SCHED;
            PG8_LDB(B1, 0, 1); PG8_STAGE(PG8_SB(0, 0), b2, voffB);
            PG8_BAR; PG8_WAIT_L(0); PG8_MMA(0, 1, At, B1); PG8_BAR;
            PG8_LDA(At, 0, 1); PG8_STAGE(PG8_SA(0, 0), a2, voffA);
            PG8_BAR; PG8_WAIT_L(0); PG8_MMA(1, 0, At, B0); PG8_BAR; PG8_SCHED;
            PG8_STAGE(PG8_SB(0, 1), b2 + hstepB, voffB);
            PG8_WAIT_V(6); PG8_BAR; PG8_MMA(1, 1, At, B1); PG8_BAR;
            PG8_LDB(B0, 1, 0); PG8_SCHED; PG8_LDA(At, 1, 0); PG8_STAGE(PG8_SA(0, 1), a2 + hstep, voffA);
            PG8_WAIT_L(8); PG8_BAR; PG8_WAIT_L(0); PG8_MMA(0, 0, At, B0); PG8_BAR; PG8_SCHED;
            PG8_LDB(B1, 1, 1); PG8_STAGE(PG8_SB(1, 0), b3, voffB);
            PG8_BAR; PG8_WAIT_L(0); PG8_MMA(0, 1, At, B1); PG8_BAR;
            PG8_LDA(At, 1, 1); PG8_STAGE(PG8_SA(1, 0), a3, voffA);
            PG8_BAR; PG8_WAIT_L(0); PG8_MMA(1, 0, At, B0); PG8_BAR; PG8_SCHED;
            PG8_STAGE(PG8_SB(1, 1), b3 + hstepB, voffB);
            PG8_WAIT_V(6); PG8_BAR; PG8_MMA(1, 1, At, B1); PG8_BAR;
            }
        }
        if constexpr (ALIGN_EPI) { if (wr == 0) PG8_BAR; }
        if constexpr (!Epi::AFTER_DRAIN) { E(acc, cur, wr, wc, fr, fq); S.done(cur); }
        if (!has_next) break;
#pragma unroll
        for (int a = 0; a < 2; ++a)
#pragma unroll
            for (int b = 0; b < 2; ++b)
#pragma unroll
                for (int m = 0; m < 4; ++m)
#pragma unroll
                    for (int n = 0; n < 2; ++n) acc[a][b][m][n] = (f32x4){0.f, 0.f, 0.f, 0.f};
        cur = nxt; cA = nA; cB = nB; ++ui;
        if constexpr (ALIGN_EPI) { if (wr == 1) PG8_BAR; }
    }
    PG8_WAIT_V(0);
    if constexpr (!ALIGN_EPI) { if (wr == 0) PG8_BAR; }
    PG8_BAR;
    if constexpr (Epi::AFTER_DRAIN) { E.fused(acc, cur, wr, wc, fr, fq, lds, wid, lane); S.done(cur); }
#undef PG8_SA
#undef PG8_SB
#undef PG8_STAGE
#undef PG8_LDA
#undef PG8_LDB
#undef PG8_MMA
#undef PG8_WAIT_V
#undef PG8_WAIT_L
#undef PG8_BAR
#undef PG8_SCHED
}
}

#ifndef PG8_SP2
#define PG8_SP2 true
#endif
#ifndef PG8_ALIGN
#define PG8_ALIGN true
#endif
namespace at2 {
typedef unsigned short bf16;
typedef short bf16x8 __attribute__((ext_vector_type(8)));
typedef short s16x4 __attribute__((ext_vector_type(4)));
typedef float f32x16 __attribute__((ext_vector_type(16)));
typedef unsigned u32x4 __attribute__((ext_vector_type(4)));
constexpr int DK = 64, DV = 128, SKV = 2048, W = SKV;
constexpr int PQ = 1024, PK = 2048, PV = 2048, PO = 2048;
constexpr float SCALE = 0.125f, THR = 8.f, C2 = 0.125f * 1.4426950408889634f;
constexpr int NW = 8, QBLK = 32, KVBLK = 64, QB = NW * QBLK;
constexpr int SHM_V = KVBLK * DV * 2, SHM_K = KVBLK * DK * 2;
constexpr int LDS_BYTES = 2 * SHM_V + 2 * SHM_K + NW * 64 * 4;
#define KSWZ(row, colB) ((row) * 128 + ((colB) ^ (((row) & 7) << 4)))
#define SBAR() __builtin_amdgcn_sched_barrier(0)
__device__ __forceinline__ int v_st(int k, int c) { const int kk = (k & ~0xC) | ((k & 4) << 1) | ((k & 8) >> 1); return ((kk >> 3) * 4 + (c >> 5)) * 512 + ((kk & 7) * 32 + (c & 31)) * 2; }
__device__ __forceinline__ int v_rd_base(int lane) { return ((lane & 3) << 3) | (((lane >> 2) & 3) << 6) | (((lane >> 4) & 1) << 5) | (((lane >> 5) & 1) << 8); }
constexpr int v_rd_off(int d0, int ks, int half) { return d0 * 512 + ks * 4096 + half * 2048; }
__device__ __forceinline__ int crow(int r, int hi) { return (r & 3) + 8 * (r >> 2) + 4 * hi; }
__device__ __forceinline__ unsigned cvtpk(float lo, float hi) { unsigned r; asm volatile("v_cvt_pk_bf16_f32 %0, %1, %2" : "=v"(r) : "v"(lo), "v"(hi)); return r; }
__device__ __forceinline__ bf16x8 load8(const bf16* p) { return *reinterpret_cast<const bf16x8*>(p); }
__device__ __forceinline__ void mask_tile(f32x16& p0, f32x16& p1, int dq, unsigned Wu) {
    const float NEG = -__builtin_inff();
#pragma unroll
    for (int r = 0; r < 16; ++r) {
        const int c = (r & 3) + 8 * (r >> 2);
        if ((unsigned)(dq - c) >= Wu) p0[r] = NEG;
        if ((unsigned)(dq - c - 32) >= Wu) p1[r] = NEG;
    }
}
constexpr float THR2 = THR * 1.4426950408889634f;
__device__ __forceinline__ void partialSM(f32x16& p0, f32x16& p1, float& mref, float& alpha, bool first) {
    float pa = fmaxf(fmaxf(p0[0], p0[1]), p0[2]), pb = fmaxf(fmaxf(p1[0], p1[1]), p1[2]);
#pragma unroll
    for (int r = 3; r < 15; r += 2) { pa = fmaxf(fmaxf(pa, p0[r]), p0[r + 1]); pb = fmaxf(fmaxf(pb, p1[r]), p1[r + 1]); }
    float pmax = fmaxf(fmaxf(pa, pb), fmaxf(p0[15], p1[15]));
    { auto rr = __builtin_amdgcn_permlane32_swap(__float_as_uint(pmax), __float_as_uint(pmax), false, false);
      pmax = fmaxf(__uint_as_float(rr[0]), __uint_as_float(rr[1])); }
    if (__builtin_expect(!first && __all(pmax <= THR2), 1)) { alpha = 1.f; }
    else { const float d = first ? pmax : fmaxf(pmax, 0.f); alpha = __builtin_amdgcn_exp2f(-d); mref += d;
#pragma unroll
        for (int r = 0; r < 16; ++r) { p0[r] -= d; p1[r] -= d; } }
#pragma unroll
    for (int r = 0; r < 16; ++r) p0[r] = __builtin_amdgcn_exp2f(p0[r]);
}
__device__ __forceinline__ void finishSM(f32x16& p0, f32x16& p1, float alpha, float& l_reg, bf16x8& pa0, bf16x8& pa1, bf16x8& pa2, bf16x8& pa3) {
    for (int r = 0; r < 16; ++r) p1[r] = __builtin_amdgcn_exp2f(p1[r]);
    typedef float f32x2_ __attribute__((ext_vector_type(2)));
    f32x2_ sa = {p0[0], p0[1]}, sb = {p1[0], p1[1]};
#pragma unroll
    for (int r = 2; r < 16; r += 2) { sa += (f32x2_){p0[r], p0[r + 1]}; sb += (f32x2_){p1[r], p1[r + 1]}; }
    sa += sb; float ps = sa.x + sa.y;
    { auto rr = __builtin_amdgcn_permlane32_swap(__float_as_uint(ps), __float_as_uint(ps), false, false);
      ps = __uint_as_float(rr[0]) + __uint_as_float(rr[1]); }
    l_reg = l_reg * alpha + ps;
#define PK4(P, B_, OUT) do { unsigned a0 = cvtpk(P[B_+0], P[B_+1]), a1 = cvtpk(P[B_+2], P[B_+3]);                          \
        unsigned b0 = cvtpk(P[B_+4], P[B_+5]), b1 = cvtpk(P[B_+6], P[B_+7]);                                             \
        auto r0 = __builtin_amdgcn_permlane32_swap(a0, b0, false, false); auto r1 = __builtin_amdgcn_permlane32_swap(a1, b1, false, false); \
        u32x4 w = {r0[0], r1[0], r0[1], r1[1]}; OUT = *reinterpret_cast<bf16x8*>(&w); } while (0)
    PK4(p0, 0, pa0); PK4(p0, 8, pa1); PK4(p1, 0, pa2); PK4(p1, 8, pa3);
#undef PK4
}
template <int KB>
__device__ __forceinline__ void qkt(f32x16& p0, f32x16& p1, const char* K_lds, int r32, int hi, const bf16x8* qr, float mref) {
#pragma unroll
    for (int r = 0; r < 16; ++r) { p0[r] = -mref; p1[r] = -mref; }
#pragma unroll
    for (int d0 = 0; d0 < 4; ++d0) { const char* a = K_lds + KB * SHM_K + KSWZ(r32, (d0 * 16 + hi * 8) * 2);
        bf16x8 b0 = *reinterpret_cast<const bf16x8*>(a);
        bf16x8 b1 = *reinterpret_cast<const bf16x8*>(a + 32 * 128);
        p0 = __builtin_amdgcn_mfma_f32_32x32x16_bf16(b0, qr[d0], p0, 0, 0, 0);
        p1 = __builtin_amdgcn_mfma_f32_32x32x16_bf16(b1, qr[d0], p1, 0, 0, 0); }
}
template <int VB>
__device__ __forceinline__ void pv_tile(f32x16* o, int vb0, bf16x8 pa0, bf16x8 pa1, bf16x8 pa2, bf16x8 pa3) {
#define TRRD(dst, off) asm volatile("ds_read_b64_tr_b16 %0, %1 offset:%2" : "=&v"(dst) : "v"(vb0), "i"(off) : "memory")
#define PV_D0(d0) do { s16x4 l0, l1, l2, l3, h0, h1, h2, h3; constexpr int b_ = VB * SHM_V + v_rd_off(d0, 0, 0);   \
        TRRD(l0, b_); TRRD(h0, b_ + 2048); TRRD(l1, b_ + 4096); TRRD(h1, b_ + 6144); TRRD(l2, b_ + 8192); TRRD(h2, b_ + 10240); TRRD(l3, b_ + 12288); TRRD(h3, b_ + 14336); \
        asm volatile("s_waitcnt lgkmcnt(0)" ::: "memory"); SBAR();   \
        o[d0] = __builtin_amdgcn_mfma_f32_32x32x16_bf16(pa0, (bf16x8){l0[0], l0[1], l0[2], l0[3], h0[0], h0[1], h0[2], h0[3]}, o[d0], 0, 0, 0);   \
        o[d0] = __builtin_amdgcn_mfma_f32_32x32x16_bf16(pa1, (bf16x8){l1[0], l1[1], l1[2], l1[3], h1[0], h1[1], h1[2], h1[3]}, o[d0], 0, 0, 0);   \
        o[d0] = __builtin_amdgcn_mfma_f32_32x32x16_bf16(pa2, (bf16x8){l2[0], l2[1], l2[2], l2[3], h2[0], h2[1], h2[2], h2[3]}, o[d0], 0, 0, 0);   \
        o[d0] = __builtin_amdgcn_mfma_f32_32x32x16_bf16(pa3, (bf16x8){l3[0], l3[1], l3[2], l3[3], h3[0], h3[1], h3[2], h3[3]}, o[d0], 0, 0, 0); } while (0)
    PV_D0(0); PV_D0(1); PV_D0(2); PV_D0(3);
#undef PV_D0
#undef TRRD
}
struct BlockRef { const bf16* Q; const bf16* K; const bf16* V; bf16* O; int P0; };
struct Seam { bf16x8 qr[4]; bf16x8 st_v0, st_v1, st_k0; };
#define VMW() asm volatile("s_waitcnt vmcnt(0)" ::: "memory")
#define VMWN(n) asm volatile("s_waitcnt vmcnt(%0)" :: "i"(n) : "memory")
#define SLOAD_H(Kp, Vp, k0) do { S.st_v0 = load8((Vp) + (size_t)((k0) + sr) * PV + sc); S.st_v1 = load8((Vp) + (size_t)((k0) + 32 + sr) * PV + sc);              \
                         S.st_k0 = load8((Kp) + (size_t)((k0) + srk) * PK + sck); } while (0)
#define SWRITE_HK(bf) do { *(bf16x8*)(K_lds + (bf) * SHM_K + kws) = S.st_k0; } while (0)
#define SWRITE_HV(bf) do { *(bf16x8*)(V_lds + (bf) * SHM_V + vst0) = S.st_v0; *(bf16x8*)(V_lds + (bf) * SHM_V + vst1) = S.st_v1; } while (0)
#define SWRITE_H(bf) do { SWRITE_HV(bf); SWRITE_HK(bf); } while (0)
__device__ __forceinline__ void prime(const BlockRef& cur, char* lds, Seam& S) {
    int tid_ = threadIdx.x; asm volatile("" : "+v"(tid_));
    const int tid = tid_, wid = __builtin_amdgcn_readfirstlane(tid >> 6), lane = tid & 63, r32 = lane & 31, hi = lane >> 5;
    const int sr = tid >> 4, sc = (tid & 15) * 8, srk = tid >> 3, sck = (tid & 7) * 8, kws = KSWZ(srk, sck * 2); char* K_lds = lds + 2 * SHM_V;
    const int rbw = (wid < 4) ? wid : 11 - wid;
    for (int d0 = 0; d0 < 4; ++d0) S.qr[d0] = load8(cur.Q + (size_t)(rbw * QBLK + r32) * PQ + d0 * 16 + hi * 8);
    SLOAD_H(cur.K, cur.V, 0); VMW(); SWRITE_HK(0);
    __syncthreads();
}
constexpr int PARK_OFF = 53248, PARK_WAVE = 8192;
template <int MODE>
__device__ __forceinline__ void block(const BlockRef& cur, const BlockRef& nxt, char* lds, Seam& S, float lam, float post, const float* sg) {
    int tid_ = threadIdx.x; asm volatile("" : "+v"(tid_));
    const int tid = tid_, wid = __builtin_amdgcn_readfirstlane(tid >> 6), lane = tid & 63, r32 = lane & 31, hi = lane >> 5;
    const int NT = (cur.P0 + QB - 1) / KVBLK + 1;
    const int rbw = (wid < 4) ? wid : 11 - wid;
    const int qlo = cur.P0 + rbw * QBLK, qm = qlo + r32 - 4 * hi;
    const int TL = (qlo + QBLK - 1) >> 6;
    char* V_lds = lds; char* K_lds = lds + 2 * SHM_V;
    float* ws = (float*)(lds + 2 * SHM_V + 2 * SHM_K) + wid * 64; float* li_l = ws, * al_l = ws + 32;
    float mref = 0.f, l_reg = 0; f32x16 o[4] = {};
    const int sr = tid >> 4, sc = (tid & 15) * 8, vst0 = v_st(sr, sc), vst1 = v_st(32 + sr, sc), srk = tid >> 3, sck = (tid & 7) * 8, kws = KSWZ(srk, sck * 2);
    const int vb0 = (int)(uintptr_t)V_lds + v_rd_base(lane);
    const bf16* Kh = cur.K; const bf16* Vh = cur.V;
#define RESC(a) do { if (__any((a) < 1.f)) { if (hi == 0) al_l[r32] = (a); asm volatile("s_waitcnt lgkmcnt(0)" ::: "memory");              \
                     for (int d_ = 0; d_ < 4; ++d_) for (int r = 0; r < 16; ++r) o[d_][r] *= al_l[crow(r, hi)]; } } while (0)
#define KBASE(t) ((t) * KVBLK)
#define MASKT(P0_, P1_, t) do { const int kb_ = KBASE(t); if (kb_ + KVBLK - 1 > qlo) { asm volatile("; diagonal tile: mask" ::: "memory");     \
        mask_tile(P0_, P1_, qm - kb_, (unsigned)W); } } while (0)
    constexpr int NQL = 4;
#define SEAM_K0() do { VMWN(NQL); SWRITE_HK(0); SBAR(); } while (0)
    f32x16 pA0, pA1, pB0, pB1; float alA, alB;
    SWRITE_HV(0); SBAR();
    if (NT > 1) SLOAD_H(Kh, Vh, KBASE(1));
    SBAR(); qkt<0>(pA0, pA1, K_lds, r32, hi, S.qr, mref);
    MASKT(pA0, pA1, 0); partialSM(pA0, pA1, mref, alA, true);
    if (NT > 1) { VMW(); SWRITE_H(1); }
    __syncthreads();
#define HALF_STEP(PX0, PX1, alX, PY0, PY1, alY, t, KB, VB, SB) do { bf16x8 pa0, pa1, pa2, pa3;                              \
        SBAR(); qkt<KB>(PX0, PX1, K_lds, r32, hi, S.qr, mref);                                                                \
        finishSM(PY0, PY1, alY, l_reg, pa0, pa1, pa2, pa3); SBAR();                                                           \
        if ((t) + 1 < NT) { SLOAD_H(Kh, Vh, KBASE((t) + 1)); SBAR(); }                                                        \
        pv_tile<VB>(o, vb0, pa0, pa1, pa2, pa3); MASKT(PX0, PX1, (t)); partialSM(PX0, PX1, mref, alX, false);                  \
        __syncthreads();                                                                                                      \
        if ((t) + 1 < NT) { VMW(); SWRITE_H(SB); }                                                                            \
        RESC(alX); __syncthreads(); } while (0)
#define HALF_STEP_C(PX0, PX1, alX, PY0, PY1, alY, t, KB, VB, SB) do { bf16x8 pa0, pa1, pa2, pa3;                            \
        SBAR(); if ((t) <= TL) qkt<KB>(PX0, PX1, K_lds, r32, hi, S.qr, mref);                                                 \
        if ((t) - 1 <= TL) finishSM(PY0, PY1, alY, l_reg, pa0, pa1, pa2, pa3); SBAR();                                        \
        if ((t) + 1 < NT) { SLOAD_H(Kh, Vh, KBASE((t) + 1)); SBAR(); }                                                        \
        if ((t) - 1 <= TL) pv_tile<VB>(o, vb0, pa0, pa1, pa2, pa3);                                                           \
        if ((t) <= TL) { MASKT(PX0, PX1, (t)); partialSM(PX0, PX1, mref, alX, false); } else alX = 1.f;                        \
        __syncthreads();                                                                                                      \
        if ((t) + 1 < NT) { VMW(); SWRITE_H(SB); }                                                                            \
        RESC(alX); __syncthreads(); } while (0)
    for (int t = 1; t + 3 < NT; t += 2) {
        HALF_STEP(pB0, pB1, alB, pA0, pA1, alA, t, 1, 0, 0);
        HALF_STEP(pA0, pA1, alA, pB0, pB1, alB, t + 1, 0, 1, 1);
    }
    HALF_STEP(pB0, pB1, alB, pA0, pA1, alA, NT - 3, 1, 0, 0);
    HALF_STEP_C(pA0, pA1, alA, pB0, pB1, alB, NT - 2, 0, 1, 1);
    const bool even = (NT & 1) == 0;
    if (even) { SBAR(); if (NT - 1 <= TL) qkt<1>(pB0, pB1, K_lds, r32, hi, S.qr, mref); SBAR(); }
    SLOAD_H(nxt.K, nxt.V, 0); SBAR();
#pragma unroll
    for (int d0 = 0; d0 < 4; ++d0) S.qr[d0] = load8(nxt.Q + (size_t)(rbw * QBLK + r32) * PQ + d0 * 16 + hi * 8);
    SBAR();
    if (NT - 2 <= TL) { bf16x8 pa0, pa1, pa2, pa3; finishSM(pA0, pA1, alA, l_reg, pa0, pa1, pa2, pa3); SBAR();
        pv_tile<0>(o, vb0, pa0, pa1, pa2, pa3); }
    if (even) { if (NT - 1 <= TL) { MASKT(pB0, pB1, NT - 1); partialSM(pB0, pB1, mref, alB, false); } else alB = 1.f;
        __syncthreads(); RESC(alB);
        if (NT - 1 <= TL) { bf16x8 pa0, pa1, pa2, pa3; finishSM(pB0, pB1, alB, l_reg, pa0, pa1, pa2, pa3); SBAR(); pv_tile<1>(o, vb0, pa0, pa1, pa2, pa3); } }
    SBAR(); SEAM_K0();
    if (hi == 0) li_l[r32] = l_reg; asm volatile("s_waitcnt lgkmcnt(0)" ::: "memory");
    float rli[16];
#pragma unroll
    for (int r = 0; r < 16; ++r) rli[r] = __builtin_amdgcn_rcpf(li_l[crow(r, hi)]);
    unsigned* park = (unsigned*)(lds + PARK_OFF + wid * PARK_WAVE) + lane;
    if (MODE == 0) {
#pragma unroll
        for (int r = 0; r < 16; ++r) { park[(2 * r) * 64] = cvtpk(o[0][r] * rli[r], o[1][r] * rli[r]); park[(2 * r + 1) * 64] = cvtpk(o[2][r] * rli[r], o[3][r] * rli[r]); }
    } else {
        float gsub[4];
#pragma unroll
        for (int d0 = 0; d0 < 4; ++d0) gsub[d0] = sg[d0 * 32 + r32];
        bf16* Ow = cur.O + (size_t)(rbw * QBLK) * 1024;
#pragma unroll
        for (int r = 0; r < 16; ++r) { const unsigned w0 = park[(2 * r) * 64], w1 = park[(2 * r + 1) * 64];
            float x[4] = {__uint_as_float(w0 << 16) - lam * (o[0][r] * rli[r]), __uint_as_float(w0 & 0xffff0000u) - lam * (o[1][r] * rli[r]),
                          __uint_as_float(w1 << 16) - lam * (o[2][r] * rli[r]), __uint_as_float(w1 & 0xffff0000u) - lam * (o[3][r] * rli[r])};
            float ss = (x[0] * x[0] + x[1] * x[1]) + (x[2] * x[2] + x[3] * x[3]);
            ss += __shfl_xor(ss, 1); ss += __shfl_xor(ss, 2); ss += __shfl_xor(ss, 4); ss += __shfl_xor(ss, 8); ss += __shfl_xor(ss, 16);
            const float rstd = rsqrtf(ss * (1.0f / 128.0f) + 1e-5f) * post; const int orow = crow(r, hi);
#pragma unroll
            for (int d0 = 0; d0 < 4; ++d0) { const float v = x[d0] * rstd * gsub[d0]; const float vn = __shfl_xor(v, 1);
                if ((r32 & 1) == 0) *(unsigned*)(Ow + (size_t)orow * 1024 + d0 * 32 + r32) = cvtpk(v, vn); } }
    }
    __syncthreads();
#undef RESC
#undef KBASE
#undef MASKT
#undef SEAM_K0
#undef HALF_STEP
#undef HALF_STEP_C
}
#undef VMW
#undef VMWN
#undef SLOAD_H
#undef SWRITE_HK
#undef SWRITE_HV
#undef SWRITE_H
#undef KSWZ
#undef SBAR
}
#define GAS __attribute__((address_space(1)))
#define LAS __attribute__((address_space(3)))
typedef unsigned short bf16;
typedef unsigned v4u __attribute__((ext_vector_type(4)));
typedef float f32x4 __attribute__((ext_vector_type(4)));
typedef short bf16x8 __attribute__((ext_vector_type(8)));
typedef GAS unsigned gu32;
typedef GAS unsigned long long gu64;
#define RLX_AGENT __ATOMIC_RELAXED, __HIP_MEMORY_SCOPE_AGENT
#define LDS_WAIT() asm volatile("s_waitcnt lgkmcnt(0)" ::: "memory")
#define VM_WAIT() asm volatile("s_waitcnt vmcnt(0)" ::: "memory")
__device__ __forceinline__ unsigned long long rt() { return __builtin_amdgcn_s_memrealtime(); }
__device__ __forceinline__ unsigned f2bf(float f) { unsigned u = __builtin_bit_cast(unsigned, f); return (u + 0x7fffu + ((u >> 16) & 1u)) >> 16; }
__device__ __forceinline__ unsigned pk2(float lo, float hi) { return f2bf(lo) | (f2bf(hi) << 16); }

#define XB_TMO      128
#define XB_XCNT(j)  (256  + 64 * (j))
#define XB_XSUB(j)  (1280 + 64 * (j))
#define XB_XGEN(j)  (2304 + 64 * (j))
#define XB_TOP      3328
#define XB_TOPGEN   3392
#define XCD_BAR_WORDS 3456
#define XB_SPIN_CAP (1u << 18)

__device__ __forceinline__ unsigned xb_ld(unsigned* p)              { return __hip_atomic_load(p, __ATOMIC_RELAXED, __HIP_MEMORY_SCOPE_AGENT); }
__device__ __forceinline__ unsigned xb_add(unsigned* p, unsigned v) { return __hip_atomic_fetch_add(p, v, __ATOMIC_RELAXED, __HIP_MEMORY_SCOPE_AGENT); }
__device__ __forceinline__ unsigned xb_xcc_id() { return (unsigned)__builtin_amdgcn_s_getreg((3 << 11) | 20) & 0xFu; }
#define XB_SPIN(cond, bar) do { unsigned _sp = 0; while (cond) { __builtin_amdgcn_s_sleep(1); \
    if ((++_sp & 255u) == 0u) { if (xb_ld(&(bar)[XB_TMO])) break; if (_sp > XB_SPIN_CAP) { atomicAdd(&(bar)[XB_TMO], 1u); break; } } } } while (0)

struct XcdBarrier {
    unsigned* bar; unsigned x;
    volatile LAS unsigned* st;
};

__device__ __forceinline__ XcdBarrier xcd_barrier_post(unsigned* bar, volatile LAS unsigned* st) {
    XcdBarrier b; b.bar = bar; b.x = xb_xcc_id(); b.st = st;
    if (threadIdx.x == 0) (void)xb_add(&bar[XB_XCNT(b.x)], 1u);
    return b;
}
__device__ __forceinline__ void xcd_barrier_complete(unsigned* bar, unsigned x, unsigned& nloc, unsigned& nx) {
    const unsigned G = gridDim.x * gridDim.y * gridDim.z;
    unsigned sum, cnt, mine, sp = 0u;
    for (;;) {
        sum = 0u; cnt = 0u; mine = 0u;
#pragma unroll
        for (unsigned j = 0; j < 16; ++j) { const unsigned c = xb_ld(&bar[XB_XCNT(j)]); sum += c; cnt += (c > 0u) ? 1u : 0u; mine = (j == x) ? c : mine; }
        if (sum == G) break;
        __builtin_amdgcn_s_sleep(1);
        if ((++sp & 255u) == 0u) { if (xb_ld(&bar[XB_TMO])) break; if (sp > XB_SPIN_CAP) { atomicAdd(&bar[XB_TMO], 1u); break; } }
    }
    nloc = mine > 0u ? mine : 1u; nx = cnt > 0u ? cnt : 1u;
}

__device__ __forceinline__ void xcd_barrier(const XcdBarrier& b) {
    asm volatile("s_waitcnt vmcnt(0)" ::: "memory");
    __syncthreads();
    if (threadIdx.x == 0) {
        unsigned* bar = b.bar;
        __builtin_amdgcn_s_waitcnt(0);
        unsigned nloc = b.st[0], nx = b.st[1];
        if (nloc == 0u) { xcd_barrier_complete(bar, b.x, nloc, nx); b.st[0] = nloc; b.st[1] = nx; }
        const unsigned old = xb_add(&bar[XB_XSUB(b.x)], 1u);
        const unsigned gen = old / nloc;
        if (old + 1u == (gen + 1u) * nloc) {
            __builtin_amdgcn_fence(__ATOMIC_RELEASE, "agent");
            asm volatile("s_waitcnt vmcnt(0)" ::: "memory");
            const unsigned og = xb_add(&bar[XB_TOP], 1u);
            const unsigned tg = og / nx;
            if (og + 1u == (tg + 1u) * nx) xb_add(&bar[XB_TOPGEN], 1u);
            else XB_SPIN(xb_ld(&bar[XB_TOPGEN]) == tg, bar);
            __builtin_amdgcn_fence(__ATOMIC_ACQUIRE, "agent");
            xb_add(&bar[XB_XGEN(b.x)], 1u);
            asm volatile("s_waitcnt vmcnt(0)" ::: "memory");
        } else {
            XB_SPIN(xb_ld(&bar[XB_XGEN(b.x)]) == gen, bar);
            __builtin_amdgcn_fence(__ATOMIC_ACQUIRE, "agent");
            asm volatile("s_waitcnt vmcnt(0)" ::: "memory");
        }
    }
    __syncthreads();
}


#ifndef EPIRES_ALIGN
#define EPIRES_ALIGN true
#endif
#ifndef PROBE_SKIP
#define PROBE_SKIP 0
#endif
#ifndef PROBE_DUP
#define PROBE_DUP 0
#endif
#define REP(k) _Pragma("unroll 1") for (int rep_ = 0; rep_ < ((PROBE_DUP == (k)) ? 2 : 1); ++rep_)
#ifndef PH_MASK
#define PH_MASK 0xffff
#endif
#define PHM(b) ((PH_MASK >> (b)) & 1)
struct Frame {
    LAS unsigned char* lds;
    volatile LAS unsigned* MISC;
    gu32* ctl;
    int tid, lane, wave;
    int vcu, G;
    unsigned char* ws;
};
__device__ __forceinline__ const void* ld_arg(int i) {
    const void* ka = (const void*)__builtin_amdgcn_kernarg_segment_ptr(); unsigned long long p;
    asm volatile("s_load_dwordx2 %0, %1, %2\n\ts_waitcnt lgkmcnt(0)" : "=s"(p) : "s"(ka), "s"(i * 8) : "memory");
    return (const void*)p;
}
#define PHASE_FRAME Frame F = F0; { size_t z_ = 0; asm volatile("" : "+s"(z_)); F.ws = F0.ws + z_;     \
    int t_ = threadIdx.x; asm volatile("" : "+v"(t_)); F.tid = t_; F.lane = t_ & 63; F.wave = __builtin_amdgcn_readfirstlane(t_ >> 6); }
#define ARGP(T, i) ((T*)(F.ws + ((size_t)ld_arg(i) - (size_t)F.ws)))
#define INF(i) ARGP(const float, i)
#define WSF(off) ((float*)(F.ws + (off)))
#define WSB(off) ((bf16*)(F.ws + (off)))
__device__ __forceinline__ float wave_sum(float v) {
#pragma unroll
    for (int o = 1; o < 64; o <<= 1) v += __shfl_xor(v, o);
    return v;
}
__device__ __forceinline__ float bflo(unsigned w) { return __uint_as_float(w << 16); }
__device__ __forceinline__ float bfhi(unsigned w) { return __uint_as_float(w & 0xffff0000u); }
typedef unsigned u32x2 __attribute__((ext_vector_type(2)));

typedef float f32x16_sg __attribute__((ext_vector_type(16)));
constexpr int SG_AP = 1028;
template <bool SILU>
__device__ __forceinline__ void small_gemm_unit(Frame& F, const float* A, int lda, const float* W, int ldw, int N, int n0, const float* bias, float* out, int ldo) {
    LAS float* As = (LAS float*)(F.lds + RING_OFF);
    int tl_ = F.tid; asm volatile("" : "+v"(tl_)); const int tidl = tl_, lanel = tl_ & 63, r = tl_ & 31, hi = (tl_ >> 5) & 1;
    for (int i = tidl; i < 8192; i += NWAVES * 64) { const int b = i >> 8, k4 = (i & 255) * 4;
        f32x4 v = *(const f32x4*)(A + (size_t)b * lda + k4);
        if (SILU) {
#pragma unroll
            for (int e = 0; e < 4; ++e) v[e] = v[e] / (1.0f + expf(-v[e])); }
        *(LAS f32x4*)(As + b * SG_AP + k4) = v; }
    __syncthreads();
    const int c0 = n0 + r, c1 = n0 + 32 + r;
    const unsigned wstride = (unsigned)ldw * 4u;
    unsigned woff0 = ((unsigned)(F.wave * 128 + 4 * hi) * (unsigned)ldw + (unsigned)(c0 < N ? c0 : n0)) * 4u;
    const unsigned wd1 = (unsigned)((c1 < N ? c1 : n0) - (c0 < N ? c0 : n0)) * 4u;
    f32x16_sg acc0 = {}, acc1 = {};
    float ba[32], bb[32];
#define SG_LD(bx) do { _Pragma("unroll") for (int s_ = 0; s_ < 4; ++s_) { _Pragma("unroll") for (int i_ = 0; i_ < 4; ++i_) { const unsigned o_ = woff0 + (unsigned)i_ * wstride; \
        bx[s_ * 8 + i_] = *(const float*)((const char*)W + o_); bx[s_ * 8 + 4 + i_] = *(const float*)((const char*)W + (unsigned)(o_ + wd1)); } woff0 += 8u * wstride; } } while (0)
    SG_LD(ba);
#pragma unroll 1
    for (int g = 0; g < 4; ++g) {
        if (g < 3) SG_LD(bb);
        const LAS float* ap = As + r * SG_AP + F.wave * 128 + g * 32 + 4 * hi;
#pragma unroll
        for (int s_ = 0; s_ < 4; ++s_) { const f32x4 a4 = *(const LAS f32x4*)(ap + s_ * 8);
#pragma unroll
            for (int i_ = 0; i_ < 4; ++i_) { acc0 = __builtin_amdgcn_mfma_f32_32x32x2f32(a4[i_], ba[s_ * 8 + i_], acc0, 0, 0, 0); acc1 = __builtin_amdgcn_mfma_f32_32x32x2f32(a4[i_], ba[s_ * 8 + 4 + i_], acc1, 0, 0, 0); } }
#pragma unroll
        for (int j = 0; j < 32; ++j) ba[j] = bb[j];
    }
#undef SG_LD
    __syncthreads();
    LAS float* red = As;
#pragma unroll
    for (int i = 0; i < 16; ++i) { const int b = (i & 3) + 8 * (i >> 2) + 4 * hi; red[(F.wave * 32 + b) * 64 + r] = acc0[i]; red[(F.wave * 32 + b) * 64 + 32 + r] = acc1[i]; }
    __syncthreads();
#pragma unroll
    for (int j = 0; j < 4; ++j) { const int o = tidl + 512 * j, b = o >> 6, cc = o & 63; float s = 0.f;
#pragma unroll
        for (int w = 0; w < 8; ++w) s += red[(w * 32 + b) * 64 + cc];
        const int n = n0 + cc; if (n < N) out[(size_t)b * ldo + n] = s + (bias ? bias[n] : 0.f); }
    __syncthreads();
}
__device__ __forceinline__ void p0_transpose_item(const float* W, int ldw, int K, int ncols, bf16* WT, LAS float* scr, int item, int lane) {
    const int nblk = ncols / 32, kb = item / nblk, nb = item % nblk, k0 = 64 * kb, n0 = 32 * nb;
    float tv[32];
#pragma unroll
    for (int i = 0; i < 32; ++i) tv[i] = W[(size_t)(k0 + 2 * i + (lane >> 5)) * ldw + n0 + (lane & 31)];
#pragma unroll
    for (int i = 0; i < 32; ++i) scr[(2 * i + (lane >> 5)) * 33 + (lane & 31)] = tv[i];
    LDS_WAIT(); asm volatile("" ::: "memory");
    const int c = lane & 7;
#pragma unroll
    for (int j = 0; j < 4; ++j) { const int n = (lane >> 3) + 8 * j; const LAS float* s = scr + (8 * c) * 33 + n;
        v4u o; o.x = pk2(s[0 * 33], s[1 * 33]); o.y = pk2(s[2 * 33], s[3 * 33]); o.z = pk2(s[4 * 33], s[5 * 33]); o.w = pk2(s[6 * 33], s[7 * 33]);
        *(GAS v4u*)(WT + (size_t)(n0 + n) * K + k0 + 8 * c) = o; }
    LDS_WAIT(); asm volatile("" ::: "memory");
}
__device__ __forceinline__ void sincos_d(double a, double& s, double& c) {
    const double k = rint(a * 0.63661977236758134308);
    const double r = fma(-k, 6.123233995736766e-17, fma(-k, 1.5707963267948966, a));
    const int q = ((int)k) & 3;
    const double r2 = r * r;
    double sp = 1.0 / 6227020800.0; sp = sp * r2 - 1.0 / 39916800.0; sp = sp * r2 + 1.0 / 362880.0; sp = sp * r2 - 1.0 / 5040.0; sp = sp * r2 + 1.0 / 120.0; sp = sp * r2 - 1.0 / 6.0; sp = sp * r2 + 1.0;
    const double sr = r * sp;
    double cp = -1.0 / 87178291200.0; cp = cp * r2 + 1.0 / 479001600.0; cp = cp * r2 - 1.0 / 3628800.0; cp = cp * r2 + 1.0 / 40320.0; cp = cp * r2 - 1.0 / 720.0; cp = cp * r2 + 1.0 / 24.0; cp = cp * r2 - 0.5; cp = cp * r2 + 1.0;
    const double cr = cp;
    s = (q == 0) ? sr : (q == 1) ? cr : (q == 2) ? -sr : -cr;
    c = (q == 0) ? cr : (q == 1) ? -sr : (q == 2) ? -cr : sr;
}
__device__ __forceinline__ int tr_early(int k) { return k < 2048 ? k : k < 4096 ? 8192 + (k - 2048) : k < 5632 ? 16384 + (k - 4096) : 19456 + (k - 5632); }
__device__ __forceinline__ int tr_late(int k) { return k < 6144 ? 2048 + k : k < 12288 ? 10240 + (k - 6144) : k < 13824 ? 17920 + (k - 12288) : k < 14336 ? 19968 + (k - 13824) : 20480 + (k - 14336); }
__device__ __forceinline__ void transpose_range(Frame& F, int first, int stride, bool late) {
    const float* in_w_up = INF(7); const float* in_w_down = INF(8); const float* in_w_in = INF(9); const float* in_w_mo = INF(12); const float* in_kv_w = INF(16); const float* in_w_q = INF(17); const float* in_w_do = INF(20);
    LAS float* scr = (LAS float*)(F.lds + RING_OFF + F.wave * 16384);
    const int n = late ? 17408 : 6144;
    for (int k = first; k < n; k += stride) {
        const float* W; bf16* WT; int ldw, K, nc, r = late ? tr_late(k) : tr_early(k);
        if (r < 8192) { const int l = r >> 11; r &= 2047; W = in_w_up + (size_t)l * D * FF; WT = WSB(WS_WUP) + (size_t)l * D * FF; ldw = FF; K = D; nc = FF; }
        else if (r < 16384) { r -= 8192; const int l = r >> 11; r &= 2047; W = in_w_down + (size_t)l * D * FF; WT = WSB(WS_WDN) + (size_t)l * D * FF; ldw = D; K = FF; nc = D; }
        else if (r < 19456) { r -= 16384; const int l = r / 1536; r -= l * 1536; W = in_w_in + (size_t)l * D * A_IN; WT = WSB(WS_WIN) + (size_t)l * D * A_INP; ldw = A_IN; K = D; nc = A_INP; }
        else if (r < 20480) { r -= 19456; const int l = r >> 9; r &= 511; W = in_w_mo + (size_t)l * D * D; WT = WSB(WS_WMO) + (size_t)l * D * D; ldw = D; K = D; nc = D; }
        else if (r < 21504) { r -= 20480; W = in_kv_w; WT = WSB(WS_WKV); ldw = 2048; K = D; nc = 2048; }
        else if (r < 22528) { r -= 21504; const int l = r >> 9; r &= 511; W = in_w_q + (size_t)l * D * D; WT = WSB(WS_WQ) + (size_t)l * D * D; ldw = D; K = D; nc = D; }
        else { r -= 22528; const int l = r >> 9; r &= 511; W = in_w_do + (size_t)l * D * D; WT = WSB(WS_WDO) + (size_t)l * D * D; ldw = D; K = D; nc = D; }
        p0_transpose_item(W, ldw, K, nc, WT, scr, r, F.lane);
    }
}
__device__ __forceinline__ void bias_range(Frame& F, int first, int stride, bool late) {
    const float* in_w_in = INF(9); const float* in_w_up = INF(7); const float* in_kv_w = INF(16); const float* in_w_q = INF(17);
    const int n = late ? 305 : 113;
    for (int k = first; k < n; k += stride) {
        const int u = late ? (k < 49 ? 49 + k : 162 + (k - 49)) : (k < 49 ? k : 98 + (k - 49));
        const float *A, *W; float* out; int lda, ld, n0;
        if (u < 98) { const int l = u / 49, ch = u % 49; A = WSF(WS_MODS) + (size_t)l * 32 * 6144; lda = 6144; W = in_w_in + (size_t)l * D * A_IN; ld = A_IN; out = WSF(WS_B_IN) + (size_t)l * 32 * A_IN; n0 = ch * 64; }
        else if (u < 354) { const int l = (u - 98) >> 6, ch = (u - 98) & 63; A = WSF(WS_MODS) + (size_t)l * 32 * 6144 + 3072; lda = 6144; W = in_w_up + (size_t)l * D * FF; ld = FF; out = WSF(WS_B_UP) + (size_t)l * 32 * FF; n0 = ch * 64; }
        else if (u < 386) { A = WSF(WS_KVMOD); lda = 2048; W = in_kv_w; ld = 2048; out = WSF(WS_B_KV); n0 = (u - 354) * 64; }
        else { const int j = (u - 386) >> 4, ch = (u - 386) & 15; A = WSF(WS_MODS) + (size_t)(2 + j) * 32 * 6144; lda = 6144; W = in_w_q + (size_t)j * D * D; ld = D; out = WSF(WS_B_Q) + (size_t)j * 32 * D; n0 = ch * 64; }
        small_gemm_unit<false>(F, A, lda, W, ld, ld, n0, nullptr, out, ld);
    }
}
__device__ __forceinline__ void deferred_prologue(const Frame& F0) {
    PHASE_FRAME;
    const int v = (int)blockIdx.x - 128, NV = F.G - 128;
    bias_range(F, v, NV, true);
    transpose_range(F, v * NWAVES + F.wave, NV * NWAVES, true);
    const int* in_pos = ARGP(const int, 2); const float* in_lam_p = INF(18);
    const int gt = v * (NWAVES * 64) + F.tid, NGT = NV * NWAVES * 64;
    for (int i = gt; i < M * 8; i += NGT) { const int m = i >> 3, j = i & 7;
        const float inv = (j == 0) ? 1.0f : (j == 1) ? 0.1939227432012558f : (j == 2) ? 0.03760603070259094f : (j == 3) ? 0.007292664609849453f : (j == 4) ? 0.0014142135623842478f
                        : (j == 5) ? 0.00027424818836152554f : (j == 6) ? 5.318296098266728e-05f : 1.0313386155758053e-05f;
        const float ang = (float)in_pos[m] * inv; double s, c; sincos_d((double)ang, s, c);
        WSF(WS_ROPE)[(size_t)m * 16 + j] = (float)c; WSF(WS_ROPE)[(size_t)m * 16 + 8 + j] = (float)s; }
    if (v == 0 && F.tid < 2) { const float* lp = in_lam_p + F.tid * 256; float s1 = 0.f, s2 = 0.f;
        for (int i = 0; i < 64; ++i) { s1 += lp[i] * lp[64 + i]; s2 += lp[128 + i] * lp[192 + i]; }
        WSF(WS_LAM)[F.tid] = expf(s1) - expf(s2) + (F.tid == 0 ? 0.4707130183435842f : 0.5560582041556406f); }
}
__device__ __forceinline__ void p0a(const Frame& F0) {
    PHASE_FRAME;
    const float* in_c = INF(1); const float* in_ada_w = INF(3); const float* in_ada_b = INF(4); const float* in_kv_ada_w = INF(14); const float* in_kv_ada_b = INF(15); const float* in_w_up = INF(7); const float* in_w_down = INF(8); const float* in_w_in = INF(9); const float* in_w_mo = INF(12); const float* in_kv_w = INF(16); const float* in_w_q = INF(17); const float* in_w_do = INF(20); const int* in_pos = ARGP(const int, 2); const float* in_lam_p = INF(18);
    for (int u = F.vcu; u < 416; u += F.G) {
        const float *W, *bias; float* out; int ld, n0;
        if (u < 384) { const int l = u / 96, ch = u % 96; W = in_ada_w + (size_t)l * 1024 * 6144; bias = in_ada_b + l * 6144; out = WSF(WS_MODS) + (size_t)l * 32 * 6144; ld = 6144; n0 = ch * 64; }
        else { W = in_kv_ada_w; bias = in_kv_ada_b; out = WSF(WS_KVMOD); ld = 2048; n0 = (u - 384) * 64; }
        small_gemm_unit<true>(F, in_c, 1024, W, ld, ld, n0, bias, out, ld);
    }
    transpose_range(F, F.vcu * NWAVES + F.wave, F.G * NWAVES, false);
    const int gt = F.vcu * (NWAVES * 64) + F.tid, NGT = F.G * NWAVES * 64;
    for (int i = gt; i < 2 * 8 * 1024; i += NGT) { const int l = i >> 13, j = (i >> 10) & 7, k = i & 1023; WSF(WS_WG)[i] = in_w_in[(size_t)l * D * A_IN + (size_t)k * A_IN + A_INP + j]; }
}
__device__ __forceinline__ void p0b(const Frame& F0) {
    PHASE_FRAME;
    const float* in_w_in = INF(9); const float* in_w_up = INF(7); const float* in_kv_w = INF(16); const float* in_w_q = INF(17); const float* in_norm_mix_g = INF(5); const float* in_norm_mlp_g = INF(6); const float* in_kv_norm_g = INF(13); const float* in_x = INF(0); float* in_out = ARGP(float, 22);
    bias_range(F, F.vcu, F.G, false);
    const int gt = F.vcu * (NWAVES * 64) + F.tid, NGT = F.G * NWAVES * 64;
    for (int i = gt; i < 4 * 32 * 1024; i += NGT) { const int l = i >> 15, b = (i >> 10) & 31, k = i & 1023;
        WSF(WS_GM_MIX)[i] = in_norm_mix_g[l * 1024 + k] * (1.0f + WSF(WS_MODS)[(size_t)l * 32 * 6144 + (size_t)b * 6144 + 1024 + k]);
        WSF(WS_GM_MLP)[i] = in_norm_mlp_g[l * 1024 + k] * (1.0f + WSF(WS_MODS)[(size_t)l * 32 * 6144 + (size_t)b * 6144 + 4096 + k]); }
    for (int i = gt; i < 32 * 1024; i += NGT) { const int b = i >> 10, k = i & 1023; WSF(WS_GM_KV)[i] = in_kv_norm_g[k] * (1.0f + WSF(WS_KVMOD)[(size_t)b * 2048 + 1024 + k]); }
    const int gw = F.vcu * NWAVES + F.wave, NGW = F.G * NWAVES;
    for (int m0 = 4 * gw; m0 < M; m0 += 4 * NGW) {
        const int b = m0 >> 11; f32x4 v[4][4];
#pragma unroll
        for (int i = 0; i < 4; ++i)
#pragma unroll
            for (int j = 0; j < 4; ++j) v[i][j] = *(const f32x4*)(in_x + (size_t)(m0 + i) * D + 4 * F.lane + 256 * j);
        f32x4 gmv[4];
#pragma unroll
        for (int j = 0; j < 4; ++j) { const int c = 4 * F.lane + 256 * j; const f32x4 g = *(const f32x4*)(in_norm_mix_g + c), sc = *(const f32x4*)(WSF(WS_MODS) + (size_t)b * 6144 + 1024 + c); gmv[j] = g * (sc + 1.0f); }
#pragma unroll
        for (int i = 0; i < 4; ++i) { const int m = m0 + i; bf16* orow = (bf16*)in_out + (size_t)m * D; bf16* gr = WSB(WS_XG) + (size_t)m * D; float ss = 0.f;
#pragma unroll
            for (int j = 0; j < 4; ++j) { const int c = 4 * F.lane + 256 * j; const f32x4 x = v[i][j]; { u32x2 xb; xb.x = pk2(x[0], x[1]); xb.y = pk2(x[2], x[3]); *(u32x2*)(orow + c) = xb; }
                ss += (x[0] * x[0] + x[1] * x[1]) + (x[2] * x[2] + x[3] * x[3]);
                const f32x4 y = x * gmv[j]; u32x2 w; w.x = pk2(y[0], y[1]); w.y = pk2(y[2], y[3]); *(u32x2*)(gr + c) = w; }
            ss = wave_sum(ss);
            if (F.lane < 16) WSF(WS_SSQ)[(size_t)m * 16 + F.lane] = (F.lane == 0) ? ss : 0.f; }
    }
}
__device__ __forceinline__ void gates_phase(const Frame& F0, int l) {
    PHASE_FRAME;
    const float* in_b_gates = INF(10);
    const float* WGl = WSF(WS_WG) + l * 8192;
    const float* bg = in_b_gates + l * 8;
    const float* bin = WSF(WS_B_IN) + (size_t)l * 32 * A_IN;
    constexpr int GWP = 2064;
    LAS unsigned char* Wl = F.lds + RING_OFF;
    for (int i = F.tid; i < 2 * 9 * (GWP / 4); i += NWAVES * 64) ((LAS unsigned*)Wl)[i] = 0u;
    __syncthreads();
    for (int i = F.tid; i < 8 * 512; i += NWAVES * 64) { const int g = i >> 9, k2 = (i & 511) * 2;
        const float w0 = WGl[g * 1024 + k2], w1 = WGl[g * 1024 + k2 + 1];
        const unsigned h0 = f2bf(w0), h1 = f2bf(w1);
        const float r0 = w0 - __uint_as_float(h0 << 16), r1 = w1 - __uint_as_float(h1 << 16);
        *(LAS unsigned*)(Wl + g * GWP + k2 * 2) = h0 | (h1 << 16);
        *(LAS unsigned*)(Wl + (9 + g) * GWP + k2 * 2) = f2bf(r0) | (f2bf(r1) << 16); }
    __syncthreads();
    const int r = F.lane & 31, hi = F.lane >> 5;
    const int m = (F.vcu * NWAVES + F.wave) * 32 + r;
    const bf16* xrow = WSB(WS_XG) + (size_t)m * D + 8 * hi;
    const LAS unsigned char* wa = Wl + (r < 8 ? r : 8) * GWP + 16 * hi;
    typedef float f32x16_g __attribute__((ext_vector_type(16)));
    f32x16_g acc = {};
    bf16x8 xa[16], xb[16];
#define GT_LD(xs, s0) do { _Pragma("unroll") for (int s_ = 0; s_ < 16; ++s_) xs[s_] = *(const bf16x8*)(xrow + ((s0) + s_) * 16); } while (0)
#define GT_MM(xs, s0) do { _Pragma("unroll") for (int s_ = 0; s_ < 16; ++s_) { const bf16x8 ah = *(const LAS bf16x8*)(wa + ((s0) + s_) * 32), al = *(const LAS bf16x8*)(wa + 9 * GWP + ((s0) + s_) * 32); \
        acc = __builtin_amdgcn_mfma_f32_32x32x16_bf16(ah, xs[s_], acc, 0, 0, 0); acc = __builtin_amdgcn_mfma_f32_32x32x16_bf16(al, xs[s_], acc, 0, 0, 0); } } while (0)
    GT_LD(xa, 0); __builtin_amdgcn_sched_barrier(0);
    GT_LD(xb, 16); __builtin_amdgcn_sched_barrier(0); GT_MM(xa, 0); __builtin_amdgcn_sched_barrier(0);
    GT_LD(xa, 32); __builtin_amdgcn_sched_barrier(0); GT_MM(xb, 16); __builtin_amdgcn_sched_barrier(0);
    GT_LD(xb, 48); __builtin_amdgcn_sched_barrier(0); GT_MM(xa, 32); __builtin_amdgcn_sched_barrier(0);
    GT_MM(xb, 48);
#undef GT_LD
#undef GT_MM
    const f32x4 q0 = *(const f32x4*)(WSF(WS_SSQ) + (size_t)m * 16 + 8 * hi), q1 = *(const f32x4*)(WSF(WS_SSQ) + (size_t)m * 16 + 8 * hi + 4);
    float spt = ((q0[0] + q0[1]) + (q0[2] + q0[3])) + ((q1[0] + q1[1]) + (q1[2] + q1[3])); spt += __shfl_xor(spt, 32);
    const float rstd = rsqrtf(spt * (1.0f / 1024.0f) + 1e-6f);
    const f32x4 bv = *(const f32x4*)(bin + (size_t)(m >> 11) * A_IN + A_INP + 4 * hi), gv = *(const f32x4*)(bg + 4 * hi);
    f32x4 o;
#pragma unroll
    for (int i = 0; i < 4; ++i) { const float pre = rstd * acc[i] + bv[i] + gv[i];
        const float ls = fminf(pre, 0.f) - log1pf(expf(-fabsf(pre)));
        o[i] = hi ? ls : pre; }
    *(f32x4*)(WSF(WS_GATES) + (size_t)m * 8 + 4 * hi) = o;
    __syncthreads();
}
namespace ml {
typedef short bf16x8 __attribute__((ext_vector_type(8)));
typedef short s16x4 __attribute__((ext_vector_type(4)));
typedef float f32x16 __attribute__((ext_vector_type(16)));
typedef float f32x2_t __attribute__((ext_vector_type(2))); typedef __bf16 bf16x2_t __attribute__((ext_vector_type(2)));
constexpr int QP = 272, KWP = 320, VP = 576, PP = 144, HP = 528;
constexpr int L_QS = 0, L_KS = L_QS + 64 * QP, L_KW = L_KS + 64 * QP, L_VS = L_KW + 64 * KWP, L_P = L_VS + 64 * VP, L_HST = L_P + 64 * PP, L_TAB = L_HST + 64 * HP;
constexpr int T_US = L_TAB, T_MT = T_US + 256, T_WI = T_MT + 256, T_FL = T_WI + 256, T_D0 = T_FL + 256, T_D1 = T_D0 + 256, T_QN = T_D1 + 256, T_N = T_QN + 256, T_SSQ = T_N + 1024, L_END = T_SSQ + 2048;
__device__ __forceinline__ int crow(int r, int hi) { return (r & 3) + 8 * (r >> 2) + 4 * hi; }
__device__ __forceinline__ unsigned cvtpk(float lo, float hi) { f32x2_t v = {lo, hi}; bf16x2_t b = __builtin_convertvector(v, bf16x2_t); return __builtin_bit_cast(unsigned, b); }
__device__ __forceinline__ s16x4 vtr(const LAS unsigned char* p) { typedef short v4i16_t __attribute__((ext_vector_type(4))); return __builtin_bit_cast(s16x4, __builtin_amdgcn_ds_read_tr16_b64_v4i16((LAS v4i16_t*)p)); }
__device__ __forceinline__ bf16x8 cat(s16x4 lo, s16x4 hi) { return (bf16x8){lo[0], lo[1], lo[2], lo[3], hi[0], hi[1], hi[2], hi[3]}; }
#define ML_MFMA(a, b, c) __builtin_amdgcn_mfma_f32_32x32x16_bf16((a), (b), (c), 0, 0, 0)
}
__device__ __forceinline__ void mlstm_mfma_phase(const Frame& F0, int l, const int skip = 0) {
    using namespace ml;
    PHASE_FRAME;
    LAS unsigned char* L = F.lds;
    const int w = F.wave;
    LAS float* us = (LAS float*)(L + T_US); LAS float* Mt = (LAS float*)(L + T_MT); LAS float* wi = (LAS float*)(L + T_WI); LAS float* fl = (LAS float*)(L + T_FL);
    LAS float* d0 = (LAS float*)(L + T_D0); LAS float* d1 = (LAS float*)(L + T_D1); LAS float* qn = (LAS float*)(L + T_QN); LAS float* nb = (LAS float*)(L + T_N); LAS float* ssqp = (LAS float*)(L + T_SSQ);
    const bf16* QKVO = WSB(WS_QKVO); const float* GATES = WSF(WS_GATES); bf16* HN = WSB(WS_HN);
    for (int u = blockIdx.x; u < 128; u += F.G) {
        const int b = u >> 2, hd = u & 3; const size_t rowbase = (size_t)b * SEQ;
        int tid = F.tid; const int lane = tid & 63;
        for (int i = tid; i < 32 * 8; i += NWAVES * 64) { const int t = i >> 3, c8 = i & 7; *(LAS u32x2*)(L + L_P + t * PP + 64 + c8 * 8) = (u32x2){0u, 0u}; }
        if (tid < 256) nb[tid] = 0.f;
        f32x16 Cst[4];
#pragma unroll
        for (int kt = 0; kt < 4; ++kt)
#pragma unroll
            for (int i = 0; i < 16; ++i) Cst[kt][i] = 0.f;
        float mst = 0.f;
        v4u pq[2], pk[2], pv[4]; float pig, plf;
        const char* ubase = (const char*)QKVO + (size_t)u * 2048 * 1536;
#define ML_VOQ ((unsigned)((tid >> 4) * 1536 + (tid & 15) * 16))
#define ML_VOV ((unsigned)((tid >> 5) * 1536 + (tid & 31) * 16))
#define ML_PREFETCH(c) do { const char* cb_ = ubase + (size_t)(c) * (64 * 1536); const unsigned voq = ML_VOQ, vov = ML_VOV; \
            _Pragma("unroll") for (int ii = 0; ii < 2; ++ii) { pq[ii] = *(const v4u*)(cb_ + ii * (32 * 1536) + voq); pk[ii] = *(const v4u*)(cb_ + ii * (32 * 1536) + 256 + voq); } \
            _Pragma("unroll") for (int ii = 0; ii < 4; ++ii) pv[ii] = *(const v4u*)(cb_ + ii * (16 * 1536) + 512 + vov); \
            const float* gp_ = GATES + (rowbase + (size_t)(c) * 64) * 8 + hd; pig = gp_[lane * 8]; plf = gp_[lane * 8 + 4]; } while (0)
        ML_PREFETCH(0);
        v4u po[4];
#define ML_T3(CC) do { if (!(skip & 4)) { \
              _Pragma("unroll") for (int ii = 0; ii < 4; ++ii) { const int i = tid + 512 * ii, rr = i >> 5, ch = i & 31; float ss = 0.f; \
                _Pragma("unroll") for (int ww = 0; ww < 8; ++ww) ss += ssqp[ww * 64 + rr]; \
                const float rstd = rsqrtf(ss * (1.0f / 256.0f) + 1e-6f); \
                const v4u hv = *(const LAS v4u*)(L + L_HST + rr * HP + ch * 16); v4u o; \
                _Pragma("unroll") for (int e = 0; e < 4; ++e) o[e] = cvtpk(bflo(hv[e]) * rstd * bflo(po[ii][e]), bfhi(hv[e]) * rstd * bfhi(po[ii][e])); \
                *(v4u*)(HN + (rowbase + (size_t)(CC) * 64 + rr) * 1024 + hd * 256 + ch * 8) = o; } } } while (0)
        for (int c = 0; c < 32; ++c) {
            asm volatile("" : "+v"(tid));
            const int lane = tid & 63, r = lane & 31, h = lane >> 5, blk = (lane >> 4) & 1, q4 = (lane & 15) >> 2, p4 = lane & 3;
            const size_t row0 = rowbase + (size_t)c * 64;
#define ML_DPP(idv, x, ctrl, rmask) __builtin_bit_cast(float, __builtin_amdgcn_update_dpp(__builtin_bit_cast(int, (float)(idv)), __builtin_bit_cast(int, (float)(x)), ctrl, rmask, 0xf, false))
            float gb = plf;
            if (!(skip & 1)) { gb += ML_DPP(0.f, gb, 0x111, 0xf); gb += ML_DPP(0.f, gb, 0x112, 0xf); gb += ML_DPP(0.f, gb, 0x114, 0xf); gb += ML_DPP(0.f, gb, 0x118, 0xf);
                gb += ML_DPP(0.f, gb, 0x142, 0xa); gb += ML_DPP(0.f, gb, 0x143, 0xc); }
            const float uu = pig - gb; float pm = uu;
            if (!(skip & 1)) { const float NI = -__builtin_inff();
                pm = fmaxf(pm, ML_DPP(NI, pm, 0x111, 0xf)); pm = fmaxf(pm, ML_DPP(NI, pm, 0x112, 0xf)); pm = fmaxf(pm, ML_DPP(NI, pm, 0x114, 0xf)); pm = fmaxf(pm, ML_DPP(NI, pm, 0x118, 0xf));
                pm = fmaxf(pm, ML_DPP(NI, pm, 0x142, 0xa)); pm = fmaxf(pm, ML_DPP(NI, pm, 0x143, 0xc)); }
#undef ML_DPP
            const float Mt_l = fmaxf(mst, pm);
            const float G = __shfl(gb, 63), M63 = __shfl(Mt_l, 63);
            const float w_old = __expf(mst - M63), ws_l = __expf(uu - M63), wi_l = __expf(mst - Mt_l), fl_l = __expf(-(gb + Mt_l));
            const int nsel = (c & 1) * 128;
            if (w == 0) { us[lane] = uu; Mt[lane] = Mt_l; wi[lane] = wi_l; fl[lane] = fl_l; }
#pragma unroll
            for (int ii = 0; ii < 2; ++ii) { const int i = tid + 512 * ii, rr = i >> 4, ch = i & 15;
                *(LAS v4u*)(L + L_QS + rr * QP + ch * 16) = pq[ii]; *(LAS v4u*)(L + L_KS + rr * QP + ch * 16) = pk[ii];
                const float wsr = __shfl(ws_l, rr & 63); v4u kw;
#pragma unroll
                for (int e = 0; e < 4; ++e) kw[e] = cvtpk(bflo(pk[ii][e]) * wsr, bfhi(pk[ii][e]) * wsr);
                *(LAS v4u*)(L + L_KW + rr * KWP + ch * 16) = kw; }
#pragma unroll
            for (int ii = 0; ii < 4; ++ii) { const int i = tid + 512 * ii, rr = i >> 5, ch = i & 31; *(LAS v4u*)(L + L_VS + rr * VP + ch * 16) = pv[ii]; }
            mst = G + M63;
            if (c + 1 < 32 && !(skip & 32)) ML_PREFETCH(c + 1);
            asm volatile("" ::: "memory");
            if (c > 0) ML_T3(c - 1);
            asm volatile("s_waitcnt lgkmcnt(0)\n\ts_barrier" ::: "memory");
            { const char* ob = ubase + (size_t)c * (64 * 1536) + 1024;
#pragma unroll
              for (int ii = 0; ii < 4; ++ii) po[ii] = (skip & 32) ? (v4u){0u, 0u, 0u, 0u} : *(const v4u*)(ob + ii * (16 * 1536) + ML_VOV); }
            if (skip & 2) {} else if (w < 3) {
                const int st = (w == 2) ? 1 : 0, tt = (w >= 1) ? 1 : 0;
                f32x16 s;
#pragma unroll
                for (int i = 0; i < 16; ++i) s[i] = 0.f;
#pragma unroll
                for (int ks = 0; ks < 8; ++ks) { const bf16x8 a = *(const LAS bf16x8*)(L + L_KS + (32 * st + r) * QP + (16 * ks + 8 * h) * 2), bq = *(const LAS bf16x8*)(L + L_QS + (32 * tt + r) * QP + (16 * ks + 8 * h) * 2);
                    s = ML_MFMA(a, bq, s); }
                const float mt = Mt[32 * tt + r]; float rs = 0.f;
#pragma unroll
                for (int i = 0; i < 16; ++i) { const int sl = crow(i, h); const float wgt = __expf(us[32 * st + sl] - mt); const bool keep = (st != tt) || (sl <= r);
                    s[i] = keep ? s[i] * wgt : 0.f; rs += s[i]; }
                rs += __shfl_xor(rs, 32);
                if (h == 0) { if (st == 0) d0[32 * tt + r] = rs; else d1[32 * tt + r] = rs; }
#pragma unroll
                for (int g = 0; g < 4; ++g) { u32x2 pw; pw.x = cvtpk(s[4 * g], s[4 * g + 1]); pw.y = cvtpk(s[4 * g + 2], s[4 * g + 3]);
                    *(LAS u32x2*)(L + L_P + (32 * tt + r) * PP + (32 * st + 8 * g + 4 * h) * 2) = pw; }
            } else if (w == 3) {
                float a = 0.f; const LAS float* np = nb + nsel;
#pragma unroll
                for (int j = 0; j < 16; ++j) { const v4u qw = *(const LAS v4u*)(L + L_QS + lane * QP + j * 16); const f32x4 n0 = *(const LAS f32x4*)(np + 8 * j), n1 = *(const LAS f32x4*)(np + 8 * j + 4);
                    a += (bflo(qw[0]) * n0[0] + bfhi(qw[0]) * n0[1]) + (bflo(qw[1]) * n0[2] + bfhi(qw[1]) * n0[3]) + (bflo(qw[2]) * n1[0] + bfhi(qw[2]) * n1[1]) + (bflo(qw[3]) * n1[2] + bfhi(qw[3]) * n1[3]); }
                qn[lane] = a;
            } else if (w < 6) {
                const int dk = tid - 256; float a = w_old * nb[nsel + dk];
#pragma unroll 8
                for (int s = 0; s < 64; ++s) a += __uint_as_float((unsigned)(*(const LAS unsigned short*)(L + L_KW + s * KWP + dk * 2)) << 16);
                nb[(128 - nsel) + dk] = a;
            }
            f32x16 hq[2];
#pragma unroll
            for (int tt = 0; tt < 2; ++tt)
#pragma unroll
                for (int i = 0; i < 16; ++i) hq[tt][i] = 0.f;
            if (!(skip & 8))
#pragma unroll
            for (int kt = 0; kt < 4; ++kt)
#pragma unroll
                for (int ss = 0; ss < 2; ++ss) {
                    v4u cp;
#pragma unroll
                    for (int e = 0; e < 4; ++e) cp[e] = cvtpk(Cst[kt][8 * ss + 2 * e], Cst[kt][8 * ss + 2 * e + 1]);
                    const bf16x8 ca = __builtin_bit_cast(bf16x8, cp);
#pragma unroll
                    for (int tt = 0; tt < 2; ++tt) { const LAS unsigned char* qp = L + L_QS + (32 * tt + r) * QP + (32 * kt + 16 * ss + 4 * h) * 2;
                        const s16x4 lo = *(const LAS s16x4*)(qp), hi = *(const LAS s16x4*)(qp + 16);
                        hq[tt] = ML_MFMA(ca, cat(lo, hi), hq[tt]); }
                }
            __syncthreads();
#pragma unroll
            for (int tt = 0; tt < 2; ++tt) { const float wt = wi[32 * tt + r];
#pragma unroll
                for (int i = 0; i < 16; ++i) hq[tt][i] *= wt; }
#pragma unroll
            for (int kt = 0; kt < 4; ++kt)
#pragma unroll
                for (int i = 0; i < 16; ++i) Cst[kt][i] *= w_old;
            if (!(skip & 16))
#pragma unroll
            for (int ks = 0; ks < 4; ++ks) {
                const LAS unsigned char* vp = L + L_VS + (16 * ks + 8 * h + q4) * VP + (32 * w + 16 * blk + 4 * p4) * 2; const bf16x8 vf = cat(vtr(vp), vtr(vp + 4 * VP));
#pragma unroll
                for (int tt = 0; tt < 2; ++tt) { const bf16x8 pb = *(const LAS bf16x8*)(L + L_P + (32 * tt + r) * PP + (16 * ks + 8 * h) * 2); hq[tt] = ML_MFMA(vf, pb, hq[tt]); }
#pragma unroll
                for (int kt = 0; kt < 4; ++kt) { const LAS unsigned char* kp = L + L_KW + (16 * ks + 8 * h + q4) * KWP + (32 * kt + 16 * blk + 4 * p4) * 2; Cst[kt] = ML_MFMA(cat(vtr(kp), vtr(kp + 4 * KWP)), vf, Cst[kt]); }
            }
            if (!(skip & 64))
#pragma unroll
            for (int tt = 0; tt < 2; ++tt) { const int t = 32 * tt + r;
                const float den = d0[t] + (tt ? d1[t] : 0.f) + wi[t] * qn[t], inv = __builtin_amdgcn_rcpf(fmaxf(fabsf(den), fl[t])); float ss = 0.f;
#pragma unroll
                for (int i = 0; i < 16; ++i) { hq[tt][i] *= inv; ss += hq[tt][i] * hq[tt][i]; }
                ss += __shfl_xor(ss, 32);
                if (h == 0) ssqp[w * 64 + t] = ss;
#pragma unroll
                for (int g = 0; g < 4; ++g) { u32x2 hw; hw.x = cvtpk(hq[tt][4 * g], hq[tt][4 * g + 1]); hw.y = cvtpk(hq[tt][4 * g + 2], hq[tt][4 * g + 3]);
                    *(LAS u32x2*)(L + L_HST + t * HP + (32 * w + 8 * g + 4 * h) * 2) = hw; } }
            __syncthreads();
        }
        ML_T3(31);
        __syncthreads();
#undef ML_T3
#undef ML_PREFETCH
    }
}
static_assert(ml::L_END <= LDSCTL_OFF, "mLSTM LDS map");

__device__ __forceinline__ void combine_local(const Frame& F, int j, int b, int h) {
    const float* in_subln_g = INF(19);
    const float lam = WSF(WS_LAM)[j], post = 1.0f - (j == 0 ? 0.4707130183435842f : 0.5560582041556406f);
    const int cg = F.lane & 7; const float* sg = in_subln_g + j * 128 + 16 * cg;
    for (int s0 = 0; s0 < 32; s0 += 4) {
        v4u a0[4], a1[4], b0[4], b1[4];
#pragma unroll
        for (int i = 0; i < 4; ++i) { const size_t row = (size_t)b * SEQ + (s0 + i) * 64 + F.wave * 8 + (F.lane >> 3); const bf16* o1 = WSB(WS_O) + row * 2048 + h * 128 + 16 * cg; const bf16* o2 = o1 + 1024;
            a0[i] = *(const v4u*)(o1); a1[i] = *(const v4u*)(o1 + 8); b0[i] = *(const v4u*)(o2); b1[i] = *(const v4u*)(o2 + 8); }
#pragma unroll
        for (int i = 0; i < 4; ++i) { const size_t row = (size_t)b * SEQ + (s0 + i) * 64 + F.wave * 8 + (F.lane >> 3);
            float o[16]; float ss = 0.f;
#pragma unroll
            for (int e = 0; e < 4; ++e) { o[2 * e] = bflo(a0[i][e]) - lam * bflo(b0[i][e]); o[2 * e + 1] = bfhi(a0[i][e]) - lam * bfhi(b0[i][e]); o[8 + 2 * e] = bflo(a1[i][e]) - lam * bflo(b1[i][e]); o[8 + 2 * e + 1] = bfhi(a1[i][e]) - lam * bfhi(b1[i][e]); }
#pragma unroll
            for (int k = 0; k < 16; ++k) ss += o[k] * o[k];
            ss += __shfl_xor(ss, 1); ss += __shfl_xor(ss, 2); ss += __shfl_xor(ss, 4);
            const float rstd = rsqrtf(ss * (1.0f / 128.0f) + 1e-5f) * post;
            v4u r0, r1;
#pragma unroll
            for (int e = 0; e < 4; ++e) { r0[e] = pk2(o[2 * e] * rstd * sg[2 * e], o[2 * e + 1] * rstd * sg[2 * e + 1]); r1[e] = pk2(o[8 + 2 * e] * rstd * sg[8 + 2 * e], o[8 + 2 * e + 1] * rstd * sg[8 + 2 * e + 1]); }
            bf16* dst = WSB(WS_HN) + row * 1024 + h * 128 + 16 * cg; *(v4u*)(dst) = r0; *(v4u*)(dst + 8) = r1; }
    }
}
__device__ __forceinline__ void final_phase(const Frame& F0, float fill, const XcdBarrier& bar) {
    PHASE_FRAME;
    const float* in_final_g = INF(21); unsigned char* ob = ARGP(unsigned char, 22);
    const bf16* X16 = (const bf16*)ob; float* out = (float*)ob;
    const int gw = F.vcu * NWAVES + F.wave, NGW = F.G * NWAVES;
    f32x4 gv[4];
#pragma unroll
    for (int j = 0; j < 4; ++j) gv[j] = *(const f32x4*)(in_final_g + 4 * F.lane + 256 * j);
#define FIN_ROW(xw, spv, m) do { const float rstd_ = rsqrtf(wave_sum(spv) * (1.0f / 1024.0f) + 1e-6f); float* xr_ = out + (size_t)(m) * D; \
        _Pragma("unroll") for (int j = 0; j < 4; ++j) { const f32x4 x_ = {bflo((xw)[j].x), bfhi((xw)[j].x), bflo((xw)[j].y), bfhi((xw)[j].y)}; f32x4 y_ = x_ * rstd_ * gv[j]; \
            if (fill != 0.f) y_ = (f32x4){fill, fill, fill, fill}; *(f32x4*)(xr_ + 4 * F.lane + 256 * j) = y_; } } while (0)
    u32x2 lo[16][4]; float lsp[16];
#pragma unroll
    for (int i = 0; i < 16; ++i) { const int m = gw + i * NGW; lsp[i] = (F.lane < 16) ? WSF(WS_SSQ)[(size_t)m * 16 + F.lane] : 0.f;
#pragma unroll
        for (int j = 0; j < 4; ++j) lo[i][j] = *(const u32x2*)(X16 + (size_t)m * D + 4 * F.lane + 256 * j); }
    for (int m0 = M / 2 + 4 * gw; m0 < M; m0 += 4 * NGW) {
        u32x2 v[4][4]; float sp[4];
#pragma unroll
        for (int i = 0; i < 4; ++i) { sp[i] = (F.lane < 16) ? WSF(WS_SSQ)[(size_t)(m0 + i) * 16 + F.lane] : 0.f;
#pragma unroll
            for (int j = 0; j < 4; ++j) v[i][j] = *(const u32x2*)(X16 + (size_t)(m0 + i) * D + 4 * F.lane + 256 * j); }
#pragma unroll
        for (int i = 0; i < 4; ++i) FIN_ROW(v[i], sp[i], m0 + i);
    }
    xcd_barrier(bar);
#pragma unroll
    for (int i = 0; i < 16; ++i) FIN_ROW(lo[i], lsp[i], gw + i * NGW);
#undef FIN_ROW
}

#define IN(k) true
#define SEAM(k) do { xcd_barrier(bar); if (PROBE_DUP == 20) xcd_barrier(bar); } while (0)
template <int l> __device__ __forceinline__ void layer_phases(const Frame& F0, const XcdBarrier& bar, const int lo, const int hi, unsigned char* lds) {
        const int pb = 2 + 10 * l;
        if constexpr (l < 2) {
            REP(2) if (IN(pb + 0)) { PHASE_FRAME;
                if (PHM(2)) { gates_phase(F, l); if (PROBE_DUP == 21) gates_phase(F, l); }
                pg8::Gemm g{WSB(WS_XG), WSB(WS_WIN) + (size_t)l * D * A_INP, M, A_INP, D}; pg8::StaticOrder S; S.init(M, A_INP, F.G, (int)blockIdx.x);
                pg8::EpiLin<0> E{F.ws, WS_QKVO, A_INP, WS_B_IN + (size_t)l * 32 * A_IN * 4, A_IN, 0, 0, 1.0f, INF(11) + l * 1024};
                if (PHM(3)) pg8::gemm_phase<pg8::EpiLin<0>, pg8::StaticOrder, PG8_ALIGN, PG8_SP2>(F.lds + RING_OFF, g, S, E);
                SEAM(pb + 0);
            }
            REP(3) if (IN(pb + 1)) { PHASE_FRAME; if (l == 0 && blockIdx.x >= 128) deferred_prologue(F); else if (PHM(4)) mlstm_mfma_phase(F, l, (PROBE_DUP == 3 && rep_ == 0) ? PROBE_SKIP : 0); SEAM(pb + 1); }
        } else {
            const int j = l - 2;
            REP(4) if (IN(pb + 0)) { PHASE_FRAME;
                pg8::Gemm g{WSB(WS_XG), WSB(WS_WQ) + (size_t)j * D * D, M, D, D}; pg8::StaticOrder S; S.init(M, D, F.G, (int)blockIdx.x);
                pg8::EpiLin<2> E{F.ws, WS_Q, D, WS_B_Q + (size_t)j * 32 * D * 4, D, 0, 4, at2::C2, nullptr};
                if (PHM(5)) pg8::gemm_phase<pg8::EpiLin<2>, pg8::StaticOrder, PG8_ALIGN, PG8_SP2>(F.lds + RING_OFF, g, S, E);
                SEAM(pb + 0);
            }
            REP(5) if (IN(pb + 1)) { PHASE_FRAME;
                if (PHM(6)) {
                    const at2::bf16* Q0 = (const at2::bf16*)WSB(WS_Q); const at2::bf16* K0 = (const at2::bf16*)WSB(WS_KV); at2::bf16* O0 = (at2::bf16*)WSB(WS_HN);
                    const float lam = WSF(WS_LAM)[j], post = 1.0f - (j == 0 ? 0.4707130183435842f : 0.5560582041556406f); const float* sg = INF(19) + j * 128;
                    const int vq = F.vcu;
#define AT2_REF(R, g) do { const int bh_ = (((g) >> 2) * 256 + vq) >> 2, p_ = vq & 3, k_ = (g) & 3, comp_ = k_ & 1, qb_ = (k_ < 2) ? p_ : 7 - p_; \
                           const size_t rb_ = (size_t)(bh_ >> 3) * SEQ; const int hc_ = (bh_ & 7) * 128; \
                           R.Q = Q0 + (rb_ + (size_t)qb_ * 256) * 1024 + hc_ + comp_ * 64; R.K = K0 + rb_ * 2048 + hc_ + comp_ * 64; R.V = K0 + rb_ * 2048 + 1024 + hc_; \
                           R.O = O0 + (rb_ + (size_t)qb_ * 256) * 1024 + hc_; R.P0 = qb_ * 256; } while (0)
                    at2::Seam S; at2::BlockRef cur, nxt; AT2_REF(cur, 0);
                    at2::prime(cur, (char*)lds + RING_OFF, S);
#pragma unroll 1
                    for (int g = 0; g < 16; g += 2) {
                        AT2_REF(nxt, g + 1); at2::block<0>(cur, nxt, (char*)lds + RING_OFF, S, lam, post, sg); cur = nxt;
                        if (g + 2 < 16) AT2_REF(nxt, g + 2);
                        at2::block<1>(cur, nxt, (char*)lds + RING_OFF, S, lam, post, sg); cur = nxt; }
#undef AT2_REF
                }
                SEAM(pb + 1);
            }
        }
        REP(9) if (IN(pb + 3)) { PHASE_FRAME;
            const bf16* W = (l < 2) ? WSB(WS_WMO) + (size_t)l * D * D : WSB(WS_WDO) + (size_t)(l - 2) * D * D;
            pg8::Gemm g{WSB(WS_HN), W, M, D, D}; pg8::StaticOrder S; S.init(M, D, F.G, (int)blockIdx.x);
            bf16* x16 = ARGP(bf16, 22); pg8::EpiRes E{F.ws, x16, (PROBE_DUP == 9 && rep_ == 0) ? (size_t)65536 : WS_MODS + ((size_t)l * 32 * 6144 + 2048) * 4, WS_GM_MLP + (size_t)l * 32 * 1024 * 4, 0, 0};
            if (PHM(8)) pg8::gemm_phase<pg8::EpiRes, pg8::StaticOrder, EPIRES_ALIGN, PG8_SP2>(F.lds + RING_OFF, g, S, E);
            SEAM(pb + 3);
        }
        constexpr int NHM = 1, MHL = M / NHM;
        constexpr size_t HOFF = (l < 2) ? WS_H : WS_HA;
#pragma unroll 1
        for (int hm = 0; hm < NHM; ++hm) {
            REP(7) if (IN(pb + 4 + 2 * hm)) { PHASE_FRAME;
                pg8::Gemm g{WSB(WS_XG) + (size_t)hm * MHL * D, WSB(WS_WUP) + (size_t)l * D * FF, MHL, FF, D}; pg8::StaticOrder S; S.init(MHL, FF, F.G, (int)blockIdx.x);
                pg8::EpiLin<1> E{F.ws, HOFF, FF, WS_B_UP + (size_t)l * 32 * FF * 4, FF, hm * MHL, 0, 1.0f, nullptr};
                if (PHM(9)) pg8::gemm_phase<pg8::EpiLin<1>, pg8::StaticOrder, PG8_ALIGN, PG8_SP2>(F.lds + RING_OFF, g, S, E);
                SEAM(pb + 4 + 2 * hm);
            }
            REP(10) if (IN(pb + 5 + 2 * hm)) { PHASE_FRAME;
                pg8::Gemm g{WSB(HOFF), WSB(WS_WDN) + (size_t)l * D * FF, MHL, D, FF}; pg8::StaticOrder S; S.init(MHL, D, F.G, (int)blockIdx.x);
                bf16* x16 = ARGP(bf16, 22); pg8::EpiRes E{F.ws, x16, (PROBE_DUP == 10 && rep_ == 0) ? (size_t)65536 : WS_MODS + ((size_t)l * 32 * 6144 + 5120) * 4, (l < 3) ? WS_GM_MIX + (size_t)(l + 1) * 32 * 1024 * 4 : 0, (l == 1) ? WS_GM_KV : 0, hm * MHL};
                if (PHM(10)) pg8::gemm_phase<pg8::EpiRes, pg8::StaticOrder, EPIRES_ALIGN, PG8_SP2>(F.lds + RING_OFF, g, S, E);
                SEAM(pb + 5 + 2 * hm);
            }
        }
        if constexpr (l == 1) REP(8) if (IN(pb + 8)) { PHASE_FRAME;
            pg8::Gemm g{WSB(WS_HN), WSB(WS_WKV), M, 2048, D}; pg8::StaticOrder S; S.init(M, 2048, F.G, (int)blockIdx.x);
            pg8::EpiLin<2> E{F.ws, WS_KV, 2048, WS_B_KV, 2048, 0, 4, 1.0f, nullptr};
            if (PHM(11)) pg8::gemm_phase<pg8::EpiLin<2>, pg8::StaticOrder, PG8_ALIGN, PG8_SP2>(F.lds + RING_OFF, g, S, E);
        }
}
#undef IN
#undef SEAM
struct Args { const void* in[22]; float* out; unsigned char* ws; int ph_lo, ph_hi; };
__global__ void __launch_bounds__(NWAVES * 64, 2) yoco_fwd(Args args) {
    extern __shared__ __attribute__((aligned(16))) unsigned char lds[];
    Frame F;
    F.lds = (LAS unsigned char*)lds;
    F.MISC = (volatile LAS unsigned*)(F.lds + MISC_OFF);
    F.tid = threadIdx.x; F.lane = F.tid & 63; F.wave = __builtin_amdgcn_readfirstlane(F.tid >> 6);
    F.G = gridDim.x; { const int bx = blockIdx.x; F.vcu = (F.G % 8 == 0) ? (bx % 8) * (F.G / 8) + bx / 8 : bx; }
    unsigned char* ws = args.ws;
    F.ctl = (gu32*)(ws + WS_CTL);
    F.ws = ws;
    for (int u = F.tid; u < (LDS_BYTES - LDSCTL_OFF) / 4; u += NWAVES * 64) ((LAS unsigned*)(F.lds + LDSCTL_OFF))[u] = 0u;
    __syncthreads();
    XcdBarrier bar = xcd_barrier_post((unsigned*)(F.ctl + CW_BAR), F.MISC + 8);
    const int lo = 0, hi = 43;
#define IN(k) true
#define SEAM(k) do { xcd_barrier(bar); if (PROBE_DUP == 20) xcd_barrier(bar); } while (0)

    REP(1) { REP(11) if (PHM(0) && IN(0)) { p0a(F); SEAM(0); }
    REP(12) if (PHM(1) && IN(1)) { p0b(F); SEAM(1); } }
    layer_phases<0>(F, bar, lo, hi, lds); layer_phases<1>(F, bar, lo, hi, lds); layer_phases<2>(F, bar, lo, hi, lds); layer_phases<3>(F, bar, lo, hi, lds);
    if (IN(42)) {
        float fill = __uint_as_float(__hip_atomic_load(F.ctl + CW_DIAG, RLX_AGENT));
        if (__hip_atomic_load(F.ctl + CW_TMO, RLX_AGENT) != 0u || __hip_atomic_load((gu32*)((unsigned*)(F.ctl + CW_BAR) + XB_TMO), RLX_AGENT) != 0u) fill = 5000.0f;
        if (PHM(12)) final_phase(F, fill, bar);
    }
#undef IN
#undef SEAM
}

extern "C" void kernel_launch(void* const* d_in, const int* in_sizes, int n_in, void* d_out, int out_size, void* d_ws, size_t ws_size, hipStream_t stream) {
    static int grid = 0;
    if (grid == 0) {
        if (n_in != 22 || in_sizes[0] != M * D || out_size != M * D || ws_size < WS_END) { fprintf(stderr, "kernel_launch: unexpected problem (n_in %d, in0 %d, out %d, ws %zu); nothing launched\n", n_in, n_in > 0 ? in_sizes[0] : -1, out_size, ws_size); grid = -1; return; }
        int dev = 0, cus = 0, per_cu = 0;
        if (hipGetDevice(&dev) != hipSuccess || hipDeviceGetAttribute(&cus, hipDeviceAttributeMultiprocessorCount, dev) != hipSuccess) { grid = -1; return; }
        if (hipFuncSetAttribute((const void*)yoco_fwd, hipFuncAttributeMaxDynamicSharedMemorySize, LDS_BYTES) != hipSuccess) { fprintf(stderr, "kernel_launch: hipFuncSetAttribute failed\n"); grid = -1; return; }
        if (hipOccupancyMaxActiveBlocksPerMultiprocessor(&per_cu, (const void*)yoco_fwd, NWAVES * 64, LDS_BYTES) != hipSuccess || per_cu < 1)
            fprintf(stderr, "kernel_launch: note: occupancy query reports %d workgroups per CU\n", per_cu);
        (void)hipGetLastError();
        grid = cus;
        if (grid != 256) { fprintf(stderr, "kernel_launch: %d CUs; the attention and final phases are laid out for a grid of exactly 256 workgroups; nothing launched\n", cus); grid = -1; return; }
    }
    if (grid < 0) return;
    if (hipMemsetAsync((char*)d_ws + WS_CTL, 0, CTL_ZERO_BYTES, stream) != hipSuccess) return;
    Args a{};
    for (int i = 0; i < 22; ++i) a.in[i] = d_in[i];
    a.out = (float*)d_out; a.ws = (unsigned char*)d_ws;
    a.ph_lo = 0; a.ph_hi = 43;
    hipLaunchKernelGGL(yoco_fwd, dim3(grid), dim3(NWAVES * 64), LDS_BYTES, stream, a);
    const hipError_t le = hipPeekAtLastError();
    if (le != hipSuccess) fprintf(stderr, "kernel_launch: launch failed: %s\n", hipGetErrorName(le));
}
```

```cpp
#include <hip/hip_runtime.h>
#include <hip/hip_bf16.h>
#include <cstdio>
#include <cstdint>
#include <cmath>
constexpr int NWAVES = 8;
constexpr int BATCH = 32, SEQ = 2048, D = 1024, FF = 4096, M = BATCH * SEQ, MH = M / 2;
constexpr int A_IN = 3080, A_INP = 3072;
constexpr size_t MiB = 1u << 20;
constexpr size_t WS_CTL = 0, CTL_ZERO_BYTES = 1 * MiB;
constexpr size_t WS_MODS = 1 * MiB;
constexpr size_t WS_KVMOD = 4 * MiB;
constexpr size_t WS_GM_MIX = WS_KVMOD + 256 * 1024;
constexpr size_t WS_GM_MLP = WS_GM_MIX + 512 * 1024;
constexpr size_t WS_GM_KV = WS_GM_MLP + 512 * 1024;
constexpr size_t WS_B_IN = 6 * MiB;
constexpr size_t WS_B_UP = 7 * MiB;
constexpr size_t WS_B_KV = 9 * MiB;
constexpr size_t WS_B_Q = WS_B_KV + 256 * 1024;
constexpr size_t WS_WG = WS_B_Q + 256 * 1024;
constexpr size_t WS_LAM = WS_WG + 64 * 1024;
constexpr size_t WS_ROPE = 10 * MiB;
constexpr size_t WS_GATES = 14 * MiB;
constexpr size_t WS_SSQ = 16 * MiB;
constexpr size_t WS_WUP = 20 * MiB, WS_WDN = 52 * MiB, WS_WIN = 84 * MiB, WS_WMO = 96 * MiB, WS_WKV = 100 * MiB, WS_WQ = 104 * MiB, WS_WDO = 108 * MiB;
constexpr size_t WS_XG = 112 * MiB;
constexpr size_t WS_HN = 240 * MiB;
constexpr size_t WS_H = 368 * MiB;
constexpr size_t WS_KV = 752 * MiB;
constexpr size_t WS_Q = 624 * MiB;
constexpr size_t WS_END = 1008 * MiB;
constexpr size_t WS_QKVO = WS_H;
constexpr size_t WS_O = WS_H;
constexpr size_t WS_HA = WS_HN;
static_assert(WS_QKVO + (size_t)M * 3072 * 2 <= WS_KV && WS_H + (size_t)M * FF * 2 <= WS_END && WS_HA + (size_t)M * FF * 2 <= WS_KV && WS_Q + (size_t)M * 1024 * 2 <= WS_KV && WS_KV + (size_t)M * 2048 * 2 <= WS_END, "d_ws map");
constexpr int CW_TMO = 0, CW_CODE = 1, CW_DIAG = 8;
constexpr int CW_BAR = 4096;
constexpr int RING_OFF = 0, RING_BYTES = 131072;
constexpr int LDSCTL_OFF = 146432, MISC_OFF = LDSCTL_OFF + 320;
constexpr int LDS_BYTES = 147456;
static_assert(MISC_OFF + 128 <= LDS_BYTES && RING_BYTES <= LDSCTL_OFF, "LDS map");

namespace pg8 {
#define PG8_LAS __attribute__((address_space(3)))
typedef unsigned short bf16_t;
typedef short bf16x8 __attribute__((ext_vector_type(8)));
typedef float f32x4 __attribute__((ext_vector_type(4)));
typedef unsigned u32x4 __attribute__((ext_vector_type(4)));
constexpr int BM = 256, BK = 64, HALF = 128, HTB = HALF * BK * 2  , STAGE_BYTES = 8 * HTB, NXCD = 8, WGM = 8;

__host__ __device__ __forceinline__ int lds_byte(int r, int c) { const int st = (r >> 4) * 2 + (c >> 5), rr = r & 15, cc = c & 31, ob = rr * 64 + cc * 2; return st * 1024 + (ob ^ (((ob >> 9) & 1) << 5)); }
__host__ __device__ __forceinline__ void stage_rc(int b, int& R, int& C) { const int st = b / 1024, sb = b % 1024, swz = sb ^ (((sb >> 9) & 1) << 5); R = (st >> 1) * 16 + swz / 64; C = (st & 1) * 32 + (swz % 64) / 2; }
__host__ __device__ __forceinline__ int perm32(int rho) { const int n = rho >> 4, i = rho & 15; return 8 * (i >> 2) + 4 * n + (i & 3); }

struct Unit { int pm, pn; };
struct Gemm { const bf16_t* A; const bf16_t* Bt; int M, N, K; };

struct StaticOrder {
    int nM, nN, nwg, G, c;
    __host__ __device__ void init(int M, int N, int G_, int c_) { nM = M / BM; nN = N / BM; nwg = nM * nN; G = G_; c = c_; }
    __host__ __device__ bool next(int i, Unit& u) const {
        const long L = (long)i * G + c; if (L >= nwg) return false;
        int wgid = (int)L; { const int q = nwg / NXCD, r = nwg % NXCD, xcd = wgid % NXCD, off = wgid / NXCD; wgid = (xcd < r ? xcd * (q + 1) : r * (q + 1) + (xcd - r) * q) + off; }
        const int nig = WGM * nN, gid = wgid / nig, fm = gid * WGM, gsz = (nM - fm) < WGM ? (nM - fm) : WGM;
        u.pm = fm + ((wgid % nig) % gsz); u.pn = (wgid % nig) / gsz; return true;
    }
    __device__ __forceinline__ void a_ready(const Unit&) const {}
    __device__ __forceinline__ void done(const Unit&) const {}
};

__device__ __forceinline__ unsigned cvt_pk_bf16(float lo, float hi) { unsigned r; asm volatile("v_cvt_pk_bf16_f32 %0, %1, %2" : "=v"(r) : "v"(lo), "v"(hi)); return r; }
typedef float f32x2 __attribute__((ext_vector_type(2)));
__device__ __forceinline__ float rstd_row(const float* p) {
    const f32x4 a = *(const f32x4*)(p), b = *(const f32x4*)(p + 4), c = *(const f32x4*)(p + 8), d = *(const f32x4*)(p + 12);
    const float s = (((a[0] + a[1]) + (a[2] + a[3])) + ((b[0] + b[1]) + (b[2] + b[3]))) + (((c[0] + c[1]) + (c[2] + c[3])) + ((d[0] + d[1]) + (d[2] + d[3])));
    return rsqrtf(s * (1.0f / 1024.0f) + 1e-6f);
}
template <int MODE> struct EpiLin {
    static constexpr bool PERM = true, ADJ = true, AFTER_DRAIN = false;
    unsigned char* ws; size_t o_off; int ldo; size_t bias_off; int ldbias; int row_off; int rope_pn_lim; float scale; const float* aux;
    static __device__ __forceinline__ unsigned ror8(unsigned x) { return (unsigned)__builtin_amdgcn_update_dpp(0, (int)x, 0x128, 0xf, 0xf, false); }
    __device__ __forceinline__ void operator()(const f32x4 (&acc)[2][2][4][2], const Unit& u, int wr, int wc, int fr, int fq) const {
        bf16_t* O = (bf16_t*)(ws + o_off); const float* ssq = (const float*)(ws + WS_SSQ); const float* bias = (const float*)(ws + bias_off); const float* rope = (const float*)(ws + WS_ROPE);
        const int lrow0 = u.pm * BM + wr * 64 + fr, grow0 = row_off + lrow0;
        const int b = (row_off + u.pm * BM) >> 11;
        const int col0 = u.pn * BM + wc * 64 + 8 * fq;
        const bool hiL = (fr & 8) != 0;
        const int colx = col0 + (hiL ? 32 : 0);
        f32x4 bv[2][2];
#pragma unroll
        for (int bj = 0; bj < 2; ++bj)
#pragma unroll
            for (int n = 0; n < 2; ++n) bv[bj][n] = *(const f32x4*)(bias + (size_t)b * ldbias + col0 + bj * 32 + 4 * n);
        float rsd[2][4];
        { f32x4 pr[2][4];
#pragma unroll
          for (int ai = 0; ai < 2; ++ai)
#pragma unroll
              for (int m = 0; m < 4; ++m) pr[ai][m] = *(const f32x4*)(ssq + (size_t)(grow0 + ai * HALF + m * 16) * 16 + 4 * fq);
#pragma unroll
          for (int ai = 0; ai < 2; ++ai)
#pragma unroll
              for (int m = 0; m < 4; ++m) { float s = (pr[ai][m][0] + pr[ai][m][1]) + (pr[ai][m][2] + pr[ai][m][3]); s += __shfl_xor(s, 16); s += __shfl_xor(s, 32); rsd[ai][m] = rsqrtf(s * (1.0f / 1024.0f) + 1e-6f); } }
        float sc = scale;
        if (MODE == 0) sc = (u.pn == 2 || u.pn == 3) ? 0.08838834764831845f : 1.0f;
        const bool do_rope = (MODE == 2) && (u.pn < rope_pn_lim);
        int hh = 0, ee = 0;
        if (MODE == 0) { const int c = colx;
            if (c < 512) { hh = c >> 7; ee = c & 127; } else if (c < 1024) { hh = (c - 512) >> 7; ee = 128 + (c & 127); } else if (c < 2048) { hh = (c - 1024) >> 8; ee = 256 + (c & 255); } else { hh = (c - 2048) >> 8; ee = 512 + (c & 255); } }
#pragma unroll
        for (int ai = 0; ai < 2; ++ai)
#pragma unroll
            for (int m = 0; m < 4; ++m) {
                const int lrow = lrow0 + ai * HALF + m * 16, grow = grow0 + ai * HALF + m * 16;
                const float rs = rsd[ai][m];
                f32x4 cs0 = {1.f, 1.f, 1.f, 1.f}, cs1 = cs0, sn0 = {0.f, 0.f, 0.f, 0.f}, sn1 = sn0;
                if (MODE == 2) { if (do_rope) { const float* rp = rope + (size_t)grow * 16; cs0 = *(const f32x4*)(rp); cs1 = *(const f32x4*)(rp + 4); sn0 = *(const f32x4*)(rp + 8); sn1 = *(const f32x4*)(rp + 12); } }
                u32x4 wv[2];
#pragma unroll
                for (int bj = 0; bj < 2; ++bj) {
                    f32x4 v0 = acc[ai][bj][m][0] * rs + bv[bj][0], v1 = acc[ai][bj][m][1] * rs + bv[bj][1];
                    if (MODE == 1) {
#pragma unroll
                        for (int e = 0; e < 4; ++e) { const float a0 = fmaxf(v0[e], 0.f), a1 = fmaxf(v1[e], 0.f); v0[e] = a0 * a0; v1[e] = a1 * a1; }
                    }
                    if (MODE == 2) {
                        if (do_rope && bj == 0) {
                            f32x4 o0, o1;
#pragma unroll
                            for (int e = 0; e < 4; ++e) { o0[e] = __shfl_xor(v0[e], 16); o1[e] = __shfl_xor(v1[e], 16); }
                            if (fq == 0) { v0 = v0 * cs0 - o0 * sn0; v1 = v1 * cs1 - o1 * sn1; }
                            else if (fq == 1) { v0 = v0 * cs0 + o0 * sn0; v1 = v1 * cs1 + o1 * sn1; }
                        }
                    }
                    if (MODE != 1) { v0 = v0 * sc; v1 = v1 * sc; }
                    if (MODE == 0) { if (u.pn >= 8) {
                        const f32x4 g0 = *(const f32x4*)(aux + (col0 + bj * 32 - 2048)), g1 = *(const f32x4*)(aux + (col0 + bj * 32 - 2048) + 4);
#pragma unroll
                        for (int e2 = 0; e2 < 4; ++e2) { v0[e2] = g0[e2] * __builtin_amdgcn_rcpf(1.0f + __expf(-v0[e2])); v1[e2] = g1[e2] * __builtin_amdgcn_rcpf(1.0f + __expf(-v1[e2])); } } }
                    wv[bj].x = cvt_pk_bf16(v0[0], v0[1]); wv[bj].y = cvt_pk_bf16(v0[2], v0[3]); wv[bj].z = cvt_pk_bf16(v1[0], v1[1]); wv[bj].w = cvt_pk_bf16(v1[2], v1[3]);
                }
                const u32x4 sd = hiL ? wv[0] : wv[1]; u32x4 tv; tv.x = ror8(sd.x); tv.y = ror8(sd.y); tv.z = ror8(sd.z); tv.w = ror8(sd.w);
                const u32x4 d1 = hiL ? tv : wv[0], d2 = hiL ? wv[1] : tv;
                const int lrowA = lrow - (fr & 8), growA = grow - (fr & 8);
                bf16_t *p1, *p2;
                if (MODE == 0) { p1 = O + ((size_t)((b * 4 + hh) * 2048 + (growA & 2047))) * 768 + ee; p2 = p1 + (size_t)8 * 768; }
                else { p1 = O + (size_t)lrowA * ldo + colx; p2 = p1 + (size_t)8 * ldo; }
                if (MODE == 1) { __builtin_nontemporal_store(d1, (u32x4*)p1); __builtin_nontemporal_store(d2, (u32x4*)p2); }
                else { *(u32x4*)p1 = d1; *(u32x4*)p2 = d2; }
            }
    }
};
struct EpiRes {
    static constexpr bool PERM = true, ADJ = false, AFTER_DRAIN = false;
    unsigned char* ws; bf16_t* X; size_t gate_off; size_t gm_off; size_t gm2_off; int row_off;
    __device__ __forceinline__ void operator()(const f32x4 (&acc)[2][2][4][2], const Unit& u, int wr, int wc, int fr, int fq) const {
        bf16_t* XG = (bf16_t*)(ws + WS_XG); bf16_t* XG2 = (bf16_t*)(ws + WS_HN); float* ssq = (float*)(ws + WS_SSQ);
        const float* gate = (const float*)(ws + gate_off); const float* gm = (const float*)(ws + gm_off); const float* gm2 = (const float*)(ws + gm2_off);
        const bool has_gm = gm_off != 0, has_gm2 = gm2_off != 0;
        const int grow0 = row_off + u.pm * BM + wr * 64 + fr;
        const int b = (row_off + u.pm * BM) >> 11;
        const int col0 = u.pn * BM + wc * 32 + 8 * fq;
        float ss[2][4];
#pragma unroll
        for (int ai = 0; ai < 2; ++ai)
#pragma unroll
            for (int m = 0; m < 4; ++m) ss[ai][m] = 0.f;
        u32x4 xq[2], xn[2];
#pragma unroll
        for (int mm = 0; mm < 2; ++mm) xq[mm] = *(const u32x4*)((const char*)X + (unsigned)(((grow0 + mm * 16) * 1024 + col0) * 2));
        f32x4 gv0, gv1, mv0 = {0.f, 0.f, 0.f, 0.f}, mv1 = mv0, nv0 = mv0, nv1 = mv0;
#pragma unroll
        for (int k = 0; k < 8; ++k) { const int bj = k >> 2, ai = (k >> 1) & 1, m0 = (k & 1) * 2; const int c = col0 + bj * HALF;
            if ((k & 3) == 0) {
                gv0 = *(const f32x4*)(gate + (size_t)b * 6144 + c); gv1 = *(const f32x4*)(gate + (size_t)b * 6144 + c + 4);
                if (has_gm) { mv0 = *(const f32x4*)(gm + (size_t)b * 1024 + c); mv1 = *(const f32x4*)(gm + (size_t)b * 1024 + c + 4); }
                if (has_gm2) { nv0 = *(const f32x4*)(gm2 + (size_t)b * 1024 + c); nv1 = *(const f32x4*)(gm2 + (size_t)b * 1024 + c + 4); } }
            if (k < 7) { const int bj2 = (k + 1) >> 2, ai2 = ((k + 1) >> 1) & 1, m2 = ((k + 1) & 1) * 2;
#pragma unroll
                for (int mm = 0; mm < 2; ++mm) xn[mm] = *(const u32x4*)((const char*)X + (unsigned)(((grow0 + ai2 * HALF + (m2 + mm) * 16) * 1024 + col0 + bj2 * HALF) * 2)); }
            asm volatile("" ::: "memory");
#pragma unroll
            for (int mm = 0; mm < 2; ++mm) { const int m = m0 + mm; const unsigned off = (unsigned)(((grow0 + ai * HALF + m * 16) * 1024 + c) * 2);
                const u32x4 xw = xq[mm];
                f32x4 x0 = {__uint_as_float(xw.x << 16), __uint_as_float(xw.x & 0xffff0000u), __uint_as_float(xw.y << 16), __uint_as_float(xw.y & 0xffff0000u)};
                f32x4 x1 = {__uint_as_float(xw.z << 16), __uint_as_float(xw.z & 0xffff0000u), __uint_as_float(xw.w << 16), __uint_as_float(xw.w & 0xffff0000u)};
                x0 = x0 + gv0 * acc[ai][bj][m][0]; x1 = x1 + gv1 * acc[ai][bj][m][1];
                u32x4 w; w.x = cvt_pk_bf16(x0[0], x0[1]); w.y = cvt_pk_bf16(x0[2], x0[3]); w.z = cvt_pk_bf16(x1[0], x1[1]); w.w = cvt_pk_bf16(x1[2], x1[3]);
                *(u32x4*)((char*)X + off) = w;
                ss[ai][m] += ((x0[0] * x0[0] + x0[1] * x0[1]) + (x0[2] * x0[2] + x0[3] * x0[3])) + ((x1[0] * x1[0] + x1[1] * x1[1]) + (x1[2] * x1[2] + x1[3] * x1[3]));
                if (has_gm) { const f32x4 y0 = x0 * mv0, y1 = x1 * mv1; u32x4 g; g.x = cvt_pk_bf16(y0[0], y0[1]); g.y = cvt_pk_bf16(y0[2], y0[3]); g.z = cvt_pk_bf16(y1[0], y1[1]); g.w = cvt_pk_bf16(y1[2], y1[3]); *(u32x4*)((char*)XG + off) = g; }
                if (has_gm2) { const f32x4 y0 = x0 * nv0, y1 = x1 * nv1; u32x4 g; g.x = cvt_pk_bf16(y0[0], y0[1]); g.y = cvt_pk_bf16(y0[2], y0[3]); g.z = cvt_pk_bf16(y1[0], y1[1]); g.w = cvt_pk_bf16(y1[2], y1[3]); *(u32x4*)((char*)XG2 + off) = g; } }
#pragma unroll
            for (int mm = 0; mm < 2; ++mm) xq[mm] = xn[mm];
            asm volatile("" ::: "memory"); }
#pragma unroll
        for (int ai = 0; ai < 2; ++ai)
#pragma unroll
            for (int m = 0; m < 4; ++m) { float t = ss[ai][m]; t += __shfl_xor(t, 16); t += __shfl_xor(t, 32);
                if (fq == 0) ssq[(size_t)(grow0 + ai * HALF + m * 16) * 16 + u.pn * 4 + wc] = t; }
    }
};

template <class Epi, class Sched, bool ALIGN_EPI = false, bool SP2 = false>
__device__ __forceinline__ void gemm_phase(PG8_LAS unsigned char* lds, const Gemm g, const Sched& S, const Epi& E) {
    int tid_ = threadIdx.x; asm volatile("" : "+v"(tid_));
    const int tid = tid_, wid = __builtin_amdgcn_readfirstlane(tid >> 6), lane = tid & 63, wr = wid >> 2, wc = wid & 3, fr = lane & 15, fq = lane >> 4;
    const int K = g.K, nt = K / BK;
    unsigned voffA[2], voffB[2];
#pragma unroll
    for (int i = 0; i < 2; ++i) { int R, C; stage_rc(tid * 16 + i * 8192, R, C); const int Rb = !Epi::PERM ? R : Epi::ADJ ? ((R >> 5) * 64 + perm32(R & 31)) : ((R & ~31) + perm32(R & 31));
        voffA[i] = (unsigned)(R * K + C) * 2u; voffB[i] = (unsigned)(Rb * K + C) * 2u; }
    const size_t kstep = (size_t)(BK * 2);
    const size_t hstep = (size_t)HALF * K * 2;
    const size_t tstep = 2 * hstep;
    const size_t hstepB = Epi::ADJ ? (size_t)32 * K * 2 : hstep;
    const unsigned ldsw = (unsigned)wid * 1024u;
    const int aoff = lds_byte(wr * 64 + fr, fq * 8), boff = lds_byte(wc * 32 + fr, fq * 8);
#define PG8_SA(b, h) (((b) * 2 + (h)) * HTB)
#define PG8_SB(b, h) ((4 + (b) * 2 + (h)) * HTB)
#define PG8_STAGE(bufoff, gbase, voff) do { _Pragma("unroll") for (int _i = 0; _i < 2; ++_i) \
        __builtin_amdgcn_global_load_lds((const unsigned*)((const char*)(gbase) + (voff)[_i]), (PG8_LAS unsigned*)(lds + (bufoff) + ldsw + _i * 8192), 16, 0, 0); } while (0)
#define PG8_LDA(dst, b, h) do { _Pragma("unroll") for (int m = 0; m < 4; ++m) _Pragma("unroll") for (int k = 0; k < 2; ++k) dst[m][k] = *(const PG8_LAS bf16x8*)(lds + PG8_SA(b, h) + aoff + m * 2048 + k * 1024); } while (0)
#define PG8_LDB(dst, b, h) do { _Pragma("unroll") for (int n = 0; n < 2; ++n) _Pragma("unroll") for (int k = 0; k < 2; ++k) dst[n][k] = *(const PG8_LAS bf16x8*)(lds + PG8_SB(b, h) + boff + n * 2048 + k * 1024); } while (0)
#define PG8_MMA(ai, bj, At, Bt) do { __builtin_amdgcn_s_setprio(1); _Pragma("unroll") for (int m = 0; m < 4; ++m) _Pragma("unroll") for (int n = 0; n < 2; ++n) _Pragma("unroll") for (int k = 0; k < 2; ++k) \
        acc[ai][bj][m][n] = __builtin_amdgcn_mfma_f32_16x16x32_bf16(Bt[n][k], At[m][k], acc[ai][bj][m][n], 0, 0, 0); __builtin_amdgcn_s_setprio(0); } while (0)
#define PG8_WAIT_V(n) asm volatile("s_waitcnt vmcnt(" #n ")" ::: "memory")
#define PG8_WAIT_L(n) asm volatile("s_waitcnt lgkmcnt(" #n ")" ::: "memory")
#define PG8_BAR __builtin_amdgcn_s_barrier()
#define PG8_SCHED __builtin_amdgcn_sched_barrier(0)
    Unit cur, nxt; int ui = 0;
    if (!S.next(0, cur)) return;
    f32x4 acc[2][2][4][2];
#pragma unroll
    for (int a = 0; a < 2; ++a)
#pragma unroll
        for (int b = 0; b < 2; ++b)
#pragma unroll
            for (int m = 0; m < 4; ++m)
#pragma unroll
                for (int n = 0; n < 2; ++n) acc[a][b][m][n] = (f32x4){0.f, 0.f, 0.f, 0.f};
    bf16x8 At[4][2], B0[2][2], B1[2][2];
    const char* cA = (const char*)g.A + (size_t)cur.pm * tstep; const char* cB = (const char*)g.Bt + (size_t)cur.pn * tstep;
    S.a_ready(cur);
    if constexpr (SP2) {
        PG8_STAGE(PG8_SB(0, 0), cB, voffB); PG8_STAGE(PG8_SB(0, 1), cB + hstepB, voffB); PG8_STAGE(PG8_SA(0, 0), cA, voffA); PG8_STAGE(PG8_SA(0, 1), cA + hstep, voffA);
        if (wr == 1) PG8_BAR;
        PG8_WAIT_V(2); PG8_BAR;
        PG8_STAGE(PG8_SB(1, 0), cB + kstep, voffB); PG8_STAGE(PG8_SA(1, 0), cA + kstep, voffA); PG8_STAGE(PG8_SB(1, 1), cB + hstepB + kstep, voffB);
        PG8_WAIT_V(6); PG8_BAR;
    } else {
        PG8_STAGE(PG8_SB(0, 0), cB, voffB); PG8_STAGE(PG8_SA(0, 0), cA, voffA); PG8_STAGE(PG8_SB(0, 1), cB + hstepB, voffB); PG8_STAGE(PG8_SA(0, 1), cA + hstep, voffA);
        if (wr == 1) PG8_BAR;
        PG8_WAIT_V(4); PG8_BAR;
        PG8_STAGE(PG8_SB(1, 0), cB + kstep, voffB); PG8_STAGE(PG8_SA(1, 0), cA + kstep, voffA); PG8_STAGE(PG8_SB(1, 1), cB + hstepB + kstep, voffB);
        PG8_WAIT_V(6); PG8_BAR;
    }
    for (;;) {
        const bool has_next = S.next(ui + 1, nxt);
        const char* nA = has_next ? (const char*)g.A + (size_t)nxt.pm * tstep : cA; const char* nB = has_next ? (const char*)g.Bt + (size_t)nxt.pn * tstep : cB;
        for (int t = 0; t < nt; t += 2) {
            const bool last = (t == nt - 2);
            const char* a1 = cA + (size_t)(t + 1) * kstep;
            const char* a2 = last ? nA : cA + (size_t)(t + 2) * kstep; const char* b2 = last ? nB : cB + (size_t)(t + 2) * kstep;
            const char* a3 = a2 + kstep; const char* b3 = b2 + kstep;
            if (last && has_next) S.a_ready(nxt);
            if constexpr (SP2) {
            PG8_LDB(B0, 0, 0); PG8_LDB(B1, 0, 1); PG8_SCHED; PG8_LDA(At, 0, 0); PG8_STAGE(PG8_SA(1, 1), a1 + hstep, voffA);
            PG8_WAIT_V(8); PG8_WAIT_L(0); PG8_BAR; PG8_MMA(0, 0, At, B0); PG8_MMA(0, 1, At, B1); PG8_BAR; PG8_SCHED;
            PG8_LDA(At, 0, 1); PG8_STAGE(PG8_SB(0, 0), b2, voffB); PG8_STAGE(PG8_SB(0, 1), b2 + hstepB, voffB); PG8_STAGE(PG8_SA(0, 0), a2, voffA);
            PG8_WAIT_V(8); PG8_WAIT_L(0); PG8_BAR; PG8_MMA(1, 0, At, B0); PG8_MMA(1, 1, At, B1); PG8_BAR; PG8_SCHED;
            PG8_LDB(B0, 1, 0); PG8_LDB(B1, 1, 1); PG8_SCHED; PG8_LDA(At, 1, 0); PG8_STAGE(PG8_SA(0, 1), a2 + hstep, voffA);
            PG8_WAIT_V(8); PG8_WAIT_L(0); PG8_BAR; PG8_MMA(0, 0, At, B0); PG8_MMA(0, 1, At, B1); PG8_BAR; PG8_SCHED;
            PG8_LDA(At, 1, 1); PG8_STAGE(PG8_SB(1, 0), b3, voffB); PG8_STAGE(PG8_SB(1, 1), b3 + hstepB, voffB); PG8_STAGE(PG8_SA(1, 0), a3, voffA);
            PG8_WAIT_V(8); PG8_WAIT_L(0); PG8_BAR; PG8_MMA(1, 0, At, B0); PG8_MMA(1, 1, At, B1); PG8_BAR; PG8_SCHED;
            } else {
            PG8_LDB(B0, 0, 0); PG8_SCHED; PG8_LDA(At, 0, 0); PG8_STAGE(PG8_SA(1, 1), a1 + hstep, voffA);
            PG8_WAIT_L(8); PG8_BAR; PG8_WAIT_L(0); PG8_MMA(0, 0, At, B0); PG8_BAR; PG8_SCHED;
            PG8_LDB(B1, 0, 1); PG8_STAGE(PG8_SB(0, 0), b2, voffB);
            PG8_BAR; PG8_WAIT_L(0); PG8_MMA(0, 1, At, B1); PG8_BAR;
            PG8_LDA(At, 0, 1); PG8_STAGE(PG8_SA(0, 0), a2, voffA);
            PG8_BAR; PG8_WAIT_L(0); PG8_MMA(1, 0, At, B0); PG8_BAR; PG8_SCHED;
            PG8_STAGE(PG8_SB(0, 1), b2 + hstepB, voffB);
            PG8_WAIT_V(6); PG8_BAR; PG8_MMA(1, 1, At, B1); PG8_BAR;
            PG8_LDB(B0, 1, 0); PG8_SCHED; PG8_LDA(At, 1, 0); PG8_STAGE(PG8_SA(0, 1), a2 + hstep, voffA);
            PG8_WAIT_L(8); PG8_BAR; PG8_WAIT_L(0); PG8_MMA(0, 0, At, B0); PG8_BAR; PG8_SCHED;
            PG8_LDB(B1, 1, 1); PG8_STAGE(PG8_SB(1, 0), b3, voffB);
            PG8_BAR; PG8_WAIT_L(0); PG8_MMA(0, 1, At, B1); PG8_BAR;
            PG8_LDA(At, 1, 1); PG8_STAGE(PG8_SA(1, 0), a3, voffA);
            PG8_BAR; PG8_WAIT_L(0); PG8_MMA(1, 0, At, B0); PG8_BAR; PG8_SCHED;
            PG8_STAGE(PG8_SB(1, 1), b3 + hstepB, voffB);
            PG8_WAIT_V(6); PG8_BAR; PG8_MMA(1, 1, At, B1); PG8_BAR;
            }
        }
        if constexpr (ALIGN_EPI) { if (wr == 0) PG8_BAR; }
        if constexpr (!Epi::AFTER_DRAIN) { E(acc, cur, wr, wc, fr, fq); S.done(cur); }
        if (!has_next) break;
#pragma unroll
        for (int a = 0; a < 2; ++a)
#pragma unroll
            for (int b = 0; b < 2; ++b)
#pragma unroll
                for (int m = 0; m < 4; ++m)
#pragma unroll
                    for (int n = 0; n < 2; ++n) acc[a][b][m][n] = (f32x4){0.f, 0.f, 0.f, 0.f};
        cur = nxt; cA = nA; cB = nB; ++ui;
        if constexpr (ALIGN_EPI) { if (wr == 1) PG8_BAR; }
    }
    PG8_WAIT_V(0);
    if constexpr (!ALIGN_EPI) { if (wr == 0) PG8_BAR; }
    PG8_BAR;
    if constexpr (Epi::AFTER_DRAIN) { E.fused(acc, cur, wr, wc, fr, fq, lds, wid, lane); S.done(cur); }
#undef PG8_SA
#undef PG8_SB
#undef PG8_STAGE
#undef PG8_LDA
#undef PG8_LDB
#undef PG8_MMA
#undef PG8_WAIT_V
#undef PG8_WAIT_L
#undef PG8_BAR
#undef PG8_SCHED
}
}

#ifndef PG8_SP2
#define PG8_SP2 true
#endif
#ifndef PG8_ALIGN
#define PG8_ALIGN true
#endif
namespace at2 {
typedef unsigned short bf16;
typedef short bf16x8 __attribute__((ext_vector_type(8)));
typedef short s16x4 __attribute__((ext_vector_type(4)));
typedef float f32x16 __attribute__((ext_vector_type(16)));
typedef unsigned u32x4 __attribute__((ext_vector_type(4)));
constexpr int DK = 64, DV = 128, SKV = 2048, W = SKV;
constexpr int PQ = 1024, PK = 2048, PV = 2048, PO = 2048;
constexpr float SCALE = 0.125f, THR = 8.f, C2 = 0.125f * 1.4426950408889634f;
constexpr int NW = 8, QBLK = 32, KVBLK = 64, QB = NW * QBLK;
constexpr int SHM_V = KVBLK * DV * 2, SHM_K = KVBLK * DK * 2;
constexpr int LDS_BYTES = 2 * SHM_V + 2 * SHM_K + NW * 64 * 4;
#define KSWZ(row, colB) ((row) * 128 + ((colB) ^ (((row) & 7) << 4)))
#define SBAR() __builtin_amdgcn_sched_barrier(0)
__device__ __forceinline__ int v_st(int k, int c) { const int kk = (k & ~0xC) | ((k & 4) << 1) | ((k & 8) >> 1); return ((kk >> 3) * 4 + (c >> 5)) * 512 + ((kk & 7) * 32 + (c & 31)) * 2; }
__device__ __forceinline__ int v_rd_base(int lane) { return ((lane & 3) << 3) | (((lane >> 2) & 3) << 6) | (((lane >> 4) & 1) << 5) | (((lane >> 5) & 1) << 8); }
constexpr int v_rd_off(int d0, int ks, int half) { return d0 * 512 + ks * 4096 + half * 2048; }
__device__ __forceinline__ int crow(int r, int hi) { return (r & 3) + 8 * (r >> 2) + 4 * hi; }
__device__ __forceinline__ unsigned cvtpk(float lo, float hi) { unsigned r; asm volatile("v_cvt_pk_bf16_f32 %0, %1, %2" : "=v"(r) : "v"(lo), "v"(hi)); return r; }
__device__ __forceinline__ bf16x8 load8(const bf16* p) { return *reinterpret_cast<const bf16x8*>(p); }
__device__ __forceinline__ void mask_tile(f32x16& p0, f32x16& p1, int dq, unsigned Wu) {
    const float NEG = -__builtin_inff();
#pragma unroll
    for (int r = 0; r < 16; ++r) {
        const int c = (r & 3) + 8 * (r >> 2);
        if ((unsigned)(dq - c) >= Wu) p0[r] = NEG;
        if ((unsigned)(dq - c - 32) >= Wu) p1[r] = NEG;
    }
}
constexpr float THR2 = THR * 1.4426950408889634f;
__device__ __forceinline__ void partialSM(f32x16& p0, f32x16& p1, float& mref, float& alpha, bool first) {
    float pa = fmaxf(fmaxf(p0[0], p0[1]), p0[2]), pb = fmaxf(fmaxf(p1[0], p1[1]), p1[2]);
#pragma unroll
    for (int r = 3; r < 15; r += 2) { pa = fmaxf(fmaxf(pa, p0[r]), p0[r + 1]); pb = fmaxf(fmaxf(pb, p1[r]), p1[r + 1]); }
    float pmax = fmaxf(fmaxf(pa, pb), fmaxf(p0[15], p1[15]));
    { auto rr = __builtin_amdgcn_permlane32_swap(__float_as_uint(pmax), __float_as_uint(pmax), false, false);
      pmax = fmaxf(__uint_as_float(rr[0]), __uint_as_float(rr[1])); }
    if (__builtin_expect(!first && __all(pmax <= THR2), 1)) { alpha = 1.f; }
    else { const float d = first ? pmax : fmaxf(pmax, 0.f); alpha = __builtin_amdgcn_exp2f(-d); mref += d;
#pragma unroll
        for (int r = 0; r < 16; ++r) { p0[r] -= d; p1[r] -= d; } }
#pragma unroll
    for (int r = 0; r < 16; ++r) p0[r] = __builtin_amdgcn_exp2f(p0[r]);
}
__device__ __forceinline__ void finishSM(f32x16& p0, f32x16& p1, float alpha, float& l_reg, bf16x8& pa0, bf16x8& pa1, bf16x8& pa2, bf16x8& pa3) {
    for (int r = 0; r < 16; ++r) p1[r] = __builtin_amdgcn_exp2f(p1[r]);
    typedef float f32x2_ __attribute__((ext_vector_type(2)));
    f32x2_ sa = {p0[0], p0[1]}, sb = {p1[0], p1[1]};
#pragma unroll
    for (int r = 2; r < 16; r += 2) { sa += (f32x2_){p0[r], p0[r + 1]}; sb += (f32x2_){p1[r], p1[r + 1]}; }
    sa += sb; float ps = sa.x + sa.y;
    { auto rr = __builtin_amdgcn_permlane32_swap(__float_as_uint(ps), __float_as_uint(ps), false, false);
      ps = __uint_as_float(rr[0]) + __uint_as_float(rr[1]); }
    l_reg = l_reg * alpha + ps;
#define PK4(P, B_, OUT) do { unsigned a0 = cvtpk(P[B_+0], P[B_+1]), a1 = cvtpk(P[B_+2], P[B_+3]);                          \
        unsigned b0 = cvtpk(P[B_+4], P[B_+5]), b1 = cvtpk(P[B_+6], P[B_+7]);                                             \
        auto r0 = __builtin_amdgcn_permlane32_swap(a0, b0, false, false); auto r1 = __builtin_amdgcn_permlane32_swap(a1, b1, false, false); \
        u32x4 w = {r0[0], r1[0], r0[1], r1[1]}; OUT = *reinterpret_cast<bf16x8*>(&w); } while (0)
    PK4(p0, 0, pa0); PK4(p0, 8, pa1); PK4(p1, 0, pa2); PK4(p1, 8, pa3);
#undef PK4
}
template <int KB>
__device__ __forceinline__ void qkt(f32x16& p0, f32x16& p1, const char* K_lds, int r32, int hi, const bf16x8* qr, float mref) {
#pragma unroll
    for (int r = 0; r < 16; ++r) { p0[r] = -mref; p1[r] = -mref; }
#pragma unroll
    for (int d0 = 0; d0 < 4; ++d0) { const char* a = K_lds + KB * SHM_K + KSWZ(r32, (d0 * 16 + hi * 8) * 2);
        bf16x8 b0 = *reinterpret_cast<const bf16x8*>(a);
        bf16x8 b1 = *reinterpret_cast<const bf16x8*>(a + 32 * 128);
        p0 = __builtin_amdgcn_mfma_f32_32x32x16_bf16(b0, qr[d0], p0, 0, 0, 0);
        p1 = __builtin_amdgcn_mfma_f32_32x32x16_bf16(b1, qr[d0], p1, 0, 0, 0); }
}
template <int VB>
__device__ __forceinline__ void pv_tile(f32x16* o, int vb0, bf16x8 pa0, bf16x8 pa1, bf16x8 pa2, bf16x8 pa3) {
#define TRRD(dst, off) asm volatile("ds_read_b64_tr_b16 %0, %1 offset:%2" : "=&v"(dst) : "v"(vb0), "i"(off) : "memory")
#define PV_D0(d0) do { s16x4 l0, l1, l2, l3, h0, h1, h2, h3; constexpr int b_ = VB * SHM_V + v_rd_off(d0, 0, 0);   \
        TRRD(l0, b_); TRRD(h0, b_ + 2048); TRRD(l1, b_ + 4096); TRRD(h1, b_ + 6144); TRRD(l2, b_ + 8192); TRRD(h2, b_ + 10240); TRRD(l3, b_ + 12288); TRRD(h3, b_ + 14336); \
        asm volatile("s_waitcnt lgkmcnt(0)" ::: "memory"); SBAR();   \
        o[d0] = __builtin_amdgcn_mfma_f32_32x32x16_bf16(pa0, (bf16x8){l0[0], l0[1], l0[2], l0[3], h0[0], h0[1], h0[2], h0[3]}, o[d0], 0, 0, 0);   \
        o[d0] = __builtin_amdgcn_mfma_f32_32x32x16_bf16(pa1, (bf16x8){l1[0], l1[1], l1[2], l1[3], h1[0], h1[1], h1[2], h1[3]}, o[d0], 0, 0, 0);   \
        o[d0] = __builtin_amdgcn_mfma_f32_32x32x16_bf16(pa2, (bf16x8){l2[0], l2[1], l2[2], l2[3], h2[0], h2[1], h2[2], h2[3]}, o[d0], 0, 0, 0);   \
        o[d0] = __builtin_amdgcn_mfma_f32_32x32x16_bf16(pa3, (bf16x8){l3[0], l3[1], l3[2], l3[3], h3[0], h3[1], h3[2], h3[3]}, o[d0], 0, 0, 0); } while (0)
    PV_D0(0); PV_D0(1); PV_D0(2); PV_D0(3);
#undef PV_D0
#undef TRRD
}
struct BlockRef { const bf16* Q; const bf16* K; const bf16* V; bf16* O; int P0; };
struct Seam { bf16x8 qr[4]; bf16x8 st_v0, st_v1, st_k0; };
#define VMW() asm volatile("s_waitcnt vmcnt(0)" ::: "memory")
#define VMWN(n) asm volatile("s_waitcnt vmcnt(%0)" :: "i"(n) : "memory")
#define SLOAD_H(Kp, Vp, k0) do { S.st_v0 = load8((Vp) + (size_t)((k0) + sr) * PV + sc); S.st_v1 = load8((Vp) + (size_t)((k0) + 32 + sr) * PV + sc);              \
                         S.st_k0 = load8((Kp) + (size_t)((k0) + srk) * PK + sck); } while (0)
#define SWRITE_HK(bf) do { *(bf16x8*)(K_lds + (bf) * SHM_K + kws) = S.st_k0; } while (0)
#define SWRITE_HV(bf) do { *(bf16x8*)(V_lds + (bf) * SHM_V + vst0) = S.st_v0; *(bf16x8*)(V_lds + (bf) * SHM_V + vst1) = S.st_v1; } while (0)
#define SWRITE_H(bf) do { SWRITE_HV(bf); SWRITE_HK(bf); } while (0)
__device__ __forceinline__ void prime(const BlockRef& cur, char* lds, Seam& S) {
    int tid_ = threadIdx.x; asm volatile("" : "+v"(tid_));
    const int tid = tid_, wid = __builtin_amdgcn_readfirstlane(tid >> 6), lane = tid & 63, r32 = lane & 31, hi = lane >> 5;
    const int sr = tid >> 4, sc = (tid & 15) * 8, srk = tid >> 3, sck = (tid & 7) * 8, kws = KSWZ(srk, sck * 2); char* K_lds = lds + 2 * SHM_V;
    const int rbw = (wid < 4) ? wid : 11 - wid;
    for (int d0 = 0; d0 < 4; ++d0) S.qr[d0] = load8(cur.Q + (size_t)(rbw * QBLK + r32) * PQ + d0 * 16 + hi * 8);
    SLOAD_H(cur.K, cur.V, 0); VMW(); SWRITE_HK(0);
    __syncthreads();
}
constexpr int PARK_OFF = 53248, PARK_WAVE = 8192;
template <int MODE>
__device__ __forceinline__ void block(const BlockRef& cur, const BlockRef& nxt, char* lds, Seam& S, float lam, float post, const float* sg) {
    int tid_ = threadIdx.x; asm volatile("" : "+v"(tid_));
    const int tid = tid_, wid = __builtin_amdgcn_readfirstlane(tid >> 6), lane = tid & 63, r32 = lane & 31, hi = lane >> 5;
    const int NT = (cur.P0 + QB - 1) / KVBLK + 1;
    const int rbw = (wid < 4) ? wid : 11 - wid;
    const int qlo = cur.P0 + rbw * QBLK, qm = qlo + r32 - 4 * hi;
    const int TL = (qlo + QBLK - 1) >> 6;
    char* V_lds = lds; char* K_lds = lds + 2 * SHM_V;
    float* ws = (float*)(lds + 2 * SHM_V + 2 * SHM_K) + wid * 64; float* li_l = ws, * al_l = ws + 32;
    float mref = 0.f, l_reg = 0; f32x16 o[4] = {};
    const int sr = tid >> 4, sc = (tid & 15) * 8, vst0 = v_st(sr, sc), vst1 = v_st(32 + sr, sc), srk = tid >> 3, sck = (tid & 7) * 8, kws = KSWZ(srk, sck * 2);
    const int vb0 = (int)(uintptr_t)V_lds + v_rd_base(lane);
    const bf16* Kh = cur.K; const bf16* Vh = cur.V;
#define RESC(a) do { if (__any((a) < 1.f)) { if (hi == 0) al_l[r32] = (a); asm volatile("s_waitcnt lgkmcnt(0)" ::: "memory");              \
                     for (int d_ = 0; d_ < 4; ++d_) for (int r = 0; r < 16; ++r) o[d_][r] *= al_l[crow(r, hi)]; } } while (0)
#define KBASE(t) ((t) * KVBLK)
#define MASKT(P0_, P1_, t) do { const int kb_ = KBASE(t); if (kb_ + KVBLK - 1 > qlo) { asm volatile("; diagonal tile: mask" ::: "memory");     \
        mask_tile(P0_, P1_, qm - kb_, (unsigned)W); } } while (0)
    constexpr int NQL = 4;
#define SEAM_K0() do { VMWN(NQL); SWRITE_HK(0); SBAR(); } while (0)
    f32x16 pA0, pA1, pB0, pB1; float alA, alB;
    SWRITE_HV(0); SBAR();
    if (NT > 1) SLOAD_H(Kh, Vh, KBASE(1));
    SBAR(); qkt<0>(pA0, pA1, K_lds, r32, hi, S.qr, mref);
    MASKT(pA0, pA1, 0); partialSM(pA0, pA1, mref, alA, true);
    if (NT > 1) { VMW(); SWRITE_H(1); }
    __syncthreads();
#define HALF_STEP(PX0, PX1, alX, PY0, PY1, alY, t, KB, VB, SB) do { bf16x8 pa0, pa1, pa2, pa3;                              \
        SBAR(); qkt<KB>(PX0, PX1, K_lds, r32, hi, S.qr, mref);                                                                \
        finishSM(PY0, PY1, alY, l_reg, pa0, pa1, pa2, pa3); SBAR();                                                           \
        if ((t) + 1 < NT) { SLOAD_H(Kh, Vh, KBASE((t) + 1)); SBAR(); }                                                        \
        pv_tile<VB>(o, vb0, pa0, pa1, pa2, pa3); MASKT(PX0, PX1, (t)); partialSM(PX0, PX1, mref, alX, false);                  \
        __syncthreads();                                                                                                      \
        if ((t) + 1 < NT) { VMW(); SWRITE_H(SB); }                                                                            \
        RESC(alX); __syncthreads(); } while (0)
#define HALF_STEP_C(PX0, PX1, alX, PY0, PY1, alY, t, KB, VB, SB) do { bf16x8 pa0, pa1, pa2, pa3;                            \
        SBAR(); if ((t) <= TL) qkt<KB>(PX0, PX1, K_lds, r32, hi, S.qr, mref);                                                 \
        if ((t) - 1 <= TL) finishSM(PY0, PY1, alY, l_reg, pa0, pa1, pa2, pa3); SBAR();                                        \
        if ((t) + 1 < NT) { SLOAD_H(Kh, Vh, KBASE((t) + 1)); SBAR(); }                                                        \
        if ((t) - 1 <= TL) pv_tile<VB>(o, vb0, pa0, pa1, pa2, pa3);                                                           \
        if ((t) <= TL) { MASKT(PX0, PX1, (t)); partialSM(PX0, PX1, mref, alX, false); } else alX = 1.f;                        \
        __syncthreads();                                                                                                      \
        if ((t) + 1 < NT) { VMW(); SWRITE_H(SB); }                                                                            \
        RESC(alX); __syncthreads(); } while (0)
    for (int t = 1; t + 3 < NT; t += 2) {
        HALF_STEP(pB0, pB1, alB, pA0, pA1, alA, t, 1, 0, 0);
        HALF_STEP(pA0, pA1, alA, pB0, pB1, alB, t + 1, 0, 1, 1);
    }
    HALF_STEP(pB0, pB1, alB, pA0, pA1, alA, NT - 3, 1, 0, 0);
    HALF_STEP_C(pA0, pA1, alA, pB0, pB1, alB, NT - 2, 0, 1, 1);
    const bool even = (NT & 1) == 0;
    if (even) { SBAR(); if (NT - 1 <= TL) qkt<1>(pB0, pB1, K_lds, r32, hi, S.qr, mref); SBAR(); }
    SLOAD_H(nxt.K, nxt.V, 0); SBAR();
#pragma unroll
    for (int d0 = 0; d0 < 4; ++d0) S.qr[d0] = load8(nxt.Q + (size_t)(rbw * QBLK + r32) * PQ + d0 * 16 + hi * 8);
    SBAR();
    if (NT - 2 <= TL) { bf16x8 pa0, pa1, pa2, pa3; finishSM(pA0, pA1, alA, l_reg, pa0, pa1, pa2, pa3); SBAR();
        pv_tile<0>(o, vb0, pa0, pa1, pa2, pa3); }
    if (even) { if (NT - 1 <= TL) { MASKT(pB0, pB1, NT - 1); partialSM(pB0, pB1, mref, alB, false); } else alB = 1.f;
        __syncthreads(); RESC(alB);
        if (NT - 1 <= TL) { bf16x8 pa0, pa1, pa2, pa3; finishSM(pB0, pB1, alB, l_reg, pa0, pa1, pa2, pa3); SBAR(); pv_tile<1>(o, vb0, pa0, pa1, pa2, pa3); } }
    SBAR(); SEAM_K0();
    if (hi == 0) li_l[r32] = l_reg; asm volatile("s_waitcnt lgkmcnt(0)" ::: "memory");
    float rli[16];
#pragma unroll
    for (int r = 0; r < 16; ++r) rli[r] = __builtin_amdgcn_rcpf(li_l[crow(r, hi)]);
    unsigned* park = (unsigned*)(lds + PARK_OFF + wid * PARK_WAVE) + lane;
    if (MODE == 0) {
#pragma unroll
        for (int r = 0; r < 16; ++r) { park[(2 * r) * 64] = cvtpk(o[0][r] * rli[r], o[1][r] * rli[r]); park[(2 * r + 1) * 64] = cvtpk(o[2][r] * rli[r], o[3][r] * rli[r]); }
    } else {
        float gsub[4];
#pragma unroll
        for (int d0 = 0; d0 < 4; ++d0) gsub[d0] = sg[d0 * 32 + r32];
        bf16* Ow = cur.O + (size_t)(rbw * QBLK) * 1024;
#pragma unroll
        for (int r = 0; r < 16; ++r) { const unsigned w0 = park[(2 * r) * 64], w1 = park[(2 * r + 1) * 64];
            float x[4] = {__uint_as_float(w0 << 16) - lam * (o[0][r] * rli[r]), __uint_as_float(w0 & 0xffff0000u) - lam * (o[1][r] * rli[r]),
                          __uint_as_float(w1 << 16) - lam * (o[2][r] * rli[r]), __uint_as_float(w1 & 0xffff0000u) - lam * (o[3][r] * rli[r])};
            float ss = (x[0] * x[0] + x[1] * x[1]) + (x[2] * x[2] + x[3] * x[3]);
            ss += __shfl_xor(ss, 1); ss += __shfl_xor(ss, 2); ss += __shfl_xor(ss, 4); ss += __shfl_xor(ss, 8); ss += __shfl_xor(ss, 16);
            const float rstd = rsqrtf(ss * (1.0f / 128.0f) + 1e-5f) * post; const int orow = crow(r, hi);
#pragma unroll
            for (int d0 = 0; d0 < 4; ++d0) { const float v = x[d0] * rstd * gsub[d0]; const float vn = __shfl_xor(v, 1);
                if ((r32 & 1) == 0) *(unsigned*)(Ow + (size_t)orow * 1024 + d0 * 32 + r32) = cvtpk(v, vn); } }
    }
    __syncthreads();
#undef RESC
#undef KBASE
#undef MASKT
#undef SEAM_K0
#undef HALF_STEP
#undef HALF_STEP_C
}
#undef VMW
#undef VMWN
#undef SLOAD_H
#undef SWRITE_HK
#undef SWRITE_HV
#undef SWRITE_H
#undef KSWZ
#undef SBAR
}
#define GAS __attribute__((address_space(1)))
#define LAS __attribute__((address_space(3)))
typedef unsigned short bf16;
typedef unsigned v4u __attribute__((ext_vector_type(4)));
typedef float f32x4 __attribute__((ext_vector_type(4)));
typedef short bf16x8 __attribute__((ext_vector_type(8)));
typedef GAS unsigned gu32;
typedef GAS unsigned long long gu64;
#define RLX_AGENT __ATOMIC_RELAXED, __HIP_MEMORY_SCOPE_AGENT
#define LDS_WAIT() asm volatile("s_waitcnt lgkmcnt(0)" ::: "memory")
#define VM_WAIT() asm volatile("s_waitcnt vmcnt(0)" ::: "memory")
__device__ __forceinline__ unsigned long long rt() { return __builtin_amdgcn_s_memrealtime(); }
__device__ __forceinline__ unsigned f2bf(float f) { unsigned u = __builtin_bit_cast(unsigned, f); return (u + 0x7fffu + ((u >> 16) & 1u)) >> 16; }
__device__ __forceinline__ unsigned pk2(float lo, float hi) { return f2bf(lo) | (f2bf(hi) << 16); }

#define XB_TMO      128
#define XB_XCNT(j)  (256  + 64 * (j))
#define XB_XSUB(j)  (1280 + 64 * (j))
#define XB_XGEN(j)  (2304 + 64 * (j))
#define XB_TOP      3328
#define XB_TOPGEN   3392
#define XCD_BAR_WORDS 3456
#define XB_SPIN_CAP (1u << 18)

__device__ __forceinline__ unsigned xb_ld(unsigned* p)              { return __hip_atomic_load(p, __ATOMIC_RELAXED, __HIP_MEMORY_SCOPE_AGENT); }
__device__ __forceinline__ unsigned xb_add(unsigned* p, unsigned v) { return __hip_atomic_fetch_add(p, v, __ATOMIC_RELAXED, __HIP_MEMORY_SCOPE_AGENT); }
__device__ __forceinline__ unsigned xb_xcc_id() { return (unsigned)__builtin_amdgcn_s_getreg((3 << 11) | 20) & 0xFu; }
#define XB_SPIN(cond, bar) do { unsigned _sp = 0; while (cond) { __builtin_amdgcn_s_sleep(1); \
    if ((++_sp & 255u) == 0u) { if (xb_ld(&(bar)[XB_TMO])) break; if (_sp > XB_SPIN_CAP) { atomicAdd(&(bar)[XB_TMO], 1u); break; } } } } while (0)

struct XcdBarrier {
    unsigned* bar; unsigned x;
    volatile LAS unsigned* st;
};

__device__ __forceinline__ XcdBarrier xcd_barrier_post(unsigned* bar, volatile LAS unsigned* st) {
    XcdBarrier b; b.bar = bar; b.x = xb_xcc_id(); b.st = st;
    if (threadIdx.x == 0) (void)xb_add(&bar[XB_XCNT(b.x)], 1u);
    return b;
}
__device__ __forceinline__ void xcd_barrier_complete(unsigned* bar, unsigned x, unsigned& nloc, unsigned& nx) {
    const unsigned G = gridDim.x * gridDim.y * gridDim.z;
    unsigned sum, cnt, mine, sp = 0u;
    for (;;) {
        sum = 0u; cnt = 0u; mine = 0u;
#pragma unroll
        for (unsigned j = 0; j < 16; ++j) { const unsigned c = xb_ld(&bar[XB_XCNT(j)]); sum += c; cnt += (c > 0u) ? 1u : 0u; mine = (j == x) ? c : mine; }
        if (sum == G) break;
        __builtin_amdgcn_s_sleep(1);
        if ((++sp & 255u) == 0u) { if (xb_ld(&bar[XB_TMO])) break; if (sp > XB_SPIN_CAP) { atomicAdd(&bar[XB_TMO], 1u); break; } }
    }
    nloc = mine > 0u ? mine : 1u; nx = cnt > 0u ? cnt : 1u;
}

__device__ __forceinline__ void xcd_barrier(const XcdBarrier& b) {
    asm volatile("s_waitcnt vmcnt(0)" ::: "memory");
    __syncthreads();
    if (threadIdx.x == 0) {
        unsigned* bar = b.bar;
        __builtin_amdgcn_s_waitcnt(0);
        unsigned nloc = b.st[0], nx = b.st[1];
        if (nloc == 0u) { xcd_barrier_complete(bar, b.x, nloc, nx); b.st[0] = nloc; b.st[1] = nx; }
        const unsigned old = xb_add(&bar[XB_XSUB(b.x)], 1u);
        const unsigned gen = old / nloc;
        if (old + 1u == (gen + 1u) * nloc) {
            __builtin_amdgcn_fence(__ATOMIC_RELEASE, "agent");
            asm volatile("s_waitcnt vmcnt(0)" ::: "memory");
            const unsigned og = xb_add(&bar[XB_TOP], 1u);
            const unsigned tg = og / nx;
            if (og + 1u == (tg + 1u) * nx) xb_add(&bar[XB_TOPGEN], 1u);
            else XB_SPIN(xb_ld(&bar[XB_TOPGEN]) == tg, bar);
            __builtin_amdgcn_fence(__ATOMIC_ACQUIRE, "agent");
            xb_add(&bar[XB_XGEN(b.x)], 1u);
            asm volatile("s_waitcnt vmcnt(0)" ::: "memory");
        } else {
            XB_SPIN(xb_ld(&bar[XB_XGEN(b.x)]) == gen, bar);
            __builtin_amdgcn_fence(__ATOMIC_ACQUIRE, "agent");
            asm volatile("s_waitcnt vmcnt(0)" ::: "memory");
        }
    }
    __syncthreads();
}


#ifndef EPIRES_ALIGN
#define EPIRES_ALIGN true
#endif
#ifndef PROBE_SKIP
#define PROBE_SKIP 0
#endif
#ifndef PROBE_DUP
#define PROBE_DUP 0
#endif
#define REP(k) _Pragma("unroll 1") for (int rep_ = 0; rep_ < ((PROBE_DUP == (k)) ? 2 : 1); ++rep_)
#ifndef PH_MASK
#define PH_MASK 0xffff
#endif
#define PHM(b) ((PH_MASK >> (b)) & 1)
struct Frame {
    LAS unsigned char* lds;
    volatile LAS unsigned* MISC;
    gu32* ctl;
    int tid, lane, wave;
    int vcu, G;
    unsigned char* ws;
};
__device__ __forceinline__ const void* ld_arg(int i) {
    const void* ka = (const void*)__builtin_amdgcn_kernarg_segment_ptr(); unsigned long long p;
    asm volatile("s_load_dwordx2 %0, %1, %2\n\ts_waitcnt lgkmcnt(0)" : "=s"(p) : "s"(ka), "s"(i * 8) : "memory");
    return (const void*)p;
}
#define PHASE_FRAME Frame F = F0; { size_t z_ = 0; asm volatile("" : "+s"(z_)); F.ws = F0.ws + z_;     \
    int t_ = threadIdx.x; asm volatile("" : "+v"(t_)); F.tid = t_; F.lane = t_ & 63; F.wave = __builtin_amdgcn_readfirstlane(t_ >> 6); }
#define ARGP(T, i) ((T*)(F.ws + ((size_t)ld_arg(i) - (size_t)F.ws)))
#define INF(i) ARGP(const float, i)
#define WSF(off) ((float*)(F.ws + (off)))
#define WSB(off) ((bf16*)(F.ws + (off)))
__device__ __forceinline__ float wave_sum(float v) {
#pragma unroll
    for (int o = 1; o < 64; o <<= 1) v += __shfl_xor(v, o);
    return v;
}
__device__ __forceinline__ float bflo(unsigned w) { return __uint_as_float(w << 16); }
__device__ __forceinline__ float bfhi(unsigned w) { return __uint_as_float(w & 0xffff0000u); }
typedef unsigned u32x2 __attribute__((ext_vector_type(2)));

typedef float f32x16_sg __attribute__((ext_vector_type(16)));
constexpr int SG_AP = 1028;
template <bool SILU>
__device__ __forceinline__ void small_gemm_unit(Frame& F, const float* A, int lda, const float* W, int ldw, int N, int n0, const float* bias, float* out, int ldo) {
    LAS float* As = (LAS float*)(F.lds + RING_OFF);
    int tl_ = F.tid; asm volatile("" : "+v"(tl_)); const int tidl = tl_, lanel = tl_ & 63, r = tl_ & 31, hi = (tl_ >> 5) & 1;
    for (int i = tidl; i < 8192; i += NWAVES * 64) { const int b = i >> 8, k4 = (i & 255) * 4;
        f32x4 v = *(const f32x4*)(A + (size_t)b * lda + k4);
        if (SILU) {
#pragma unroll
            for (int e = 0; e < 4; ++e) v[e] = v[e] / (1.0f + expf(-v[e])); }
        *(LAS f32x4*)(As + b * SG_AP + k4) = v; }
    __syncthreads();
    const int c0 = n0 + r, c1 = n0 + 32 + r;
    const unsigned wstride = (unsigned)ldw * 4u;
    unsigned woff0 = ((unsigned)(F.wave * 128 + 4 * hi) * (unsigned)ldw + (unsigned)(c0 < N ? c0 : n0)) * 4u;
    const unsigned wd1 = (unsigned)((c1 < N ? c1 : n0) - (c0 < N ? c0 : n0)) * 4u;
    f32x16_sg acc0 = {}, acc1 = {};
    float ba[32], bb[32];
#define SG_LD(bx) do { _Pragma("unroll") for (int s_ = 0; s_ < 4; ++s_) { _Pragma("unroll") for (int i_ = 0; i_ < 4; ++i_) { const unsigned o_ = woff0 + (unsigned)i_ * wstride; \
        bx[s_ * 8 + i_] = *(const float*)((const char*)W + o_); bx[s_ * 8 + 4 + i_] = *(const float*)((const char*)W + (unsigned)(o_ + wd1)); } woff0 += 8u * wstride; } } while (0)
    SG_LD(ba);
#pragma unroll 1
    for (int g = 0; g < 4; ++g) {
        if (g < 3) SG_LD(bb);
        const LAS float* ap = As + r * SG_AP + F.wave * 128 + g * 32 + 4 * hi;
#pragma unroll
        for (int s_ = 0; s_ < 4; ++s_) { const f32x4 a4 = *(const LAS f32x4*)(ap + s_ * 8);
#pragma unroll
            for (int i_ = 0; i_ < 4; ++i_) { acc0 = __builtin_amdgcn_mfma_f32_32x32x2f32(a4[i_], ba[s_ * 8 + i_], acc0, 0, 0, 0); acc1 = __builtin_amdgcn_mfma_f32_32x32x2f32(a4[i_], ba[s_ * 8 + 4 + i_], acc1, 0, 0, 0); } }
#pragma unroll
        for (int j = 0; j < 32; ++j) ba[j] = bb[j];
    }
#undef SG_LD
    __syncthreads();
    LAS float* red = As;
#pragma unroll
    for (int i = 0; i < 16; ++i) { const int b = (i & 3) + 8 * (i >> 2) + 4 * hi; red[(F.wave * 32 + b) * 64 + r] = acc0[i]; red[(F.wave * 32 + b) * 64 + 32 + r] = acc1[i]; }
    __syncthreads();
#pragma unroll
    for (int j = 0; j < 4; ++j) { const int o = tidl + 512 * j, b = o >> 6, cc = o & 63; float s = 0.f;
#pragma unroll
        for (int w = 0; w < 8; ++w) s += red[(w * 32 + b) * 64 + cc];
        const int n = n0 + cc; if (n < N) out[(size_t)b * ldo + n] = s + (bias ? bias[n] : 0.f); }
    __syncthreads();
}
__device__ __forceinline__ void p0_transpose_item(const float* W, int ldw, int K, int ncols, bf16* WT, LAS float* scr, int item, int lane) {
    const int nblk = ncols / 32, kb = item / nblk, nb = item % nblk, k0 = 64 * kb, n0 = 32 * nb;
    float tv[32];
#pragma unroll
    for (int i = 0; i < 32; ++i) tv[i] = W[(size_t)(k0 + 2 * i + (lane >> 5)) * ldw + n0 + (lane & 31)];
#pragma unroll
    for (int i = 0; i < 32; ++i) scr[(2 * i + (lane >> 5)) * 33 + (lane & 31)] = tv[i];
    LDS_WAIT(); asm volatile("" ::: "memory");
    const int c = lane & 7;
#pragma unroll
    for (int j = 0; j < 4; ++j) { const int n = (lane >> 3) + 8 * j; const LAS float* s = scr + (8 * c) * 33 + n;
        v4u o; o.x = pk2(s[0 * 33], s[1 * 33]); o.y = pk2(s[2 * 33], s[3 * 33]); o.z = pk2(s[4 * 33], s[5 * 33]); o.w = pk2(s[6 * 33], s[7 * 33]);
        *(GAS v4u*)(WT + (size_t)(n0 + n) * K + k0 + 8 * c) = o; }
    LDS_WAIT(); asm volatile("" ::: "memory");
}
__device__ __forceinline__ void sincos_d(double a, double& s, double& c) {
    const double k = rint(a * 0.63661977236758134308);
    const double r = fma(-k, 6.123233995736766e-17, fma(-k, 1.5707963267948966, a));
    const int q = ((int)k) & 3;
    const double r2 = r * r;
    double sp = 1.0 / 6227020800.0; sp = sp * r2 - 1.0 / 39916800.0; sp = sp * r2 + 1.0 / 362880.0; sp = sp * r2 - 1.0 / 5040.0; sp = sp * r2 + 1.0 / 120.0; sp = sp * r2 - 1.0 / 6.0; sp = sp * r2 + 1.0;
    const double sr = r * sp;
    double cp = -1.0 / 87178291200.0; cp = cp * r2 + 1.0 / 479001600.0; cp = cp * r2 - 1.0 / 3628800.0; cp = cp * r2 + 1.0 / 40320.0; cp = cp * r2 - 1.0 / 720.0; cp = cp * r2 + 1.0 / 24.0; cp = cp * r2 - 0.5; cp = cp * r2 + 1.0;
    const double cr = cp;
    s = (q == 0) ? sr : (q == 1) ? cr : (q == 2) ? -sr : -cr;
    c = (q == 0) ? cr : (q == 1) ? -sr : (q == 2) ? -cr : sr;
}
__device__ __forceinline__ int tr_early(int k) { return k < 2048 ? k : k < 4096 ? 8192 + (k - 2048) : k < 5632 ? 16384 + (k - 4096) : 19456 + (k - 5632); }
__device__ __forceinline__ int tr_late(int k) { return k < 6144 ? 2048 + k : k < 12288 ? 10240 + (k - 6144) : k < 13824 ? 17920 + (k - 12288) : k < 14336 ? 19968 + (k - 13824) : 20480 + (k - 14336); }
__device__ __forceinline__ void transpose_range(Frame& F, int first, int stride, bool late) {
    const float* in_w_up = INF(7); const float* in_w_down = INF(8); const float* in_w_in = INF(9); const float* in_w_mo = INF(12); const float* in_kv_w = INF(16); const float* in_w_q = INF(17); const float* in_w_do = INF(20);
    LAS float* scr = (LAS float*)(F.lds + RING_OFF + F.wave * 16384);
    const int n = late ? 17408 : 6144;
    for (int k = first; k < n; k += stride) {
        const float* W; bf16* WT; int ldw, K, nc, r = late ? tr_late(k) : tr_early(k);
        if (r < 8192) { const int l = r >> 11; r &= 2047; W = in_w_up + (size_t)l * D * FF; WT = WSB(WS_WUP) + (size_t)l * D * FF; ldw = FF; K = D; nc = FF; }
        else if (r < 16384) { r -= 8192; const int l = r >> 11; r &= 2047; W = in_w_down + (size_t)l * D * FF; WT = WSB(WS_WDN) + (size_t)l * D * FF; ldw = D; K = FF; nc = D; }
        else if (r < 19456) { r -= 16384; const int l = r / 1536; r -= l * 1536; W = in_w_in + (size_t)l * D * A_IN; WT = WSB(WS_WIN) + (size_t)l * D * A_INP; ldw = A_IN; K = D; nc = A_INP; }
        else if (r < 20480) { r -= 19456; const int l = r >> 9; r &= 511; W = in_w_mo + (size_t)l * D * D; WT = WSB(WS_WMO) + (size_t)l * D * D; ldw = D; K = D; nc = D; }
        else if (r < 21504) { r -= 20480; W = in_kv_w; WT = WSB(WS_WKV); ldw = 2048; K = D; nc = 2048; }
        else if (r < 22528) { r -= 21504; const int l = r >> 9; r &= 511; W = in_w_q + (size_t)l * D * D; WT = WSB(WS_WQ) + (size_t)l * D * D; ldw = D; K = D; nc = D; }
        else { r -= 22528; const int l = r >> 9; r &= 511; W = in_w_do + (size_t)l * D * D; WT = WSB(WS_WDO) + (size_t)l * D * D; ldw = D; K = D; nc = D; }
        p0_transpose_item(W, ldw, K, nc, WT, scr, r, F.lane);
    }
}
__device__ __forceinline__ void bias_range(Frame& F, int first, int stride, bool late) {
    const float* in_w_in = INF(9); const float* in_w_up = INF(7); const float* in_kv_w = INF(16); const float* in_w_q = INF(17);
    const int n = late ? 305 : 113;
    for (int k = first; k < n; k += stride) {
        const int u = late ? (k < 49 ? 49 + k : 162 + (k - 49)) : (k < 49 ? k : 98 + (k - 49));
        const float *A, *W; float* out; int lda, ld, n0;
        if (u < 98) { const int l = u / 49, ch = u % 49; A = WSF(WS_MODS) + (size_t)l * 32 * 6144; lda = 6144; W = in_w_in + (size_t)l * D * A_IN; ld = A_IN; out = WSF(WS_B_IN) + (size_t)l * 32 * A_IN; n0 = ch * 64; }
        else if (u < 354) { const int l = (u - 98) >> 6, ch = (u - 98) & 63; A = WSF(WS_MODS) + (size_t)l * 32 * 6144 + 3072; lda = 6144; W = in_w_up + (size_t)l * D * FF; ld = FF; out = WSF(WS_B_UP) + (size_t)l * 32 * FF; n0 = ch * 64; }
        else if (u < 386) { A = WSF(WS_KVMOD); lda = 2048; W = in_kv_w; ld = 2048; out = WSF(WS_B_KV); n0 = (u - 354) * 64; }
        else { const int j = (u - 386) >> 4, ch = (u - 386) & 15; A = WSF(WS_MODS) + (size_t)(2 + j) * 32 * 6144; lda = 6144; W = in_w_q + (size_t)j * D * D; ld = D; out = WSF(WS_B_Q) + (size_t)j * 32 * D; n0 = ch * 64; }
        small_gemm_unit<false>(F, A, lda, W, ld, ld, n0, nullptr, out, ld);
    }
}
__device__ __forceinline__ void deferred_prologue(const Frame& F0) {
    PHASE_FRAME;
    const int v = (int)blockIdx.x - 128, NV = F.G - 128;
    bias_range(F, v, NV, true);
    transpose_range(F, v * NWAVES + F.wave, NV * NWAVES, true);
    const int* in_pos = ARGP(const int, 2); const float* in_lam_p = INF(18);
    const int gt = v * (NWAVES * 64) + F.tid, NGT = NV * NWAVES * 64;
    for (int i = gt; i < M * 8; i += NGT) { const int m = i >> 3, j = i & 7;
        const float inv = (j == 0) ? 1.0f : (j == 1) ? 0.1939227432012558f : (j == 2) ? 0.03760603070259094f : (j == 3) ? 0.007292664609849453f : (j == 4) ? 0.0014142135623842478f
                        : (j == 5) ? 0.00027424818836152554f : (j == 6) ? 5.318296098266728e-05f : 1.0313386155758053e-05f;
        const float ang = (float)in_pos[m] * inv; double s, c; sincos_d((double)ang, s, c);
        WSF(WS_ROPE)[(size_t)m * 16 + j] = (float)c; WSF(WS_ROPE)[(size_t)m * 16 + 8 + j] = (float)s; }
    if (v == 0 && F.tid < 2) { const float* lp = in_lam_p + F.tid * 256; float s1 = 0.f, s2 = 0.f;
        for (int i = 0; i < 64; ++i) { s1 += lp[i] * lp[64 + i]; s2 += lp[128 + i] * lp[192 + i]; }
        WSF(WS_LAM)[F.tid] = expf(s1) - expf(s2) + (F.tid == 0 ? 0.4707130183435842f : 0.5560582041556406f); }
}
__device__ __forceinline__ void p0a(const Frame& F0) {
    PHASE_FRAME;
    const float* in_c = INF(1); const float* in_ada_w = INF(3); const float* in_ada_b = INF(4); const float* in_kv_ada_w = INF(14); const float* in_kv_ada_b = INF(15); const float* in_w_up = INF(7); const float* in_w_down = INF(8); const float* in_w_in = INF(9); const float* in_w_mo = INF(12); const float* in_kv_w = INF(16); const float* in_w_q = INF(17); const float* in_w_do = INF(20); const int* in_pos = ARGP(const int, 2); const float* in_lam_p = INF(18);
    for (int u = F.vcu; u < 416; u += F.G) {
        const float *W, *bias; float* out; int ld, n0;
        if (u < 384) { const int l = u / 96, ch = u % 96; W = in_ada_w + (size_t)l * 1024 * 6144; bias = in_ada_b + l * 6144; out = WSF(WS_MODS) + (size_t)l * 32 * 6144; ld = 6144; n0 = ch * 64; }
        else { W = in_kv_ada_w; bias = in_kv_ada_b; out = WSF(WS_KVMOD); ld = 2048; n0 = (u - 384) * 64; }
        small_gemm_unit<true>(F, in_c, 1024, W, ld, ld, n0, bias, out, ld);
    }
    transpose_range(F, F.vcu * NWAVES + F.wave, F.G * NWAVES, false);
    const int gt = F.vcu * (NWAVES * 64) + F.tid, NGT = F.G * NWAVES * 64;
    for (int i = gt; i < 2 * 8 * 1024; i += NGT) { const int l = i >> 13, j = (i >> 10) & 7, k = i & 1023; WSF(WS_WG)[i] = in_w_in[(size_t)l * D * A_IN + (size_t)k * A_IN + A_INP + j]; }
}
__device__ __forceinline__ void p0b(const Frame& F0) {
    PHASE_FRAME;
    const float* in_w_in = INF(9); const float* in_w_up = INF(7); const float* in_kv_w = INF(16); const float* in_w_q = INF(17); const float* in_norm_mix_g = INF(5); const float* in_norm_mlp_g = INF(6); const float* in_kv_norm_g = INF(13); const float* in_x = INF(0); float* in_out = ARGP(float, 22);
    bias_range(F, F.vcu, F.G, false);
    const int gt = F.vcu * (NWAVES * 64) + F.tid, NGT = F.G * NWAVES * 64;
    for (int i = gt; i < 4 * 32 * 1024; i += NGT) { const int l = i >> 15, b = (i >> 10) & 31, k = i & 1023;
        WSF(WS_GM_MIX)[i] = in_norm_mix_g[l * 1024 + k] * (1.0f + WSF(WS_MODS)[(size_t)l * 32 * 6144 + (size_t)b * 6144 + 1024 + k]);
        WSF(WS_GM_MLP)[i] = in_norm_mlp_g[l * 1024 + k] * (1.0f + WSF(WS_MODS)[(size_t)l * 32 * 6144 + (size_t)b * 6144 + 4096 + k]); }
    for (int i = gt; i < 32 * 1024; i += NGT) { const int b = i >> 10, k = i & 1023; WSF(WS_GM_KV)[i] = in_kv_norm_g[k] * (1.0f + WSF(WS_KVMOD)[(size_t)b * 2048 + 1024 + k]); }
    const int gw = F.vcu * NWAVES + F.wave, NGW = F.G * NWAVES;
    for (int m0 = 4 * gw; m0 < M; m0 += 4 * NGW) {
        const int b = m0 >> 11; f32x4 v[4][4];
#pragma unroll
        for (int i = 0; i < 4; ++i)
#pragma unroll
            for (int j = 0; j < 4; ++j) v[i][j] = *(const f32x4*)(in_x + (size_t)(m0 + i) * D + 4 * F.lane + 256 * j);
        f32x4 gmv[4];
#pragma unroll
        for (int j = 0; j < 4; ++j) { const int c = 4 * F.lane + 256 * j; const f32x4 g = *(const f32x4*)(in_norm_mix_g + c), sc = *(const f32x4*)(WSF(WS_MODS) + (size_t)b * 6144 + 1024 + c); gmv[j] = g * (sc + 1.0f); }
#pragma unroll
        for (int i = 0; i < 4; ++i) { const int m = m0 + i; bf16* orow = (bf16*)in_out + (size_t)m * D; bf16* gr = WSB(WS_XG) + (size_t)m * D; float ss = 0.f;
#pragma unroll
            for (int j = 0; j < 4; ++j) { const int c = 4 * F.lane + 256 * j; const f32x4 x = v[i][j]; { u32x2 xb; xb.x = pk2(x[0], x[1]); xb.y = pk2(x[2], x[3]); *(u32x2*)(orow + c) = xb; }
                ss += (x[0] * x[0] + x[1] * x[1]) + (x[2] * x[2] + x[3] * x[3]);
                const f32x4 y = x * gmv[j]; u32x2 w; w.x = pk2(y[0], y[1]); w.y = pk2(y[2], y[3]); *(u32x2*)(gr + c) = w; }
            ss = wave_sum(ss);
            if (F.lane < 16) WSF(WS_SSQ)[(size_t)m * 16 + F.lane] = (F.lane == 0) ? ss : 0.f; }
    }
}
__device__ __forceinline__ void gates_phase(const Frame& F0, int l) {
    PHASE_FRAME;
    const float* in_b_gates = INF(10);
    const float* WGl = WSF(WS_WG) + l * 8192;
    const float* bg = in_b_gates + l * 8;
    const float* bin = WSF(WS_B_IN) + (size_t)l * 32 * A_IN;
    constexpr int GWP = 2064;
    LAS unsigned char* Wl = F.lds + RING_OFF;
    for (int i = F.tid; i < 2 * 9 * (GWP / 4); i += NWAVES * 64) ((LAS unsigned*)Wl)[i] = 0u;
    __syncthreads();
    for (int i = F.tid; i < 8 * 512; i += NWAVES * 64) { const int g = i >> 9, k2 = (i & 511) * 2;
        const float w0 = WGl[g * 1024 + k2], w1 = WGl[g * 1024 + k2 + 1];
        const unsigned h0 = f2bf(w0), h1 = f2bf(w1);
        const float r0 = w0 - __uint_as_float(h0 << 16), r1 = w1 - __uint_as_float(h1 << 16);
        *(LAS unsigned*)(Wl + g * GWP + k2 * 2) = h0 | (h1 << 16);
        *(LAS unsigned*)(Wl + (9 + g) * GWP + k2 * 2) = f2bf(r0) | (f2bf(r1) << 16); }
    __syncthreads();
    const int r = F.lane & 31, hi = F.lane >> 5;
    const int m = (F.vcu * NWAVES + F.wave) * 32 + r;
    const bf16* xrow = WSB(WS_XG) + (size_t)m * D + 8 * hi;
    const LAS unsigned char* wa = Wl + (r < 8 ? r : 8) * GWP + 16 * hi;
    typedef float f32x16_g __attribute__((ext_vector_type(16)));
    f32x16_g acc = {};
    bf16x8 xa[16], xb[16];
#define GT_LD(xs, s0) do { _Pragma("unroll") for (int s_ = 0; s_ < 16; ++s_) xs[s_] = *(const bf16x8*)(xrow + ((s0) + s_) * 16); } while (0)
#define GT_MM(xs, s0) do { _Pragma("unroll") for (int s_ = 0; s_ < 16; ++s_) { const bf16x8 ah = *(const LAS bf16x8*)(wa + ((s0) + s_) * 32), al = *(const LAS bf16x8*)(wa + 9 * GWP + ((s0) + s_) * 32); \
        acc = __builtin_amdgcn_mfma_f32_32x32x16_bf16(ah, xs[s_], acc, 0, 0, 0); acc = __builtin_amdgcn_mfma_f32_32x32x16_bf16(al, xs[s_], acc, 0, 0, 0); } } while (0)
    GT_LD(xa, 0); __builtin_amdgcn_sched_barrier(0);
    GT_LD(xb, 16); __builtin_amdgcn_sched_barrier(0); GT_MM(xa, 0); __builtin_amdgcn_sched_barrier(0);
    GT_LD(xa, 32); __builtin_amdgcn_sched_barrier(0); GT_MM(xb, 16); __builtin_amdgcn_sched_barrier(0);
    GT_LD(xb, 48); __builtin_amdgcn_sched_barrier(0); GT_MM(xa, 32); __builtin_amdgcn_sched_barrier(0);
    GT_MM(xb, 48);
#undef GT_LD
#undef GT_MM
    const f32x4 q0 = *(const f32x4*)(WSF(WS_SSQ) + (size_t)m * 16 + 8 * hi), q1 = *(const f32x4*)(WSF(WS_SSQ) + (size_t)m * 16 + 8 * hi + 4);
    float spt = ((q0[0] + q0[1]) + (q0[2] + q0[3])) + ((q1[0] + q1[1]) + (q1[2] + q1[3])); spt += __shfl_xor(spt, 32);
    const float rstd = rsqrtf(spt * (1.0f / 1024.0f) + 1e-6f);
    const f32x4 bv = *(const f32x4*)(bin + (size_t)(m >> 11) * A_IN + A_INP + 4 * hi), gv = *(const f32x4*)(bg + 4 * hi);
    f32x4 o;
#pragma unroll
    for (int i = 0; i < 4; ++i) { const float pre = rstd * acc[i] + bv[i] + gv[i];
        const float ls = fminf(pre, 0.f) - log1pf(expf(-fabsf(pre)));
        o[i] = hi ? ls : pre; }
    *(f32x4*)(WSF(WS_GATES) + (size_t)m * 8 + 4 * hi) = o;
    __syncthreads();
}
namespace ml {
typedef short bf16x8 __attribute__((ext_vector_type(8)));
typedef short s16x4 __attribute__((ext_vector_type(4)));
typedef float f32x16 __attribute__((ext_vector_type(16)));
typedef float f32x2_t __attribute__((ext_vector_type(2))); typedef __bf16 bf16x2_t __attribute__((ext_vector_type(2)));
constexpr int QP = 272, KWP = 320, VP = 576, PP = 144, HP = 528;
constexpr int L_QS = 0, L_KS = L_QS + 64 * QP, L_KW = L_KS + 64 * QP, L_VS = L_KW + 64 * KWP, L_P = L_VS + 64 * VP, L_HST = L_P + 64 * PP, L_TAB = L_HST + 64 * HP;
constexpr int T_US = L_TAB, T_MT = T_US + 256, T_WI = T_MT + 256, T_FL = T_WI + 256, T_D0 = T_FL + 256, T_D1 = T_D0 + 256, T_QN = T_D1 + 256, T_N = T_QN + 256, T_SSQ = T_N + 1024, L_END = T_SSQ + 2048;
__device__ __forceinline__ int crow(int r, int hi) { return (r & 3) + 8 * (r >> 2) + 4 * hi; }
__device__ __forceinline__ unsigned cvtpk(float lo, float hi) { f32x2_t v = {lo, hi}; bf16x2_t b = __builtin_convertvector(v, bf16x2_t); return __builtin_bit_cast(unsigned, b); }
__device__ __forceinline__ s16x4 vtr(const LAS unsigned char* p) { typedef short v4i16_t __attribute__((ext_vector_type(4))); return __builtin_bit_cast(s16x4, __builtin_amdgcn_ds_read_tr16_b64_v4i16((LAS v4i16_t*)p)); }
__device__ __forceinline__ bf16x8 cat(s16x4 lo, s16x4 hi) { return (bf16x8){lo[0], lo[1], lo[2], lo[3], hi[0], hi[1], hi[2], hi[3]}; }
#define ML_MFMA(a, b, c) __builtin_amdgcn_mfma_f32_32x32x16_bf16((a), (b), (c), 0, 0, 0)
}
__device__ __forceinline__ void mlstm_mfma_phase(const Frame& F0, int l, const int skip = 0) {
    using namespace ml;
    PHASE_FRAME;
    LAS unsigned char* L = F.lds;
    const int w = F.wave;
    LAS float* us = (LAS float*)(L + T_US); LAS float* Mt = (LAS float*)(L + T_MT); LAS float* wi = (LAS float*)(L + T_WI); LAS float* fl = (LAS float*)(L + T_FL);
    LAS float* d0 = (LAS float*)(L + T_D0); LAS float* d1 = (LAS float*)(L + T_D1); LAS float* qn = (LAS float*)(L + T_QN); LAS float* nb = (LAS float*)(L + T_N); LAS float* ssqp = (LAS float*)(L + T_SSQ);
    const bf16* QKVO = WSB(WS_QKVO); const float* GATES = WSF(WS_GATES); bf16* HN = WSB(WS_HN);
    for (int u = blockIdx.x; u < 128; u += F.G) {
        const int b = u >> 2, hd = u & 3; const size_t rowbase = (size_t)b * SEQ;
        int tid = F.tid; const int lane = tid & 63;
        for (int i = tid; i < 32 * 8; i += NWAVES * 64) { const int t = i >> 3, c8 = i & 7; *(LAS u32x2*)(L + L_P + t * PP + 64 + c8 * 8) = (u32x2){0u, 0u}; }
        if (tid < 256) nb[tid] = 0.f;
        f32x16 Cst[4];
#pragma unroll
        for (int kt = 0; kt < 4; ++kt)
#pragma unroll
            for (int i = 0; i < 16; ++i) Cst[kt][i] = 0.f;
        float mst = 0.f;
        v4u pq[2], pk[2], pv[4]; float pig, plf;
        v4u nq[2], nk[2], nv[4]; float nig, nlf;
        const char* ubase = (const char*)QKVO + (size_t)u * 2048 * 1536;
#define ML_VOQ ((unsigned)((tid >> 4) * 1536 + (tid & 15) * 16))
#define ML_VOV ((unsigned)((tid >> 5) * 1536 + (tid & 31) * 16))
#define ML_PREFETCH(c) do { const char* cb_ = ubase + (size_t)(c) * (64 * 1536); const unsigned voq = ML_VOQ, vov = ML_VOV; \
            _Pragma("unroll") for (int ii = 0; ii < 2; ++ii) { pq[ii] = *(const v4u*)(cb_ + ii * (32 * 1536) + voq); pk[ii] = *(const v4u*)(cb_ + ii * (32 * 1536) + 256 + voq); } \
            _Pragma("unroll") for (int ii = 0; ii < 4; ++ii) pv[ii] = *(const v4u*)(cb_ + ii * (16 * 1536) + 512 + vov); \
            const float* gp_ = GATES + (rowbase + (size_t)(c) * 64) * 8 + hd; pig = gp_[lane * 8]; plf = gp_[lane * 8 + 4]; } while (0)
#define ML_PREFETCH2(c) do { const char* cb_ = ubase + (size_t)(c) * (64 * 1536); const unsigned voq = ML_VOQ, vov = ML_VOV; \
            _Pragma("unroll") for (int ii = 0; ii < 2; ++ii) { nq[ii] = *(const v4u*)(cb_ + ii * (32 * 1536) + voq); nk[ii] = *(const v4u*)(cb_ + ii * (32 * 1536) + 256 + voq); } \
            _Pragma("unroll") for (int ii = 0; ii < 4; ++ii) nv[ii] = *(const v4u*)(cb_ + ii * (16 * 1536) + 512 + vov); \
            const float* gp_ = GATES + (rowbase + (size_t)(c) * 64) * 8 + hd; nig = gp_[lane * 8]; nlf = gp_[lane * 8 + 4]; } while (0)
        ML_PREFETCH(0); ML_PREFETCH2(1);
        v4u po[4];
#define ML_T3(CC) do { if (!(skip & 4)) { \
              _Pragma("unroll") for (int ii = 0; ii < 4; ++ii) { const int i = tid + 512 * ii, rr = i >> 5, ch = i & 31; float ss = 0.f; \
                _Pragma("unroll") for (int ww = 0; ww < 8; ++ww) ss += ssqp[ww * 64 + rr]; \
                const float rstd = rsqrtf(ss * (1.0f / 256.0f) + 1e-6f); \
                const v4u hv = *(const LAS v4u*)(L + L_HST + rr * HP + ch * 16); v4u o; \
                _Pragma("unroll") for (int e = 0; e < 4; ++e) o[e] = cvtpk(bflo(hv[e]) * rstd * bflo(po[ii][e]), bfhi(hv[e]) * rstd * bfhi(po[ii][e])); \
                *(v4u*)(HN + (rowbase + (size_t)(CC) * 64 + rr) * 1024 + hd * 256 + ch * 8) = o; } } } while (0)
        for (int c = 0; c < 32; ++c) {
            asm volatile("" : "+v"(tid));
            const int lane = tid & 63, r = lane & 31, h = lane >> 5, blk = (lane >> 4) & 1, q4 = (lane & 15) >> 2, p4 = lane & 3;
            const size_t row0 = rowbase + (size_t)c * 64;
#define ML_DPP(idv, x, ctrl, rmask) __builtin_bit_cast(float, __builtin_amdgcn_update_dpp(__builtin_bit_cast(int, (float)(idv)), __builtin_bit_cast(int, (float)(x)), ctrl, rmask, 0xf, false))
            float gb = plf;
            if (!(skip & 1)) { gb += ML_DPP(0.f, gb, 0x111, 0xf); gb += ML_DPP(0.f, gb, 0x112, 0xf); gb += ML_DPP(0.f, gb, 0x114, 0xf); gb += ML_DPP(0.f, gb, 0x118, 0xf);
                gb += ML_DPP(0.f, gb, 0x142, 0xa); gb += ML_DPP(0.f, gb, 0x143, 0xc); }
            const float uu = pig - gb; float pm = uu;
            if (!(skip & 1)) { const float NI = -__builtin_inff();
                pm = fmaxf(pm, ML_DPP(NI, pm, 0x111, 0xf)); pm = fmaxf(pm, ML_DPP(NI, pm, 0x112, 0xf)); pm = fmaxf(pm, ML_DPP(NI, pm, 0x114, 0xf)); pm = fmaxf(pm, ML_DPP(NI, pm, 0x118, 0xf));
                pm = fmaxf(pm, ML_DPP(NI, pm, 0x142, 0xa)); pm = fmaxf(pm, ML_DPP(NI, pm, 0x143, 0xc)); }
#undef ML_DPP
            const float Mt_l = fmaxf(mst, pm);
            const float G = __shfl(gb, 63), M63 = __shfl(Mt_l, 63);
            const float w_old = __expf(mst - M63), ws_l = __expf(uu - M63), wi_l = __expf(mst - Mt_l), fl_l = __expf(-(gb + Mt_l));
            const int nsel = (c & 1) * 128;
            if (w == 0) { us[lane] = uu; Mt[lane] = Mt_l; wi[lane] = wi_l; fl[lane] = fl_l; }
#pragma unroll
            for (int ii = 0; ii < 2; ++ii) { const int i = tid + 512 * ii, rr = i >> 4, ch = i & 15;
                *(LAS v4u*)(L + L_QS + rr * QP + ch * 16) = pq[ii]; *(LAS v4u*)(L + L_KS + rr * QP + ch * 16) = pk[ii];
                const float wsr = __shfl(ws_l, rr & 63); v4u kw;
#pragma unroll
                for (int e = 0; e < 4; ++e) kw[e] = cvtpk(bflo(pk[ii][e]) * wsr, bfhi(pk[ii][e]) * wsr);
                *(LAS v4u*)(L + L_KW + rr * KWP + ch * 16) = kw; }
#pragma unroll
            for (int ii = 0; ii < 4; ++ii) { const int i = tid + 512 * ii, rr = i >> 5, ch = i & 31; *(LAS v4u*)(L + L_VS + rr * VP + ch * 16) = pv[ii]; }
            mst = G + M63;
            if (!(skip & 32)) {
#pragma unroll
                for (int ii = 0; ii < 2; ++ii) { pq[ii] = nq[ii]; pk[ii] = nk[ii]; }
#pragma unroll
                for (int ii = 0; ii < 4; ++ii) pv[ii] = nv[ii];
                pig = nig; plf = nlf;
                if (c + 2 < 32) ML_PREFETCH2(c + 2); }
            asm volatile("" ::: "memory");
            if (c > 0) ML_T3(c - 1);
            asm volatile("s_waitcnt lgkmcnt(0)\n\ts_barrier" ::: "memory");
            { const char* ob = ubase + (size_t)c * (64 * 1536) + 1024;
#pragma unroll
              for (int ii = 0; ii < 4; ++ii) po[ii] = (skip & 32) ? (v4u){0u, 0u, 0u, 0u} : *(const v4u*)(ob + ii * (16 * 1536) + ML_VOV); }
            if (skip & 2) {} else if (w < 3) {
                const int st = (w == 2) ? 1 : 0, tt = (w >= 1) ? 1 : 0;
                f32x16 s;
#pragma unroll
                for (int i = 0; i < 16; ++i) s[i] = 0.f;
#pragma unroll
                for (int ks = 0; ks < 8; ++ks) { const bf16x8 a = *(const LAS bf16x8*)(L + L_KS + (32 * st + r) * QP + (16 * ks + 8 * h) * 2), bq = *(const LAS bf16x8*)(L + L_QS + (32 * tt + r) * QP + (16 * ks + 8 * h) * 2);
                    s = ML_MFMA(a, bq, s); }
                const float mt = Mt[32 * tt + r]; float rs = 0.f;
#pragma unroll
                for (int i = 0; i < 16; ++i) { const int sl = crow(i, h); const float wgt = __expf(us[32 * st + sl] - mt); const bool keep = (st != tt) || (sl <= r);
                    s[i] = keep ? s[i] * wgt : 0.f; rs += s[i]; }
                rs += __shfl_xor(rs, 32);
                if (h == 0) { if (st == 0) d0[32 * tt + r] = rs; else d1[32 * tt + r] = rs; }
#pragma unroll
                for (int g = 0; g < 4; ++g) { u32x2 pw; pw.x = cvtpk(s[4 * g], s[4 * g + 1]); pw.y = cvtpk(s[4 * g + 2], s[4 * g + 3]);
                    *(LAS u32x2*)(L + L_P + (32 * tt + r) * PP + (32 * st + 8 * g + 4 * h) * 2) = pw; }
            } else if (w == 3) {
                float a = 0.f; const LAS float* np = nb + nsel;
#pragma unroll
                for (int j = 0; j < 16; ++j) { const v4u qw = *(const LAS v4u*)(L + L_QS + lane * QP + j * 16); const f32x4 n0 = *(const LAS f32x4*)(np + 8 * j), n1 = *(const LAS f32x4*)(np + 8 * j + 4);
                    a += (bflo(qw[0]) * n0[0] + bfhi(qw[0]) * n0[1]) + (bflo(qw[1]) * n0[2] + bfhi(qw[1]) * n0[3]) + (bflo(qw[2]) * n1[0] + bfhi(qw[2]) * n1[1]) + (bflo(qw[3]) * n1[2] + bfhi(qw[3]) * n1[3]); }
                qn[lane] = a;
            } else if (w < 6) {
                const int dk = tid - 256; float a = w_old * nb[nsel + dk];
#pragma unroll 8
                for (int s = 0; s < 64; ++s) a += __uint_as_float((unsigned)(*(const LAS unsigned short*)(L + L_KW + s * KWP + dk * 2)) << 16);
                nb[(128 - nsel) + dk] = a;
            }
            f32x16 hq[2];
#pragma unroll
            for (int tt = 0; tt < 2; ++tt)
#pragma unroll
                for (int i = 0; i < 16; ++i) hq[tt][i] = 0.f;
            if (!(skip & 8))
#pragma unroll
            for (int kt = 0; kt < 4; ++kt)
#pragma unroll
                for (int ss = 0; ss < 2; ++ss) {
                    v4u cp;
#pragma unroll
                    for (int e = 0; e < 4; ++e) cp[e] = cvtpk(Cst[kt][8 * ss + 2 * e], Cst[kt][8 * ss + 2 * e + 1]);
                    const bf16x8 ca = __builtin_bit_cast(bf16x8, cp);
#pragma unroll
                    for (int tt = 0; tt < 2; ++tt) { const LAS unsigned char* qp = L + L_QS + (32 * tt + r) * QP + (32 * kt + 16 * ss + 4 * h) * 2;
                        const s16x4 lo = *(const LAS s16x4*)(qp), hi = *(const LAS s16x4*)(qp + 16);
                        hq[tt] = ML_MFMA(ca, cat(lo, hi), hq[tt]); }
                }
            __syncthreads();
#pragma unroll
            for (int tt = 0; tt < 2; ++tt) { const float wt = wi[32 * tt + r];
#pragma unroll
                for (int i = 0; i < 16; ++i) hq[tt][i] *= wt; }
#pragma unroll
            for (int kt = 0; kt < 4; ++kt)
#pragma unroll
                for (int i = 0; i < 16; ++i) Cst[kt][i] *= w_old;
            if (!(skip & 16))
#pragma unroll
            for (int ks = 0; ks < 4; ++ks) {
                const LAS unsigned char* vp = L + L_VS + (16 * ks + 8 * h + q4) * VP + (32 * w + 16 * blk + 4 * p4) * 2; const bf16x8 vf = cat(vtr(vp), vtr(vp + 4 * VP));
#pragma unroll
                for (int tt = 0; tt < 2; ++tt) { const bf16x8 pb = *(const LAS bf16x8*)(L + L_P + (32 * tt + r) * PP + (16 * ks + 8 * h) * 2); hq[tt] = ML_MFMA(vf, pb, hq[tt]); }
#pragma unroll
                for (int kt = 0; kt < 4; ++kt) { const LAS unsigned char* kp = L + L_KW + (16 * ks + 8 * h + q4) * KWP + (32 * kt + 16 * blk + 4 * p4) * 2; Cst[kt] = ML_MFMA(cat(vtr(kp), vtr(kp + 4 * KWP)), vf, Cst[kt]); }
            }
            if (!(skip & 64))
#pragma unroll
            for (int tt = 0; tt < 2; ++tt) { const int t = 32 * tt + r;
                const float den = d0[t] + (tt ? d1[t] : 0.f) + wi[t] * qn[t], inv = __builtin_amdgcn_rcpf(fmaxf(fabsf(den), fl[t])); float ss = 0.f;
#pragma unroll
                for (int i = 0; i < 16; ++i) { hq[tt][i] *= inv; ss += hq[tt][i] * hq[tt][i]; }
                ss += __shfl_xor(ss, 32);
                if (h == 0) ssqp[w * 64 + t] = ss;
#pragma unroll
                for (int g = 0; g < 4; ++g) { u32x2 hw; hw.x = cvtpk(hq[tt][4 * g], hq[tt][4 * g + 1]); hw.y = cvtpk(hq[tt][4 * g + 2], hq[tt][4 * g + 3]);
                    *(LAS u32x2*)(L + L_HST + t * HP + (32 * w + 8 * g + 4 * h) * 2) = hw; } }
            __syncthreads();
        }
        ML_T3(31);
        __syncthreads();
#undef ML_T3
#undef ML_PREFETCH
#undef ML_PREFETCH2
    }
}
static_assert(ml::L_END <= LDSCTL_OFF, "mLSTM LDS map");

__device__ __forceinline__ void combine_local(const Frame& F, int j, int b, int h) {
    const float* in_subln_g = INF(19);
    const float lam = WSF(WS_LAM)[j], post = 1.0f - (j == 0 ? 0.4707130183435842f : 0.5560582041556406f);
    const int cg = F.lane & 7; const float* sg = in_subln_g + j * 128 + 16 * cg;
    for (int s0 = 0; s0 < 32; s0 += 4) {
        v4u a0[4], a1[4], b0[4], b1[4];
#pragma unroll
        for (int i = 0; i < 4; ++i) { const size_t row = (size_t)b * SEQ + (s0 + i) * 64 + F.wave * 8 + (F.lane >> 3); const bf16* o1 = WSB(WS_O) + row * 2048 + h * 128 + 16 * cg; const bf16* o2 = o1 + 1024;
            a0[i] = *(const v4u*)(o1); a1[i] = *(const v4u*)(o1 + 8); b0[i] = *(const v4u*)(o2); b1[i] = *(const v4u*)(o2 + 8); }
#pragma unroll
        for (int i = 0; i < 4; ++i) { const size_t row = (size_t)b * SEQ + (s0 + i) * 64 + F.wave * 8 + (F.lane >> 3);
            float o[16]; float ss = 0.f;
#pragma unroll
            for (int e = 0; e < 4; ++e) { o[2 * e] = bflo(a0[i][e]) - lam * bflo(b0[i][e]); o[2 * e + 1] = bfhi(a0[i][e]) - lam * bfhi(b0[i][e]); o[8 + 2 * e] = bflo(a1[i][e]) - lam * bflo(b1[i][e]); o[8 + 2 * e + 1] = bfhi(a1[i][e]) - lam * bfhi(b1[i][e]); }
#pragma unroll
            for (int k = 0; k < 16; ++k) ss += o[k] * o[k];
            ss += __shfl_xor(ss, 1); ss += __shfl_xor(ss, 2); ss += __shfl_xor(ss, 4);
            const float rstd = rsqrtf(ss * (1.0f / 128.0f) + 1e-5f) * post;
            v4u r0, r1;
#pragma unroll
            for (int e = 0; e < 4; ++e) { r0[e] = pk2(o[2 * e] * rstd * sg[2 * e], o[2 * e + 1] * rstd * sg[2 * e + 1]); r1[e] = pk2(o[8 + 2 * e] * rstd * sg[8 + 2 * e], o[8 + 2 * e + 1] * rstd * sg[8 + 2 * e + 1]); }
            bf16* dst = WSB(WS_HN) + row * 1024 + h * 128 + 16 * cg; *(v4u*)(dst) = r0; *(v4u*)(dst + 8) = r1; }
    }
}
__device__ __forceinline__ void final_phase(const Frame& F0, float fill, const XcdBarrier& bar) {
    PHASE_FRAME;
    const float* in_final_g = INF(21); unsigned char* ob = ARGP(unsigned char, 22);
    const bf16* X16 = (const bf16*)ob; float* out = (float*)ob;
    const int gw = F.vcu * NWAVES + F.wave, NGW = F.G * NWAVES;
    f32x4 gv[4];
#pragma unroll
    for (int j = 0; j < 4; ++j) gv[j] = *(const f32x4*)(in_final_g + 4 * F.lane + 256 * j);
#define FIN_ROW(xw, spv, m) do { const float rstd_ = rsqrtf(wave_sum(spv) * (1.0f / 1024.0f) + 1e-6f); float* xr_ = out + (size_t)(m) * D; \
        _Pragma("unroll") for (int j = 0; j < 4; ++j) { const f32x4 x_ = {bflo((xw)[j].x), bfhi((xw)[j].x), bflo((xw)[j].y), bfhi((xw)[j].y)}; f32x4 y_ = x_ * rstd_ * gv[j]; \
            if (fill != 0.f) y_ = (f32x4){fill, fill, fill, fill}; *(f32x4*)(xr_ + 4 * F.lane + 256 * j) = y_; } } while (0)
    u32x2 lo[16][4]; float lsp[16];
#pragma unroll
    for (int i = 0; i < 16; ++i) { const int m = gw + i * NGW; lsp[i] = (F.lane < 16) ? WSF(WS_SSQ)[(size_t)m * 16 + F.lane] : 0.f;
#pragma unroll
        for (int j = 0; j < 4; ++j) lo[i][j] = *(const u32x2*)(X16 + (size_t)m * D + 4 * F.lane + 256 * j); }
    for (int m0 = M / 2 + 4 * gw; m0 < M; m0 += 4 * NGW) {
        u32x2 v[4][4]; float sp[4];
#pragma unroll
        for (int i = 0; i < 4; ++i) { sp[i] = (F.lane < 16) ? WSF(WS_SSQ)[(size_t)(m0 + i) * 16 + F.lane] : 0.f;
#pragma unroll
            for (int j = 0; j < 4; ++j) v[i][j] = *(const u32x2*)(X16 + (size_t)(m0 + i) * D + 4 * F.lane + 256 * j); }
#pragma unroll
        for (int i = 0; i < 4; ++i) FIN_ROW(v[i], sp[i], m0 + i);
    }
    xcd_barrier(bar);
#pragma unroll
    for (int i = 0; i < 16; ++i) FIN_ROW(lo[i], lsp[i], gw + i * NGW);
#undef FIN_ROW
}

#define IN(k) true
#define SEAM(k) do { xcd_barrier(bar); if (PROBE_DUP == 20) xcd_barrier(bar); } while (0)
template <int l> __device__ __forceinline__ void layer_phases(const Frame& F0, const XcdBarrier& bar, const int lo, const int hi, unsigned char* lds) {
        const int pb = 2 + 10 * l;
        if constexpr (l < 2) {
            REP(2) if (IN(pb + 0)) { PHASE_FRAME;
                if (PHM(2)) { gates_phase(F, l); if (PROBE_DUP == 21) gates_phase(F, l); }
                pg8::Gemm g{WSB(WS_XG), WSB(WS_WIN) + (size_t)l * D * A_INP, M, A_INP, D}; pg8::StaticOrder S; S.init(M, A_INP, F.G, (int)blockIdx.x);
                pg8::EpiLin<0> E{F.ws, WS_QKVO, A_INP, WS_B_IN + (size_t)l * 32 * A_IN * 4, A_IN, 0, 0, 1.0f, INF(11) + l * 1024};
                if (PHM(3)) pg8::gemm_phase<pg8::EpiLin<0>, pg8::StaticOrder, PG8_ALIGN, PG8_SP2>(F.lds + RING_OFF, g, S, E);
                SEAM(pb + 0);
            }
            REP(3) if (IN(pb + 1)) { PHASE_FRAME; if (l == 0 && blockIdx.x >= 128) deferred_prologue(F); else if (PHM(4)) mlstm_mfma_phase(F, l, (PROBE_DUP == 3 && rep_ == 0) ? PROBE_SKIP : 0); SEAM(pb + 1); }
        } else {
            const int j = l - 2;
            REP(4) if (IN(pb + 0)) { PHASE_FRAME;
                pg8::Gemm g{WSB(WS_XG), WSB(WS_WQ) + (size_t)j * D * D, M, D, D}; pg8::StaticOrder S; S.init(M, D, F.G, (int)blockIdx.x);
                pg8::EpiLin<2> E{F.ws, WS_Q, D, WS_B_Q + (size_t)j * 32 * D * 4, D, 0, 4, at2::C2, nullptr};
                if (PHM(5)) pg8::gemm_phase<pg8::EpiLin<2>, pg8::StaticOrder, PG8_ALIGN, PG8_SP2>(F.lds + RING_OFF, g, S, E);
                SEAM(pb + 0);
            }
            REP(5) if (IN(pb + 1)) { PHASE_FRAME;
                if (PHM(6)) {
                    const at2::bf16* Q0 = (const at2::bf16*)WSB(WS_Q); const at2::bf16* K0 = (const at2::bf16*)WSB(WS_KV); at2::bf16* O0 = (at2::bf16*)WSB(WS_HN);
                    const float lam = WSF(WS_LAM)[j], post = 1.0f - (j == 0 ? 0.4707130183435842f : 0.5560582041556406f); const float* sg = INF(19) + j * 128;
                    const int vq = F.vcu;
#define AT2_REF(R, g) do { const int bh_ = (((g) >> 2) * 256 + vq) >> 2, p_ = vq & 3, k_ = (g) & 3, comp_ = k_ & 1, qb_ = (k_ < 2) ? p_ : 7 - p_; \
                           const size_t rb_ = (size_t)(bh_ >> 3) * SEQ; const int hc_ = (bh_ & 7) * 128; \
                           R.Q = Q0 + (rb_ + (size_t)qb_ * 256) * 1024 + hc_ + comp_ * 64; R.K = K0 + rb_ * 2048 + hc_ + comp_ * 64; R.V = K0 + rb_ * 2048 + 1024 + hc_; \
                           R.O = O0 + (rb_ + (size_t)qb_ * 256) * 1024 + hc_; R.P0 = qb_ * 256; } while (0)
                    at2::Seam S; at2::BlockRef cur, nxt; AT2_REF(cur, 0);
                    at2::prime(cur, (char*)lds + RING_OFF, S);
#pragma unroll 1
                    for (int g = 0; g < 16; g += 2) {
                        AT2_REF(nxt, g + 1); at2::block<0>(cur, nxt, (char*)lds + RING_OFF, S, lam, post, sg); cur = nxt;
                        if (g + 2 < 16) AT2_REF(nxt, g + 2);
                        at2::block<1>(cur, nxt, (char*)lds + RING_OFF, S, lam, post, sg); cur = nxt; }
#undef AT2_REF
                }
                SEAM(pb + 1);
            }
        }
        REP(9) if (IN(pb + 3)) { PHASE_FRAME;
            const bf16* W = (l < 2) ? WSB(WS_WMO) + (size_t)l * D * D : WSB(WS_WDO) + (size_t)(l - 2) * D * D;
            pg8::Gemm g{WSB(WS_HN), W, M, D, D}; pg8::StaticOrder S; S.init(M, D, F.G, (int)blockIdx.x);
            bf16* x16 = ARGP(bf16, 22); pg8::EpiRes E{F.ws, x16, (PROBE_DUP == 9 && rep_ == 0) ? (size_t)65536 : WS_MODS + ((size_t)l * 32 * 6144 + 2048) * 4, WS_GM_MLP + (size_t)l * 32 * 1024 * 4, 0, 0};
            if (PHM(8)) pg8::gemm_phase<pg8::EpiRes, pg8::StaticOrder, EPIRES_ALIGN, PG8_SP2>(F.lds + RING_OFF, g, S, E);
            SEAM(pb + 3);
        }
        constexpr int NHM = 1, MHL = M / NHM;
        constexpr size_t HOFF = (l < 2) ? WS_H : WS_HA;
#pragma unroll 1
        for (int hm = 0; hm < NHM; ++hm) {
            REP(7) if (IN(pb + 4 + 2 * hm)) { PHASE_FRAME;
                pg8::Gemm g{WSB(WS_XG) + (size_t)hm * MHL * D, WSB(WS_WUP) + (size_t)l * D * FF, MHL, FF, D}; pg8::StaticOrder S; S.init(MHL, FF, F.G, (int)blockIdx.x);
                pg8::EpiLin<1> E{F.ws, HOFF, FF, WS_B_UP + (size_t)l * 32 * FF * 4, FF, hm * MHL, 0, 1.0f, nullptr};
                if (PHM(9)) pg8::gemm_phase<pg8::EpiLin<1>, pg8::StaticOrder, PG8_ALIGN, PG8_SP2>(F.lds + RING_OFF, g, S, E);
                SEAM(pb + 4 + 2 * hm);
            }
            REP(10) if (IN(pb + 5 + 2 * hm)) { PHASE_FRAME;
                pg8::Gemm g{WSB(HOFF), WSB(WS_WDN) + (size_t)l * D * FF, MHL, D, FF}; pg8::StaticOrder S; S.init(MHL, D, F.G, (int)blockIdx.x);
                bf16* x16 = ARGP(bf16, 22); pg8::EpiRes E{F.ws, x16, (PROBE_DUP == 10 && rep_ == 0) ? (size_t)65536 : WS_MODS + ((size_t)l * 32 * 6144 + 5120) * 4, (l < 3) ? WS_GM_MIX + (size_t)(l + 1) * 32 * 1024 * 4 : 0, (l == 1) ? WS_GM_KV : 0, hm * MHL};
                if (PHM(10)) pg8::gemm_phase<pg8::EpiRes, pg8::StaticOrder, EPIRES_ALIGN, PG8_SP2>(F.lds + RING_OFF, g, S, E);
                SEAM(pb + 5 + 2 * hm);
            }
        }
        if constexpr (l == 1) REP(8) if (IN(pb + 8)) { PHASE_FRAME;
            pg8::Gemm g{WSB(WS_HN), WSB(WS_WKV), M, 2048, D}; pg8::StaticOrder S; S.init(M, 2048, F.G, (int)blockIdx.x);
            pg8::EpiLin<2> E{F.ws, WS_KV, 2048, WS_B_KV, 2048, 0, 4, 1.0f, nullptr};
            if (PHM(11)) pg8::gemm_phase<pg8::EpiLin<2>, pg8::StaticOrder, PG8_ALIGN, PG8_SP2>(F.lds + RING_OFF, g, S, E);
        }
}
#undef IN
#undef SEAM
struct Args { const void* in[22]; float* out; unsigned char* ws; int ph_lo, ph_hi; };
__global__ void __launch_bounds__(NWAVES * 64, 2) yoco_fwd(Args args) {
    extern __shared__ __attribute__((aligned(16))) unsigned char lds[];
    Frame F;
    F.lds = (LAS unsigned char*)lds;
    F.MISC = (volatile LAS unsigned*)(F.lds + MISC_OFF);
    F.tid = threadIdx.x; F.lane = F.tid & 63; F.wave = __builtin_amdgcn_readfirstlane(F.tid >> 6);
    F.G = gridDim.x; { const int bx = blockIdx.x; F.vcu = (F.G % 8 == 0) ? (bx % 8) * (F.G / 8) + bx / 8 : bx; }
    unsigned char* ws = args.ws;
    F.ctl = (gu32*)(ws + WS_CTL);
    F.ws = ws;
    for (int u = F.tid; u < (LDS_BYTES - LDSCTL_OFF) / 4; u += NWAVES * 64) ((LAS unsigned*)(F.lds + LDSCTL_OFF))[u] = 0u;
    __syncthreads();
    XcdBarrier bar = xcd_barrier_post((unsigned*)(F.ctl + CW_BAR), F.MISC + 8);
    const int lo = 0, hi = 43;
#define IN(k) true
#define SEAM(k) do { xcd_barrier(bar); if (PROBE_DUP == 20) xcd_barrier(bar); } while (0)

    REP(1) { REP(11) if (PHM(0) && IN(0)) { p0a(F); SEAM(0); }
    REP(12) if (PHM(1) && IN(1)) { p0b(F); SEAM(1); } }
    layer_phases<0>(F, bar, lo, hi, lds); layer_phases<1>(F, bar, lo, hi, lds); layer_phases<2>(F, bar, lo, hi, lds); layer_phases<3>(F, bar, lo, hi, lds);
    if (IN(42)) {
        float fill = __uint_as_float(__hip_atomic_load(F.ctl + CW_DIAG, RLX_AGENT));
        if (__hip_atomic_load(F.ctl + CW_TMO, RLX_AGENT) != 0u || __hip_atomic_load((gu32*)((unsigned*)(F.ctl + CW_BAR) + XB_TMO), RLX_AGENT) != 0u) fill = 5000.0f;
        if (PHM(12)) final_phase(F, fill, bar);
    }
#undef IN
#undef SEAM
}

extern "C" void kernel_launch(void* const* d_in, const int* in_sizes, int n_in, void* d_out, int out_size, void* d_ws, size_t ws_size, hipStream_t stream) {
    static int grid = 0;
    if (grid == 0) {
        if (n_in != 22 || in_sizes[0] != M * D || out_size != M * D || ws_size < WS_END) { fprintf(stderr, "kernel_launch: unexpected problem (n_in %d, in0 %d, out %d, ws %zu); nothing launched\n", n_in, n_in > 0 ? in_sizes[0] : -1, out_size, ws_size); grid = -1; return; }
        int dev = 0, cus = 0, per_cu = 0;
        if (hipGetDevice(&dev) != hipSuccess || hipDeviceGetAttribute(&cus, hipDeviceAttributeMultiprocessorCount, dev) != hipSuccess) { grid = -1; return; }
        if (hipFuncSetAttribute((const void*)yoco_fwd, hipFuncAttributeMaxDynamicSharedMemorySize, LDS_BYTES) != hipSuccess) { fprintf(stderr, "kernel_launch: hipFuncSetAttribute failed\n"); grid = -1; return; }
        if (hipOccupancyMaxActiveBlocksPerMultiprocessor(&per_cu, (const void*)yoco_fwd, NWAVES * 64, LDS_BYTES) != hipSuccess || per_cu < 1)
            fprintf(stderr, "kernel_launch: note: occupancy query reports %d workgroups per CU\n", per_cu);
        (void)hipGetLastError();
        grid = cus;
        if (grid != 256) { fprintf(stderr, "kernel_launch: %d CUs; the attention and final phases are laid out for a grid of exactly 256 workgroups; nothing launched\n", cus); grid = -1; return; }
    }
    if (grid < 0) return;
    if (hipMemsetAsync((char*)d_ws + WS_CTL, 0, CTL_ZERO_BYTES, stream) != hipSuccess) return;
    Args a{};
    for (int i = 0; i < 22; ++i) a.in[i] = d_in[i];
    a.out = (float*)d_out; a.ws = (unsigned char*)d_ws;
    a.ph_lo = 0; a.ph_hi = 43;
    hipLaunchKernelGGL(yoco_fwd, dim3(grid), dim3(NWAVES * 64), LDS_BYTES, stream, a);
    const hipError_t le = hipPeekAtLastError();
    if (le != hipSuccess) fprintf(stderr, "kernel_launch: launch failed: %s\n", hipGetErrorName(le));
}
```

```cpp
#include <hip/hip_runtime.h>
#include <hip/hip_bf16.h>
#include <cstdio>
#include <cstdint>
#include <cmath>
constexpr int NWAVES = 8;
constexpr int BATCH = 32, SEQ = 2048, D = 1024, FF = 4096, M = BATCH * SEQ, MH = M / 2;
constexpr int A_IN = 3080, A_INP = 3072;
constexpr size_t MiB = 1u << 20;
constexpr size_t WS_CTL = 0, CTL_ZERO_BYTES = 1 * MiB;
constexpr size_t WS_MODS = 1 * MiB;
constexpr size_t WS_KVMOD = 4 * MiB;
constexpr size_t WS_GM_MIX = WS_KVMOD + 256 * 1024;
constexpr size_t WS_GM_MLP = WS_GM_MIX + 512 * 1024;
constexpr size_t WS_GM_KV = WS_GM_MLP + 512 * 1024;
constexpr size_t WS_B_IN = 6 * MiB;
constexpr size_t WS_B_UP = 7 * MiB;
constexpr size_t WS_B_KV = 9 * MiB;
constexpr size_t WS_B_Q = WS_B_KV + 256 * 1024;
constexpr size_t WS_WG = WS_B_Q + 256 * 1024;
constexpr size_t WS_LAM = WS_WG + 64 * 1024;
constexpr size_t WS_ROPE = 10 * MiB;
constexpr size_t WS_GATES = 14 * MiB;
constexpr size_t WS_SSQ = 16 * MiB;
constexpr size_t WS_WUP = 20 * MiB, WS_WDN = 52 * MiB, WS_WIN = 84 * MiB, WS_WMO = 96 * MiB, WS_WKV = 100 * MiB, WS_WQ = 104 * MiB, WS_WDO = 108 * MiB;
constexpr size_t WS_XG = 112 * MiB;
constexpr size_t WS_HN = 240 * MiB;
constexpr size_t WS_H = 368 * MiB;
constexpr size_t WS_KV = 752 * MiB;
constexpr size_t WS_Q = 624 * MiB;
constexpr size_t WS_END = 1008 * MiB;
constexpr size_t WS_QKVO = WS_H;
constexpr size_t WS_O = WS_H;
constexpr size_t WS_HA = WS_HN;
static_assert(WS_QKVO + (size_t)M * 3072 * 2 <= WS_KV && WS_H + (size_t)M * FF * 2 <= WS_END && WS_HA + (size_t)M * FF * 2 <= WS_KV && WS_Q + (size_t)M * 1024 * 2 <= WS_KV && WS_KV + (size_t)M * 2048 * 2 <= WS_END, "d_ws map");
constexpr int CW_TMO = 0, CW_CODE = 1, CW_DIAG = 8;
constexpr int CW_BAR = 4096;
constexpr int CW_FIN = 32768;
constexpr int RING_OFF = 0, RING_BYTES = 131072;
constexpr int LDSCTL_OFF = 146432, MISC_OFF = LDSCTL_OFF + 320;
constexpr int LDS_BYTES = 147456;
static_assert(MISC_OFF + 128 <= LDS_BYTES && RING_BYTES <= LDSCTL_OFF, "LDS map");

namespace pg8 {
#define PG8_LAS __attribute__((address_space(3)))
typedef unsigned short bf16_t;
typedef short bf16x8 __attribute__((ext_vector_type(8)));
typedef float f32x4 __attribute__((ext_vector_type(4)));
typedef unsigned u32x4 __attribute__((ext_vector_type(4)));
constexpr int BM = 256, BK = 64, HALF = 128, HTB = HALF * BK * 2  , STAGE_BYTES = 8 * HTB, NXCD = 8, WGM = 8;

__host__ __device__ __forceinline__ int lds_byte(int r, int c) { const int st = (r >> 4) * 2 + (c >> 5), rr = r & 15, cc = c & 31, ob = rr * 64 + cc * 2; return st * 1024 + (ob ^ (((ob >> 9) & 1) << 5)); }
__host__ __device__ __forceinline__ void stage_rc(int b, int& R, int& C) { const int st = b / 1024, sb = b % 1024, swz = sb ^ (((sb >> 9) & 1) << 5); R = (st >> 1) * 16 + swz / 64; C = (st & 1) * 32 + (swz % 64) / 2; }
__host__ __device__ __forceinline__ int perm32(int rho) { const int n = rho >> 4, i = rho & 15; return 8 * (i >> 2) + 4 * n + (i & 3); }

struct Unit { int pm, pn; };
struct Gemm { const bf16_t* A; const bf16_t* Bt; int M, N, K; };

struct StaticOrder {
    int nM, nN, nwg, G, c;
    __host__ __device__ void init(int M, int N, int G_, int c_) { nM = M / BM; nN = N / BM; nwg = nM * nN; G = G_; c = c_; }
    __host__ __device__ bool next(int i, Unit& u) const {
        const long L = (long)i * G + c; if (L >= nwg) return false;
        int wgid = (int)L; { const int q = nwg / NXCD, r = nwg % NXCD, xcd = wgid % NXCD, off = wgid / NXCD; wgid = (xcd < r ? xcd * (q + 1) : r * (q + 1) + (xcd - r) * q) + off; }
        const int nig = WGM * nN, gid = wgid / nig, fm = gid * WGM, gsz = (nM - fm) < WGM ? (nM - fm) : WGM;
        u.pm = fm + ((wgid % nig) % gsz); u.pn = (wgid % nig) / gsz; return true;
    }
    __device__ __forceinline__ void a_ready(const Unit&) const {}
    __device__ __forceinline__ void done(const Unit&) const {}
};

__device__ __forceinline__ unsigned cvt_pk_bf16(float lo, float hi) { unsigned r; asm volatile("v_cvt_pk_bf16_f32 %0, %1, %2" : "=v"(r) : "v"(lo), "v"(hi)); return r; }
typedef float f32x2 __attribute__((ext_vector_type(2)));
__device__ __forceinline__ float rstd_row(const float* p) {
    const f32x4 a = *(const f32x4*)(p), b = *(const f32x4*)(p + 4), c = *(const f32x4*)(p + 8), d = *(const f32x4*)(p + 12);
    const float s = (((a[0] + a[1]) + (a[2] + a[3])) + ((b[0] + b[1]) + (b[2] + b[3]))) + (((c[0] + c[1]) + (c[2] + c[3])) + ((d[0] + d[1]) + (d[2] + d[3])));
    return rsqrtf(s * (1.0f / 1024.0f) + 1e-6f);
}
__device__ __forceinline__ float sum_fq(float s) {
    { auto r_ = __builtin_amdgcn_permlane16_swap(__float_as_uint(s), __float_as_uint(s), false, false); s = __uint_as_float(r_[0]) + __uint_as_float(r_[1]); }
    { auto r_ = __builtin_amdgcn_permlane32_swap(__float_as_uint(s), __float_as_uint(s), false, false); s = __uint_as_float(r_[0]) + __uint_as_float(r_[1]); }
    return s; }
template <int MODE> struct EpiLin {
    static constexpr bool PERM = true, ADJ = true, AFTER_DRAIN = false;
    unsigned char* ws; size_t o_off; int ldo; size_t bias_off; int ldbias; int row_off; int rope_pn_lim; float scale; const float* aux;
    mutable float rsd_s[2][4] = {{0.f, 0.f, 0.f, 0.f}, {0.f, 0.f, 0.f, 0.f}}; mutable int pm_s = -1;
    static __device__ __forceinline__ unsigned ror8(unsigned x) { return (unsigned)__builtin_amdgcn_update_dpp(0, (int)x, 0x128, 0xf, 0xf, false); }
    __device__ __forceinline__ void operator()(const f32x4 (&acc)[2][2][4][2], const Unit& u, int wr, int wc, int fr, int fq) const {
        bf16_t* O = (bf16_t*)(ws + o_off); const float* ssq = (const float*)(ws + WS_SSQ); const float* bias = (const float*)(ws + bias_off); const float* rope = (const float*)(ws + WS_ROPE);
        const int lrow0 = u.pm * BM + wr * 64 + fr, grow0 = row_off + lrow0;
        const int b = (row_off + u.pm * BM) >> 11;
        const int col0 = u.pn * BM + wc * 64 + 8 * fq;
        const bool hiL = (fr & 8) != 0;
        const int colx = col0 + (hiL ? 32 : 0);
        f32x4 bv[2][2];
#pragma unroll
        for (int bj = 0; bj < 2; ++bj)
#pragma unroll
            for (int n = 0; n < 2; ++n) bv[bj][n] = *(const f32x4*)(bias + (size_t)b * ldbias + col0 + bj * 32 + 4 * n);
        float rsd[2][4];
        if (u.pm == pm_s) {
#pragma unroll
            for (int ai = 0; ai < 2; ++ai)
#pragma unroll
                for (int m = 0; m < 4; ++m) rsd[ai][m] = rsd_s[ai][m];
        } else { f32x4 pr[2][4];
#pragma unroll
          for (int ai = 0; ai < 2; ++ai)
#pragma unroll
              for (int m = 0; m < 4; ++m) pr[ai][m] = *(const f32x4*)(ssq + (size_t)(grow0 + ai * HALF + m * 16) * 16 + 4 * fq);
#pragma unroll
          for (int ai = 0; ai < 2; ++ai)
#pragma unroll
              for (int m = 0; m < 4; ++m) { float s = (pr[ai][m][0] + pr[ai][m][1]) + (pr[ai][m][2] + pr[ai][m][3]); s = sum_fq(s); rsd[ai][m] = rsqrtf(s * (1.0f / 1024.0f) + 1e-6f); rsd_s[ai][m] = rsd[ai][m]; }
          pm_s = u.pm; }
        float sc = scale;
        if (MODE == 0) sc = (u.pn == 2 || u.pn == 3) ? 0.08838834764831845f : 1.0f;
        const bool do_rope = (MODE == 2) && (u.pn < rope_pn_lim);
        int hh = 0, ee = 0;
        if (MODE == 0) { const int c = colx;
            if (c < 512) { hh = c >> 7; ee = c & 127; } else if (c < 1024) { hh = (c - 512) >> 7; ee = 128 + (c & 127); } else if (c < 2048) { hh = (c - 1024) >> 8; ee = 256 + (c & 255); } else { hh = (c - 2048) >> 8; ee = 512 + (c & 255); } }
#pragma unroll
        for (int ai = 0; ai < 2; ++ai)
#pragma unroll
            for (int m = 0; m < 4; ++m) {
                const int lrow = lrow0 + ai * HALF + m * 16, grow = grow0 + ai * HALF + m * 16;
                const float rs = rsd[ai][m];
                f32x4 cs0 = {1.f, 1.f, 1.f, 1.f}, cs1 = cs0, sn0 = {0.f, 0.f, 0.f, 0.f}, sn1 = sn0;
                if (MODE == 2) { if (do_rope) { const float* rp = rope + (size_t)grow * 16; cs0 = *(const f32x4*)(rp); cs1 = *(const f32x4*)(rp + 4); sn0 = *(const f32x4*)(rp + 8); sn1 = *(const f32x4*)(rp + 12); } }
                u32x4 wv[2];
#pragma unroll
                for (int bj = 0; bj < 2; ++bj) {
                    f32x4 v0 = acc[ai][bj][m][0] * rs + bv[bj][0], v1 = acc[ai][bj][m][1] * rs + bv[bj][1];
                    if (MODE == 1) {
#pragma unroll
                        for (int e = 0; e < 4; ++e) { const float a0 = fmaxf(v0[e], 0.f), a1 = fmaxf(v1[e], 0.f); v0[e] = a0 * a0; v1[e] = a1 * a1; }
                    }
                    if (MODE == 2) {
                        if (do_rope && bj == 0) {
                            f32x4 o0, o1;
#pragma unroll
                            for (int e = 0; e < 4; ++e) { o0[e] = __shfl_xor(v0[e], 16); o1[e] = __shfl_xor(v1[e], 16); }
                            if (fq == 0) { v0 = v0 * cs0 - o0 * sn0; v1 = v1 * cs1 - o1 * sn1; }
                            else if (fq == 1) { v0 = v0 * cs0 + o0 * sn0; v1 = v1 * cs1 + o1 * sn1; }
                        }
                    }
                    if (MODE != 1) { v0 = v0 * sc; v1 = v1 * sc; }
                    if (MODE == 0) { if (u.pn >= 8) {
                        const f32x4 g0 = *(const f32x4*)(aux + (col0 + bj * 32 - 2048)), g1 = *(const f32x4*)(aux + (col0 + bj * 32 - 2048) + 4);
#pragma unroll
                        for (int e2 = 0; e2 < 4; ++e2) { v0[e2] = g0[e2] * __builtin_amdgcn_rcpf(1.0f + __expf(-v0[e2])); v1[e2] = g1[e2] * __builtin_amdgcn_rcpf(1.0f + __expf(-v1[e2])); } } }
                    wv[bj].x = cvt_pk_bf16(v0[0], v0[1]); wv[bj].y = cvt_pk_bf16(v0[2], v0[3]); wv[bj].z = cvt_pk_bf16(v1[0], v1[1]); wv[bj].w = cvt_pk_bf16(v1[2], v1[3]);
                }
                const u32x4 sd = hiL ? wv[0] : wv[1]; u32x4 tv; tv.x = ror8(sd.x); tv.y = ror8(sd.y); tv.z = ror8(sd.z); tv.w = ror8(sd.w);
                const u32x4 d1 = hiL ? tv : wv[0], d2 = hiL ? wv[1] : tv;
                const int lrowA = lrow - (fr & 8), growA = grow - (fr & 8);
                bf16_t *p1, *p2;
                if (MODE == 0) { p1 = O + ((size_t)((b * 4 + hh) * 2048 + (growA & 2047))) * 768 + ee; p2 = p1 + (size_t)8 * 768; }
                else { p1 = O + (size_t)lrowA * ldo + colx; p2 = p1 + (size_t)8 * ldo; }
                __builtin_nontemporal_store(d1, (u32x4*)p1); __builtin_nontemporal_store(d2, (u32x4*)p2);
            }
    }
};
struct EpiRes {
    static constexpr bool PERM = true, ADJ = true, AFTER_DRAIN = false;
    unsigned char* ws; bf16_t* X; size_t gate_off; size_t gm_off; size_t gm2_off; int row_off; size_t gmp_off;
    static __device__ __forceinline__ unsigned ror8(unsigned x) { return (unsigned)__builtin_amdgcn_update_dpp(0, (int)x, 0x128, 0xf, 0xf, false); }
    static __device__ __forceinline__ u32x4 swp(u32x4 v) { u32x4 r; r.x = ror8(v.x); r.y = ror8(v.y); r.z = ror8(v.z); r.w = ror8(v.w); return r; }
    __device__ __forceinline__ void operator()(const f32x4 (&acc)[2][2][4][2], const Unit& u, int wr, int wc, int fr, int fq) const {
        bf16_t* XG = (bf16_t*)(ws + WS_XG); bf16_t* XG2 = (bf16_t*)(ws + WS_HN); float* ssq = (float*)(ws + WS_SSQ);
        const float* gate = (const float*)(ws + gate_off); const float* gm = (const float*)(ws + gm_off); const float* gm2 = (const float*)(ws + gm2_off); const float* gmp = (const float*)(ws + gmp_off);
        const bool has_gm = gm_off != 0, has_gm2 = gm2_off != 0;
        const int grow0 = row_off + u.pm * BM + wr * 64 + fr;
        const int b = (row_off + u.pm * BM) >> 11;
        const int col0 = u.pn * BM + wc * 64 + 8 * fq;
        const bool hiL = (fr & 8) != 0;
        const int growA = grow0 - (fr & 8), colx = col0 + (hiL ? 32 : 0);
        float ss[2][4];
#pragma unroll
        for (int ai = 0; ai < 2; ++ai)
#pragma unroll
            for (int m = 0; m < 4; ++m) ss[ai][m] = 0.f;
        f32x4 gv[2][2], rp[2][2], mv[2][2];
#pragma unroll
        for (int bj = 0; bj < 2; ++bj)
#pragma unroll
            for (int n = 0; n < 2; ++n) { const int c = col0 + bj * 32 + 4 * n;
                gv[bj][n] = *(const f32x4*)(gate + (size_t)b * 6144 + c);
                const f32x4 p = *(const f32x4*)(gmp + (size_t)b * 1024 + c);
#pragma unroll
                for (int e_ = 0; e_ < 4; ++e_) rp[bj][n][e_] = (p[e_] != 0.f) ? __builtin_amdgcn_rcpf(p[e_]) : 0.f;
                mv[bj][n] = has_gm ? *(const f32x4*)(gm + (size_t)b * 1024 + c) : (f32x4){0.f, 0.f, 0.f, 0.f}; }
        u32x4 l1 = *(const u32x4*)((const char*)XG + (unsigned)((growA * 1024 + colx) * 2)), l2 = *(const u32x4*)((const char*)XG + (unsigned)(((growA + 8) * 1024 + colx) * 2)), n1, n2;
#pragma unroll
        for (int k = 0; k < 8; ++k) { const int ai = k >> 2, m = k & 3; const unsigned offA = (unsigned)(((growA + ai * HALF + m * 16) * 1024 + colx) * 2);
            if (k < 7) { const int ai2 = (k + 1) >> 2, m2 = (k + 1) & 3; const unsigned o2 = (unsigned)(((growA + ai2 * HALF + m2 * 16) * 1024 + colx) * 2);
                n1 = *(const u32x4*)((const char*)XG + o2); n2 = *(const u32x4*)((const char*)XG + o2 + 8 * 2048); }
            asm volatile("" ::: "memory");
            const u32x4 tv = swp(hiL ? l1 : l2);
            const u32x4 xw0 = hiL ? tv : l1, xw1 = hiL ? l2 : tv;
            u32x4 wn[2], w2[2];
#pragma unroll
            for (int bj = 0; bj < 2; ++bj) { const u32x4 xw = bj ? xw1 : xw0;
                f32x4 x0 = {__uint_as_float(xw.x << 16), __uint_as_float(xw.x & 0xffff0000u), __uint_as_float(xw.y << 16), __uint_as_float(xw.y & 0xffff0000u)};
                f32x4 x1 = {__uint_as_float(xw.z << 16), __uint_as_float(xw.z & 0xffff0000u), __uint_as_float(xw.w << 16), __uint_as_float(xw.w & 0xffff0000u)};
                x0 = x0 * rp[bj][0] + gv[bj][0] * acc[ai][bj][m][0]; x1 = x1 * rp[bj][1] + gv[bj][1] * acc[ai][bj][m][1];
                ss[ai][m] += ((x0[0] * x0[0] + x0[1] * x0[1]) + (x0[2] * x0[2] + x0[3] * x0[3])) + ((x1[0] * x1[0] + x1[1] * x1[1]) + (x1[2] * x1[2] + x1[3] * x1[3]));
                if (has_gm) { const f32x4 y0 = x0 * mv[bj][0], y1 = x1 * mv[bj][1]; wn[bj].x = cvt_pk_bf16(y0[0], y0[1]); wn[bj].y = cvt_pk_bf16(y0[2], y0[3]); wn[bj].z = cvt_pk_bf16(y1[0], y1[1]); wn[bj].w = cvt_pk_bf16(y1[2], y1[3]); }
                else { wn[bj].x = cvt_pk_bf16(x0[0], x0[1]); wn[bj].y = cvt_pk_bf16(x0[2], x0[3]); wn[bj].z = cvt_pk_bf16(x1[0], x1[1]); wn[bj].w = cvt_pk_bf16(x1[2], x1[3]); }
                if (has_gm2) { const f32x4 q0 = *(const f32x4*)(gm2 + (size_t)b * 1024 + col0 + bj * 32), q1 = *(const f32x4*)(gm2 + (size_t)b * 1024 + col0 + bj * 32 + 4);
                    const f32x4 y0 = x0 * q0, y1 = x1 * q1; w2[bj].x = cvt_pk_bf16(y0[0], y0[1]); w2[bj].y = cvt_pk_bf16(y0[2], y0[3]); w2[bj].z = cvt_pk_bf16(y1[0], y1[1]); w2[bj].w = cvt_pk_bf16(y1[2], y1[3]); } }
            { const u32x4 sv = swp(hiL ? wn[0] : wn[1]); const u32x4 d1 = hiL ? sv : wn[0], d2 = hiL ? wn[1] : sv;
              char* dst = has_gm ? (char*)XG : (char*)X;
              __builtin_nontemporal_store(d1, (u32x4*)(dst + offA)); __builtin_nontemporal_store(d2, (u32x4*)(dst + offA + 8 * 2048)); }
            if (has_gm2) { const u32x4 sv = swp(hiL ? w2[0] : w2[1]); const u32x4 d1 = hiL ? sv : w2[0], d2 = hiL ? w2[1] : sv;
              *(u32x4*)((char*)XG2 + offA) = d1; *(u32x4*)((char*)XG2 + offA + 8 * 2048) = d2; }
            l1 = n1; l2 = n2;
            asm volatile("" ::: "memory"); }
#pragma unroll
        for (int ai = 0; ai < 2; ++ai)
#pragma unroll
            for (int m = 0; m < 4; ++m) { float t = ss[ai][m]; t = sum_fq(t);
                if (fq == 0) ssq[(size_t)(grow0 + ai * HALF + m * 16) * 16 + u.pn * 4 + wc] = t; }
    }
};

struct EpiFinal {
    static constexpr bool PERM = true, ADJ = false, AFTER_DRAIN = false;
    typedef __attribute__((address_space(1))) unsigned gu32_;
    unsigned char* ws; float* out; size_t gate_off; size_t gmp_off; const float* fg; gu32_* cnt; gu32_* tmo;
    __device__ __forceinline__ void operator()(const f32x4 (&acc)[2][2][4][2], const Unit& u, int wr, int wc, int fr, int fq) const {
        const bf16_t* XG = (const bf16_t*)(ws + WS_XG); float* ssq = (float*)(ws + WS_SSQ);
        const float* gate = (const float*)(ws + gate_off); const float* gmp = (const float*)(ws + gmp_off);
        const int grow0 = u.pm * BM + wr * 64 + fr;
        const int b = (u.pm * BM) >> 11;
        const int col0 = u.pn * BM + wc * 32 + 8 * fq;
        f32x4 xv[2][2][4][2];
        float ss[2][4];
#pragma unroll
        for (int ai = 0; ai < 2; ++ai)
#pragma unroll
            for (int m = 0; m < 4; ++m) ss[ai][m] = 0.f;
        u32x4 xq[2], xn[2];
#pragma unroll
        for (int mm = 0; mm < 2; ++mm) xq[mm] = *(const u32x4*)((const char*)XG + (unsigned)(((grow0 + mm * 16) * 1024 + col0) * 2));
        f32x4 gv0, gv1, rp0, rp1;
#pragma unroll
        for (int k = 0; k < 8; ++k) { const int bj = k >> 2, ai = (k >> 1) & 1, m0 = (k & 1) * 2; const int c = col0 + bj * HALF;
            if ((k & 3) == 0) {
                gv0 = *(const f32x4*)(gate + (size_t)b * 6144 + c); gv1 = *(const f32x4*)(gate + (size_t)b * 6144 + c + 4);
                const f32x4 p0 = *(const f32x4*)(gmp + (size_t)b * 1024 + c), p1 = *(const f32x4*)(gmp + (size_t)b * 1024 + c + 4);
#pragma unroll
                for (int e_ = 0; e_ < 4; ++e_) { rp0[e_] = (p0[e_] != 0.f) ? __builtin_amdgcn_rcpf(p0[e_]) : 0.f; rp1[e_] = (p1[e_] != 0.f) ? __builtin_amdgcn_rcpf(p1[e_]) : 0.f; } }
            if (k < 7) { const int bj2 = (k + 1) >> 2, ai2 = ((k + 1) >> 1) & 1, m2 = ((k + 1) & 1) * 2;
#pragma unroll
                for (int mm = 0; mm < 2; ++mm) xn[mm] = *(const u32x4*)((const char*)XG + (unsigned)(((grow0 + ai2 * HALF + (m2 + mm) * 16) * 1024 + col0 + bj2 * HALF) * 2)); }
#pragma unroll
            for (int mm = 0; mm < 2; ++mm) { const int m = m0 + mm; const u32x4 xw = xq[mm];
                f32x4 x0 = {__uint_as_float(xw.x << 16), __uint_as_float(xw.x & 0xffff0000u), __uint_as_float(xw.y << 16), __uint_as_float(xw.y & 0xffff0000u)};
                f32x4 x1 = {__uint_as_float(xw.z << 16), __uint_as_float(xw.z & 0xffff0000u), __uint_as_float(xw.w << 16), __uint_as_float(xw.w & 0xffff0000u)};
                x0 = x0 * rp0 + gv0 * acc[ai][bj][m][0]; x1 = x1 * rp1 + gv1 * acc[ai][bj][m][1];
                xv[bj][ai][m][0] = x0; xv[bj][ai][m][1] = x1;
                ss[ai][m] += ((x0[0] * x0[0] + x0[1] * x0[1]) + (x0[2] * x0[2] + x0[3] * x0[3])) + ((x1[0] * x1[0] + x1[1] * x1[1]) + (x1[2] * x1[2] + x1[3] * x1[3])); }
#pragma unroll
            for (int mm = 0; mm < 2; ++mm) xq[mm] = xn[mm]; }
#pragma unroll
        for (int ai = 0; ai < 2; ++ai)
#pragma unroll
            for (int m = 0; m < 4; ++m) { float t = ss[ai][m]; t = sum_fq(t);
                if (fq == 0) __hip_atomic_store(ssq + (size_t)(grow0 + ai * HALF + m * 16) * 16 + u.pn * 4 + wc, t, __ATOMIC_RELAXED, __HIP_MEMORY_SCOPE_AGENT); }
        asm volatile("s_waitcnt vmcnt(0)" ::: "memory");
        if ((threadIdx.x & 63) == 0) __hip_atomic_fetch_add(cnt + 64 * u.pm, 1u, __ATOMIC_RELAXED, __HIP_MEMORY_SCOPE_AGENT);
        if (threadIdx.x < 64) {
            const unsigned long long t0 = __builtin_amdgcn_s_memrealtime(); unsigned polls = 0;
            while ((unsigned)__builtin_amdgcn_readfirstlane(__hip_atomic_load(cnt + 64 * u.pm, __ATOMIC_RELAXED, __HIP_MEMORY_SCOPE_AGENT)) < 32u) {
                if ((++polls & 63u) == 0u && __builtin_amdgcn_readfirstlane(__hip_atomic_load(tmo, __ATOMIC_RELAXED, __HIP_MEMORY_SCOPE_AGENT)) != 0u) break;
                if (__builtin_amdgcn_s_memrealtime() - t0 > 2000000ull) { if (threadIdx.x == 0) __hip_atomic_store(tmo, 1u, __ATOMIC_RELAXED, __HIP_MEMORY_SCOPE_AGENT); break; }
                __builtin_amdgcn_s_sleep(2); }
            __builtin_amdgcn_fence(__ATOMIC_ACQUIRE, "agent");
            asm volatile("s_waitcnt vmcnt(0)" ::: "memory");
        }
        asm volatile("" ::: "memory"); __builtin_amdgcn_s_barrier(); asm volatile("" ::: "memory");
        const bool bad = __hip_atomic_load(tmo, __ATOMIC_RELAXED, __HIP_MEMORY_SCOPE_AGENT) != 0u;
#pragma unroll
        for (int ai = 0; ai < 2; ++ai)
#pragma unroll
            for (int m = 0; m < 4; ++m) { const int row = grow0 + ai * HALF + m * 16;
                const f32x4 pr = *(const f32x4*)(ssq + (size_t)row * 16 + 4 * fq);
                float s = (pr[0] + pr[1]) + (pr[2] + pr[3]); s = sum_fq(s);
                const float rstd = bad ? 0.f : rsqrtf(s * (1.0f / 1024.0f) + 1e-6f);
#pragma unroll
                for (int bj = 0; bj < 2; ++bj) { const int c = col0 + bj * HALF;
                    const f32x4 f0 = *(const f32x4*)(fg + c), f1 = *(const f32x4*)(fg + c + 4);
                    f32x4 y0 = xv[bj][ai][m][0] * rstd * f0, y1 = xv[bj][ai][m][1] * rstd * f1;
                    if (bad) { y0 = (f32x4){5000.f, 5000.f, 5000.f, 5000.f}; y1 = y0; }
                    float* op = out + (size_t)row * 1024 + c; *(f32x4*)op = y0; *(f32x4*)(op + 4) = y1; } }
    }
};
template <class Epi, class Sched, bool ALIGN_EPI = false, bool SP2 = false>
__device__ __forceinline__ void gemm_phase(PG8_LAS unsigned char* lds, const Gemm g, const Sched& S, const Epi& E) {
    int tid_ = threadIdx.x; asm volatile("" : "+v"(tid_));
    const int tid = tid_, wid = __builtin_amdgcn_readfirstlane(tid >> 6), lane = tid & 63, wr = wid >> 2, wc = wid & 3, fr = lane & 15, fq = lane >> 4;
    const int K = g.K, nt = K / BK;
    unsigned voffA[2], voffB[2];
#pragma unroll
    for (int i = 0; i < 2; ++i) { int R, C; stage_rc(tid * 16 + i * 8192, R, C); const int Rb = !Epi::PERM ? R : Epi::ADJ ? ((R >> 5) * 64 + perm32(R & 31)) : ((R & ~31) + perm32(R & 31));
        voffA[i] = (unsigned)(R * K + C) * 2u; voffB[i] = (unsigned)(Rb * K + C) * 2u; }
    const size_t kstep = (size_t)(BK * 2);
    const size_t hstep = (size_t)HALF * K * 2;
    const size_t tstep = 2 * hstep;
    const size_t hstepB = Epi::ADJ ? (size_t)32 * K * 2 : hstep;
    const unsigned ldsw = (unsigned)wid * 1024u;
    const int aoff = lds_byte(wr * 64 + fr, fq * 8), boff = lds_byte(wc * 32 + fr, fq * 8);
#define PG8_SA(b, h) (((b) * 2 + (h)) * HTB)
#define PG8_SB(b, h) ((4 + (b) * 2 + (h)) * HTB)
#define PG8_STAGE(bufoff, gbase, voff) do { _Pragma("unroll") for (int _i = 0; _i < 2; ++_i) \
        __builtin_amdgcn_global_load_lds((const unsigned*)((const char*)(gbase) + (voff)[_i]), (PG8_LAS unsigned*)(lds + (bufoff) + ldsw + _i * 8192), 16, 0, 0); } while (0)
#define PG8_LDA(dst, b, h) do { _Pragma("unroll") for (int m = 0; m < 4; ++m) _Pragma("unroll") for (int k = 0; k < 2; ++k) dst[m][k] = *(const PG8_LAS bf16x8*)(lds + PG8_SA(b, h) + aoff + m * 2048 + k * 1024); } while (0)
#define PG8_LDB(dst, b, h) do { _Pragma("unroll") for (int n = 0; n < 2; ++n) _Pragma("unroll") for (int k = 0; k < 2; ++k) dst[n][k] = *(const PG8_LAS bf16x8*)(lds + PG8_SB(b, h) + boff + n * 2048 + k * 1024); } while (0)
#define PG8_MMA(ai, bj, At, Bt) do { __builtin_amdgcn_s_setprio(1); _Pragma("unroll") for (int m = 0; m < 4; ++m) _Pragma("unroll") for (int n = 0; n < 2; ++n) _Pragma("unroll") for (int k = 0; k < 2; ++k) \
        acc[ai][bj][m][n] = __builtin_amdgcn_mfma_f32_16x16x32_bf16(Bt[n][k], At[m][k], acc[ai][bj][m][n], 0, 0, 0); __builtin_amdgcn_s_setprio(0); } while (0)
#define PG8_WAIT_V(n) asm volatile("s_waitcnt vmcnt(" #n ")" ::: "memory")
#define PG8_WAIT_L(n) asm volatile("s_waitcnt lgkmcnt(" #n ")" ::: "memory")
#define PG8_BAR __builtin_amdgcn_s_barrier()
#define PG8_SCHED __builtin_amdgcn_sched_barrier(0)
    Unit cur, nxt; int ui = 0;
    if (!S.next(0, cur)) return;
    f32x4 acc[2][2][4][2];
#pragma unroll
    for (int a = 0; a < 2; ++a)
#pragma unroll
        for (int b = 0; b < 2; ++b)
#pragma unroll
            for (int m = 0; m < 4; ++m)
#pragma unroll
                for (int n = 0; n < 2; ++n) acc[a][b][m][n] = (f32x4){0.f, 0.f, 0.f, 0.f};
    bf16x8 At[4][2], B0[2][2], B1[2][2];
    const char* cA = (const char*)g.A + (size_t)cur.pm * tstep; const char* cB = (const char*)g.Bt + (size_t)cur.pn * tstep;
    S.a_ready(cur);
    if constexpr (SP2) {
        PG8_STAGE(PG8_SB(0, 0), cB, voffB); PG8_STAGE(PG8_SB(0, 1), cB + hstepB, voffB); PG8_STAGE(PG8_SA(0, 0), cA, voffA); PG8_STAGE(PG8_SA(0, 1), cA + hstep, voffA);
        if (wr == 1) PG8_BAR;
        PG8_WAIT_V(2); PG8_BAR;
        PG8_STAGE(PG8_SB(1, 0), cB + kstep, voffB); PG8_STAGE(PG8_SA(1, 0), cA + kstep, voffA); PG8_STAGE(PG8_SB(1, 1), cB + hstepB + kstep, voffB);
        PG8_WAIT_V(6); PG8_BAR;
    } else {
        PG8_STAGE(PG8_SB(0, 0), cB, voffB); PG8_STAGE(PG8_SA(0, 0), cA, voffA); PG8_STAGE(PG8_SB(0, 1), cB + hstepB, voffB); PG8_STAGE(PG8_SA(0, 1), cA + hstep, voffA);
        if (wr == 1) PG8_BAR;
        PG8_WAIT_V(4); PG8_BAR;
        PG8_STAGE(PG8_SB(1, 0), cB + kstep, voffB); PG8_STAGE(PG8_SA(1, 0), cA + kstep, voffA); PG8_STAGE(PG8_SB(1, 1), cB + hstepB + kstep, voffB);
        PG8_WAIT_V(6); PG8_BAR;
    }
    for (;;) {
        const bool has_next = S.next(ui + 1, nxt);
        const char* nA = has_next ? (const char*)g.A + (size_t)nxt.pm * tstep : cA; const char* nB = has_next ? (const char*)g.Bt + (size_t)nxt.pn * tstep : cB;
        for (int t = 0; t < nt; t += 2) {
            const bool last = (t == nt - 2);
            const char* a1 = cA + (size_t)(t + 1) * kstep;
            const char* a2 = last ? nA : cA + (size_t)(t + 2) * kstep; const char* b2 = last ? nB : cB + (size_t)(t + 2) * kstep;
            const char* a3 = a2 + kstep; const char* b3 = b2 + kstep;
            if (last && has_next) S.a_ready(nxt);
            if constexpr (SP2) {
            PG8_LDB(B0, 0, 0); PG8_LDB(B1, 0, 1); PG8_SCHED; PG8_LDA(At, 0, 0); PG8_STAGE(PG8_SA(1, 1), a1 + hstep, voffA);
            PG8_WAIT_V(8); PG8_WAIT_L(0); PG8_BAR; PG8_MMA(0, 0, At, B0); PG8_MMA(0, 1, At, B1); PG8_BAR; PG8_SCHED;
            PG8_LDA(At, 0, 1); PG8_STAGE(PG8_SB(0, 0), b2, voffB); PG8_STAGE(PG8_SB(0, 1), b2 + hstepB, voffB); PG8_STAGE(PG8_SA(0, 0), a2, voffA);
            PG8_WAIT_V(8); PG8_WAIT_L(0); PG8_BAR; PG8_MMA(1, 0, At, B0); PG8_MMA(1, 1, At, B1); PG8_BAR; PG8_SCHED;
            PG8_LDB(B0, 1, 0); PG8_LDB(B1, 1, 1); PG8_SCHED; PG8_LDA(At, 1, 0); PG8_STAGE(PG8_SA(0, 1), a2 + hstep, voffA);
            PG8_WAIT_V(8); PG8_WAIT_L(0); PG8_BAR; PG8_MMA(0, 0, At, B0); PG8_MMA(0, 1, At, B1); PG8_BAR; PG8_SCHED;
            PG8_LDA(At, 1, 1); PG8_STAGE(PG8_SB(1, 0), b3, voffB); PG8_STAGE(PG8_SB(1, 1), b3 + hstepB, voffB); PG8_STAGE(PG8_SA(1, 0), a3, voffA);
            PG8_WAIT_V(8); PG8_WAIT_L(0); PG8_BAR; PG8_MMA(1, 0, At, B0); PG8_MMA(1, 1, At, B1); PG8_BAR; PG8_SCHED;
            } else {
            PG8_LDB(B0, 0, 0); PG8_SCHED; PG8_LDA(At, 0, 0); PG8_STAGE(PG8_SA(1, 1), a1 + hstep, voffA);
            PG8_WAIT_L(8); PG8_BAR; PG8_WAIT_L(0); PG8_MMA(0, 0, At, B0); PG8_BAR; PG8_SCHED;
            PG8_LDB(B1, 0, 1); PG8_STAGE(PG8_SB(0, 0), b2, voffB);
            PG8_BAR; PG8_WAIT_L(0); PG8_MMA(0, 1, At, B1); PG8_BAR;
            PG8_LDA(At, 0, 1); PG8_STAGE(PG8_SA(0, 0), a2, voffA);
            PG8_BAR; PG8_WAIT_L(0); PG8_MMA(1, 0, At, B0); PG8_BAR; PG8_SCHED;
            PG8_STAGE(PG8_SB(0, 1), b2 + hstepB, voffB);
            PG8_WAIT_V(6); PG8_BAR; PG8_MMA(1, 1, At, B1); PG8_BAR;
            PG8_LDB(B0, 1, 0); PG8_SCHED; PG8_LDA(At, 1, 0); PG8_STAGE(PG8_SA(0, 1), a2 + hstep, voffA);
            PG8_WAIT_L(8); PG8_BAR; PG8_WAIT_L(0); PG8_MMA(0, 0, At, B0); PG8_BAR; PG8_SCHED;
            PG8_LDB(B1, 1, 1); PG8_STAGE(PG8_SB(1, 0), b3, voffB);
            PG8_BAR; PG8_WAIT_L(0); PG8_MMA(0, 1, At, B1); PG8_BAR;
            PG8_LDA(At, 1, 1); PG8_STAGE(PG8_SA(1, 0), a3, voffA);
            PG8_BAR; PG8_WAIT_L(0); PG8_MMA(1, 0, At, B0); PG8_BAR; PG8_SCHED;
            PG8_STAGE(PG8_SB(1, 1), b3 + hstepB, voffB);
            PG8_WAIT_V(6); PG8_BAR; PG8_MMA(1, 1, At, B1); PG8_BAR;
            }
        }
        if constexpr (ALIGN_EPI) { if (wr == 0) PG8_BAR; }
        if constexpr (!Epi::AFTER_DRAIN) { E(acc, cur, wr, wc, fr, fq); S.done(cur); }
        if (!has_next) break;
#pragma unroll
        for (int a = 0; a < 2; ++a)
#pragma unroll
            for (int b = 0; b < 2; ++b)
#pragma unroll
                for (int m = 0; m < 4; ++m)
#pragma unroll
                    for (int n = 0; n < 2; ++n) acc[a][b][m][n] = (f32x4){0.f, 0.f, 0.f, 0.f};
        cur = nxt; cA = nA; cB = nB; ++ui;
        if constexpr (ALIGN_EPI) { if (wr == 1) PG8_BAR; }
    }
    PG8_WAIT_V(0);
    if constexpr (!ALIGN_EPI) { if (wr == 0) PG8_BAR; }
    PG8_BAR;
    if constexpr (Epi::AFTER_DRAIN) { E.fused(acc, cur, wr, wc, fr, fq, lds, wid, lane); S.done(cur); }
#undef PG8_SA
#undef PG8_SB
#undef PG8_STAGE
#undef PG8_LDA
#undef PG8_LDB
#undef PG8_MMA
#undef PG8_WAIT_V
#undef PG8_WAIT_L
#undef PG8_BAR
#undef PG8_SCHED
}
}

#ifndef PG8_SP2
#define PG8_SP2 true
#endif
#ifndef PG8_ALIGN
#define PG8_ALIGN true
#endif
namespace at2 {
typedef unsigned short bf16;
typedef short bf16x8 __attribute__((ext_vector_type(8)));
typedef short s16x4 __attribute__((ext_vector_type(4)));
typedef float f32x16 __attribute__((ext_vector_type(16)));
typedef unsigned u32x4 __attribute__((ext_vector_type(4)));
constexpr int DK = 64, DV = 128, SKV = 2048, W = SKV;
constexpr int PQ = 1024, PK = 2048, PV = 2048, PO = 2048;
constexpr float SCALE = 0.125f, THR = 8.f, C2 = 0.125f * 1.4426950408889634f;
constexpr int NW = 8, QBLK = 32, KVBLK = 64, QB = NW * QBLK;
constexpr int SHM_V = KVBLK * DV * 2, SHM_K = KVBLK * DK * 2;
constexpr int LDS_BYTES = 2 * SHM_V + 2 * SHM_K + NW * 64 * 4;
#define KSWZ(row, colB) ((row) * 128 + ((colB) ^ (((row) & 7) << 4)))
#define SBAR() __builtin_amdgcn_sched_barrier(0)
__device__ __forceinline__ int v_st(int k, int c) { const int kk = (k & ~0xC) | ((k & 4) << 1) | ((k & 8) >> 1); return ((kk >> 3) * 4 + (c >> 5)) * 512 + ((kk & 7) * 32 + (c & 31)) * 2; }
__device__ __forceinline__ int v_rd_base(int lane) { return ((lane & 3) << 3) | (((lane >> 2) & 3) << 6) | (((lane >> 4) & 1) << 5) | (((lane >> 5) & 1) << 8); }
constexpr int v_rd_off(int d0, int ks, int half) { return d0 * 512 + ks * 4096 + half * 2048; }
__device__ __forceinline__ int crow(int r, int hi) { return (r & 3) + 8 * (r >> 2) + 4 * hi; }
__device__ __forceinline__ unsigned cvtpk(float lo, float hi) { unsigned r; asm volatile("v_cvt_pk_bf16_f32 %0, %1, %2" : "=v"(r) : "v"(lo), "v"(hi)); return r; }
__device__ __forceinline__ bf16x8 load8(const bf16* p) { return *reinterpret_cast<const bf16x8*>(p); }
__device__ __forceinline__ void mask_tile(f32x16& p0, f32x16& p1, int dq, unsigned Wu) {
    const float NEG = -__builtin_inff();
#pragma unroll
    for (int r = 0; r < 16; ++r) {
        const int c = (r & 3) + 8 * (r >> 2);
        if ((unsigned)(dq - c) >= Wu) p0[r] = NEG;
        if ((unsigned)(dq - c - 32) >= Wu) p1[r] = NEG;
    }
}
constexpr float THR2 = THR * 1.4426950408889634f;
__device__ __forceinline__ void partialSM(f32x16& p0, f32x16& p1, float& mref, float& alpha, bool first) {
    float pa = fmaxf(fmaxf(p0[0], p0[1]), p0[2]), pb = fmaxf(fmaxf(p1[0], p1[1]), p1[2]);
#pragma unroll
    for (int r = 3; r < 15; r += 2) { pa = fmaxf(fmaxf(pa, p0[r]), p0[r + 1]); pb = fmaxf(fmaxf(pb, p1[r]), p1[r + 1]); }
    float pmax = fmaxf(fmaxf(pa, pb), fmaxf(p0[15], p1[15]));
    { auto rr = __builtin_amdgcn_permlane32_swap(__float_as_uint(pmax), __float_as_uint(pmax), false, false);
      pmax = fmaxf(__uint_as_float(rr[0]), __uint_as_float(rr[1])); }
    if (__builtin_expect(!first && __all(pmax <= THR2), 1)) { alpha = 1.f; }
    else { const float d = first ? pmax : fmaxf(pmax, 0.f); alpha = __builtin_amdgcn_exp2f(-d); mref += d;
#pragma unroll
        for (int r = 0; r < 16; ++r) { p0[r] -= d; p1[r] -= d; } }
#pragma unroll
    for (int r = 0; r < 16; ++r) p0[r] = __builtin_amdgcn_exp2f(p0[r]);
}
__device__ __forceinline__ void finishSM(f32x16& p0, f32x16& p1, float alpha, float& l_reg, bf16x8& pa0, bf16x8& pa1, bf16x8& pa2, bf16x8& pa3) {
    for (int r = 0; r < 16; ++r) p1[r] = __builtin_amdgcn_exp2f(p1[r]);
    typedef float f32x2_ __attribute__((ext_vector_type(2)));
    f32x2_ sa = {p0[0], p0[1]}, sb = {p1[0], p1[1]};
#pragma unroll
    for (int r = 2; r < 16; r += 2) { sa += (f32x2_){p0[r], p0[r + 1]}; sb += (f32x2_){p1[r], p1[r + 1]}; }
    sa += sb; float ps = sa.x + sa.y;
    { auto rr = __builtin_amdgcn_permlane32_swap(__float_as_uint(ps), __float_as_uint(ps), false, false);
      ps = __uint_as_float(rr[0]) + __uint_as_float(rr[1]); }
    l_reg = l_reg * alpha + ps;
#define PK4(P, B_, OUT) do { unsigned a0 = cvtpk(P[B_+0], P[B_+1]), a1 = cvtpk(P[B_+2], P[B_+3]);                          \
        unsigned b0 = cvtpk(P[B_+4], P[B_+5]), b1 = cvtpk(P[B_+6], P[B_+7]);                                             \
        auto r0 = __builtin_amdgcn_permlane32_swap(a0, b0, false, false); auto r1 = __builtin_amdgcn_permlane32_swap(a1, b1, false, false); \
        u32x4 w = {r0[0], r1[0], r0[1], r1[1]}; OUT = *reinterpret_cast<bf16x8*>(&w); } while (0)
    PK4(p0, 0, pa0); PK4(p0, 8, pa1); PK4(p1, 0, pa2); PK4(p1, 8, pa3);
#undef PK4
}
template <int KB>
__device__ __forceinline__ void qkt(f32x16& p0, f32x16& p1, const char* K_lds, int r32, int hi, const bf16x8* qr, float mref) {
#pragma unroll
    for (int r = 0; r < 16; ++r) { p0[r] = -mref; p1[r] = -mref; }
#pragma unroll
    for (int d0 = 0; d0 < 4; ++d0) { const char* a = K_lds + KB * SHM_K + KSWZ(r32, (d0 * 16 + hi * 8) * 2);
        bf16x8 b0 = *reinterpret_cast<const bf16x8*>(a);
        bf16x8 b1 = *reinterpret_cast<const bf16x8*>(a + 32 * 128);
        p0 = __builtin_amdgcn_mfma_f32_32x32x16_bf16(b0, qr[d0], p0, 0, 0, 0);
        p1 = __builtin_amdgcn_mfma_f32_32x32x16_bf16(b1, qr[d0], p1, 0, 0, 0); }
}
template <int VB>
__device__ __forceinline__ void pv_tile(f32x16* o, int vb0, bf16x8 pa0, bf16x8 pa1, bf16x8 pa2, bf16x8 pa3) {
#define TRRD(dst, off) asm volatile("ds_read_b64_tr_b16 %0, %1 offset:%2" : "=&v"(dst) : "v"(vb0), "i"(off) : "memory")
#define PV_D0(d0) do { s16x4 l0, l1, l2, l3, h0, h1, h2, h3; constexpr int b_ = VB * SHM_V + v_rd_off(d0, 0, 0);   \
        TRRD(l0, b_); TRRD(h0, b_ + 2048); TRRD(l1, b_ + 4096); TRRD(h1, b_ + 6144); TRRD(l2, b_ + 8192); TRRD(h2, b_ + 10240); TRRD(l3, b_ + 12288); TRRD(h3, b_ + 14336); \
        asm volatile("s_waitcnt lgkmcnt(0)" ::: "memory"); SBAR();   \
        o[d0] = __builtin_amdgcn_mfma_f32_32x32x16_bf16(pa0, (bf16x8){l0[0], l0[1], l0[2], l0[3], h0[0], h0[1], h0[2], h0[3]}, o[d0], 0, 0, 0);   \
        o[d0] = __builtin_amdgcn_mfma_f32_32x32x16_bf16(pa1, (bf16x8){l1[0], l1[1], l1[2], l1[3], h1[0], h1[1], h1[2], h1[3]}, o[d0], 0, 0, 0);   \
        o[d0] = __builtin_amdgcn_mfma_f32_32x32x16_bf16(pa2, (bf16x8){l2[0], l2[1], l2[2], l2[3], h2[0], h2[1], h2[2], h2[3]}, o[d0], 0, 0, 0);   \
        o[d0] = __builtin_amdgcn_mfma_f32_32x32x16_bf16(pa3, (bf16x8){l3[0], l3[1], l3[2], l3[3], h3[0], h3[1], h3[2], h3[3]}, o[d0], 0, 0, 0); } while (0)
    PV_D0(0); PV_D0(1); PV_D0(2); PV_D0(3);
#undef PV_D0
#undef TRRD
}
struct BlockRef { const bf16* Q; const bf16* K; const bf16* V; bf16* O; int P0; };
struct Seam { bf16x8 qr[4]; bf16x8 st_v0, st_v1, st_k0; };
#define VMW() asm volatile("s_waitcnt vmcnt(0)" ::: "memory")
#define VMWN(n) asm volatile("s_waitcnt vmcnt(%0)" :: "i"(n) : "memory")
#define SLOAD_H(Kp, Vp, k0) do { S.st_v0 = load8((Vp) + (size_t)((k0) + sr) * PV + sc); S.st_v1 = load8((Vp) + (size_t)((k0) + 32 + sr) * PV + sc);              \
                         S.st_k0 = load8((Kp) + (size_t)((k0) + srk) * PK + sck); } while (0)
#define SWRITE_HK(bf) do { *(bf16x8*)(K_lds + (bf) * SHM_K + kws) = S.st_k0; } while (0)
#define SWRITE_HV(bf) do { *(bf16x8*)(V_lds + (bf) * SHM_V + vst0) = S.st_v0; *(bf16x8*)(V_lds + (bf) * SHM_V + vst1) = S.st_v1; } while (0)
#define SWRITE_H(bf) do { SWRITE_HV(bf); SWRITE_HK(bf); } while (0)
__device__ __forceinline__ void prime(const BlockRef& cur, char* lds, Seam& S) {
    int tid_ = threadIdx.x; asm volatile("" : "+v"(tid_));
    const int tid = tid_, wid = __builtin_amdgcn_readfirstlane(tid >> 6), lane = tid & 63, r32 = lane & 31, hi = lane >> 5;
    const int sr = tid >> 4, sc = (tid & 15) * 8, srk = tid >> 3, sck = (tid & 7) * 8, kws = KSWZ(srk, sck * 2); char* K_lds = lds + 2 * SHM_V;
    const int rbw = (wid < 4) ? wid : 11 - wid;
    for (int d0 = 0; d0 < 4; ++d0) S.qr[d0] = load8(cur.Q + (size_t)(rbw * QBLK + r32) * PQ + d0 * 16 + hi * 8);
    SLOAD_H(cur.K, cur.V, 0); VMW(); SWRITE_HK(0);
    __syncthreads();
}
constexpr int PARK_OFF = 53248, PARK_WAVE = 8192;
template <int MODE>
__device__ __forceinline__ void block(const BlockRef& cur, const BlockRef& nxt, char* lds, Seam& S, float lam, float post, const float* sg) {
    int tid_ = threadIdx.x; asm volatile("" : "+v"(tid_));
    const int tid = tid_, wid = __builtin_amdgcn_readfirstlane(tid >> 6), lane = tid & 63, r32 = lane & 31, hi = lane >> 5;
    const int NT = (cur.P0 + QB - 1) / KVBLK + 1;
    const int rbw = (wid < 4) ? wid : 11 - wid;
    const int qlo = cur.P0 + rbw * QBLK, qm = qlo + r32 - 4 * hi;
    const int TL = (qlo + QBLK - 1) >> 6;
    char* V_lds = lds; char* K_lds = lds + 2 * SHM_V;
    float* ws = (float*)(lds + 2 * SHM_V + 2 * SHM_K) + wid * 64; float* li_l = ws, * al_l = ws + 32;
    float mref = 0.f, l_reg = 0; f32x16 o[4] = {};
    const int sr = tid >> 4, sc = (tid & 15) * 8, vst0 = v_st(sr, sc), vst1 = v_st(32 + sr, sc), srk = tid >> 3, sck = (tid & 7) * 8, kws = KSWZ(srk, sck * 2);
    const int vb0 = (int)(uintptr_t)V_lds + v_rd_base(lane);
    const bf16* Kh = cur.K; const bf16* Vh = cur.V;
#define RESC(a) do { if (__any((a) < 1.f)) { if (hi == 0) al_l[r32] = (a); asm volatile("s_waitcnt lgkmcnt(0)" ::: "memory");              \
                     for (int d_ = 0; d_ < 4; ++d_) for (int r = 0; r < 16; ++r) o[d_][r] *= al_l[crow(r, hi)]; } } while (0)
#define KBASE(t) ((t) * KVBLK)
#define MASKT(P0_, P1_, t) do { const int kb_ = KBASE(t); if (kb_ + KVBLK - 1 > qlo) { asm volatile("; diagonal tile: mask" ::: "memory");     \
        mask_tile(P0_, P1_, qm - kb_, (unsigned)W); } } while (0)
    constexpr int NQL = 4;
#define SEAM_K0() do { VMWN(NQL); SWRITE_HK(0); SBAR(); } while (0)
    f32x16 pA0, pA1, pB0, pB1; float alA, alB;
    SWRITE_HV(0); SBAR();
    if (NT > 1) SLOAD_H(Kh, Vh, KBASE(1));
    SBAR(); qkt<0>(pA0, pA1, K_lds, r32, hi, S.qr, mref);
    MASKT(pA0, pA1, 0); partialSM(pA0, pA1, mref, alA, true);
    if (NT > 1) { VMW(); SWRITE_H(1); }
    __syncthreads();
#define HALF_STEP(PX0, PX1, alX, PY0, PY1, alY, t, KB, VB, SB) do { bf16x8 pa0, pa1, pa2, pa3;                              \
        SBAR(); qkt<KB>(PX0, PX1, K_lds, r32, hi, S.qr, mref);                                                                \
        finishSM(PY0, PY1, alY, l_reg, pa0, pa1, pa2, pa3); SBAR();                                                           \
        if ((t) + 1 < NT) { SLOAD_H(Kh, Vh, KBASE((t) + 1)); SBAR(); }                                                        \
        pv_tile<VB>(o, vb0, pa0, pa1, pa2, pa3); MASKT(PX0, PX1, (t)); partialSM(PX0, PX1, mref, alX, false);                  \
        __syncthreads();                                                                                                      \
        if ((t) + 1 < NT) { VMW(); SWRITE_H(SB); }                                                                            \
        RESC(alX); __syncthreads(); } while (0)
#define HALF_STEP_C(PX0, PX1, alX, PY0, PY1, alY, t, KB, VB, SB) do { bf16x8 pa0, pa1, pa2, pa3;                            \
        SBAR(); if ((t) <= TL) qkt<KB>(PX0, PX1, K_lds, r32, hi, S.qr, mref);                                                 \
        if ((t) - 1 <= TL) finishSM(PY0, PY1, alY, l_reg, pa0, pa1, pa2, pa3); SBAR();                                        \
        if ((t) + 1 < NT) { SLOAD_H(Kh, Vh, KBASE((t) + 1)); SBAR(); }                                                        \
        if ((t) - 1 <= TL) pv_tile<VB>(o, vb0, pa0, pa1, pa2, pa3);                                                           \
        if ((t) <= TL) { MASKT(PX0, PX1, (t)); partialSM(PX0, PX1, mref, alX, false); } else alX = 1.f;                        \
        __syncthreads();                                                                                                      \
        if ((t) + 1 < NT) { VMW(); SWRITE_H(SB); }                                                                            \
        RESC(alX); __syncthreads(); } while (0)
    for (int t = 1; t + 3 < NT; t += 2) {
        HALF_STEP(pB0, pB1, alB, pA0, pA1, alA, t, 1, 0, 0);
        HALF_STEP(pA0, pA1, alA, pB0, pB1, alB, t + 1, 0, 1, 1);
    }
    HALF_STEP(pB0, pB1, alB, pA0, pA1, alA, NT - 3, 1, 0, 0);
    HALF_STEP_C(pA0, pA1, alA, pB0, pB1, alB, NT - 2, 0, 1, 1);
    const bool even = (NT & 1) == 0;
    if (even) { SBAR(); if (NT - 1 <= TL) qkt<1>(pB0, pB1, K_lds, r32, hi, S.qr, mref); SBAR(); }
    SLOAD_H(nxt.K, nxt.V, 0); SBAR();
#pragma unroll
    for (int d0 = 0; d0 < 4; ++d0) S.qr[d0] = load8(nxt.Q + (size_t)(rbw * QBLK + r32) * PQ + d0 * 16 + hi * 8);
    SBAR();
    if (NT - 2 <= TL) { bf16x8 pa0, pa1, pa2, pa3; finishSM(pA0, pA1, alA, l_reg, pa0, pa1, pa2, pa3); SBAR();
        pv_tile<0>(o, vb0, pa0, pa1, pa2, pa3); }
    if (even) { if (NT - 1 <= TL) { MASKT(pB0, pB1, NT - 1); partialSM(pB0, pB1, mref, alB, false); } else alB = 1.f;
        __syncthreads(); RESC(alB);
        if (NT - 1 <= TL) { bf16x8 pa0, pa1, pa2, pa3; finishSM(pB0, pB1, alB, l_reg, pa0, pa1, pa2, pa3); SBAR(); pv_tile<1>(o, vb0, pa0, pa1, pa2, pa3); } }
    SBAR(); SEAM_K0();
    if (hi == 0) li_l[r32] = l_reg; asm volatile("s_waitcnt lgkmcnt(0)" ::: "memory");
    float rli[16];
#pragma unroll
    for (int r = 0; r < 16; ++r) rli[r] = __builtin_amdgcn_rcpf(li_l[crow(r, hi)]);
    unsigned* park = (unsigned*)(lds + PARK_OFF + wid * PARK_WAVE) + lane;
    if (MODE == 0) {
#pragma unroll
        for (int r = 0; r < 16; ++r) { park[(2 * r) * 64] = cvtpk(o[0][r] * rli[r], o[1][r] * rli[r]); park[(2 * r + 1) * 64] = cvtpk(o[2][r] * rli[r], o[3][r] * rli[r]); }
    } else {
        float gsub[4];
#pragma unroll
        for (int d0 = 0; d0 < 4; ++d0) gsub[d0] = sg[d0 * 32 + r32];
        bf16* Ow = cur.O + (size_t)(rbw * QBLK) * 1024;
        unsigned pk[32];
#pragma unroll
        for (int i = 0; i < 32; ++i) pk[i] = park[i * 64];
        asm volatile("s_waitcnt lgkmcnt(0)" ::: "memory");
        char* tr = lds + PARK_OFF + wid * PARK_WAVE;
#pragma unroll
        for (int r = 0; r < 16; ++r) { const unsigned w0 = pk[2 * r], w1 = pk[2 * r + 1];
            float x[4] = {__uint_as_float(w0 << 16) - lam * (o[0][r] * rli[r]), __uint_as_float(w0 & 0xffff0000u) - lam * (o[1][r] * rli[r]),
                          __uint_as_float(w1 << 16) - lam * (o[2][r] * rli[r]), __uint_as_float(w1 & 0xffff0000u) - lam * (o[3][r] * rli[r])};
            float ss = (x[0] * x[0] + x[1] * x[1]) + (x[2] * x[2] + x[3] * x[3]);
            ss += __shfl_xor(ss, 1); ss += __shfl_xor(ss, 2); ss += __shfl_xor(ss, 4); ss += __shfl_xor(ss, 8); ss += __shfl_xor(ss, 16);
            const float rstd = rsqrtf(ss * (1.0f / 128.0f) + 1e-5f) * post; const int orow = crow(r, hi);
#pragma unroll
            for (int d0 = 0; d0 < 4; ++d0) { const float v = x[d0] * rstd * gsub[d0];
                *(unsigned short*)(tr + orow * 256 + (d0 * 32 + r32) * 2) = (unsigned short)cvtpk(v, 0.f); } }
        asm volatile("s_waitcnt lgkmcnt(0)" ::: "memory");
#pragma unroll
        for (int j = 0; j < 8; ++j) { const int p = lane + 64 * j, row = p >> 4, c8 = p & 15;
            const u32x4 wv = *(const u32x4*)(tr + row * 256 + c8 * 16);
            __builtin_nontemporal_store(wv, (u32x4*)(Ow + (size_t)row * 1024 + c8 * 8)); }
    }
    __syncthreads();
#undef RESC
#undef KBASE
#undef MASKT
#undef SEAM_K0
#undef HALF_STEP
#undef HALF_STEP_C
}
#undef VMW
#undef VMWN
#undef SLOAD_H
#undef SWRITE_HK
#undef SWRITE_HV
#undef SWRITE_H
#undef KSWZ
#undef SBAR
}
#define GAS __attribute__((address_space(1)))
#define LAS __attribute__((address_space(3)))
typedef unsigned short bf16;
typedef unsigned v4u __attribute__((ext_vector_type(4)));
typedef float f32x4 __attribute__((ext_vector_type(4)));
typedef short bf16x8 __attribute__((ext_vector_type(8)));
typedef GAS unsigned gu32;
typedef GAS unsigned long long gu64;
#define RLX_AGENT __ATOMIC_RELAXED, __HIP_MEMORY_SCOPE_AGENT
#define LDS_WAIT() asm volatile("s_waitcnt lgkmcnt(0)" ::: "memory")
#define VM_WAIT() asm volatile("s_waitcnt vmcnt(0)" ::: "memory")
__device__ __forceinline__ unsigned long long rt() { return __builtin_amdgcn_s_memrealtime(); }
__device__ __forceinline__ unsigned f2bf(float f) { unsigned u = __builtin_bit_cast(unsigned, f); return (u + 0x7fffu + ((u >> 16) & 1u)) >> 16; }
__device__ __forceinline__ unsigned pk2(float lo, float hi) { return f2bf(lo) | (f2bf(hi) << 16); }

#define XB_TMO      128
#define XB_XCNT(j)  (256  + 64 * (j))
#define XB_XSUB(j)  (1280 + 64 * (j))
#define XB_XGEN(j)  (2304 + 64 * (j))
#define XB_TOP      3328
#define XB_TOPGEN   3392
#define XCD_BAR_WORDS 3456
#define XB_SPIN_CAP (1u << 18)

__device__ __forceinline__ unsigned xb_ld(unsigned* p)              { return __hip_atomic_load(p, __ATOMIC_RELAXED, __HIP_MEMORY_SCOPE_AGENT); }
__device__ __forceinline__ unsigned xb_add(unsigned* p, unsigned v) { return __hip_atomic_fetch_add(p, v, __ATOMIC_RELAXED, __HIP_MEMORY_SCOPE_AGENT); }
__device__ __forceinline__ unsigned xb_xcc_id() { return (unsigned)__builtin_amdgcn_s_getreg((3 << 11) | 20) & 0xFu; }
#define XB_SPIN(cond, bar) do { unsigned _sp = 0; while (cond) { __builtin_amdgcn_s_sleep(1); \
    if ((++_sp & 255u) == 0u) { if (xb_ld(&(bar)[XB_TMO])) break; if (_sp > XB_SPIN_CAP) { atomicAdd(&(bar)[XB_TMO], 1u); break; } } } } while (0)

struct XcdBarrier {
    unsigned* bar; unsigned x;
    volatile LAS unsigned* st;
};

__device__ __forceinline__ XcdBarrier xcd_barrier_post(unsigned* bar, volatile LAS unsigned* st) {
    XcdBarrier b; b.bar = bar; b.x = xb_xcc_id(); b.st = st;
    if (threadIdx.x == 0) (void)xb_add(&bar[XB_XCNT(b.x)], 1u);
    return b;
}
__device__ __forceinline__ void xcd_barrier_complete(unsigned* bar, unsigned x, unsigned& nloc, unsigned& nx) {
    const unsigned G = gridDim.x * gridDim.y * gridDim.z;
    unsigned sum, cnt, mine, sp = 0u;
    for (;;) {
        sum = 0u; cnt = 0u; mine = 0u;
#pragma unroll
        for (unsigned j = 0; j < 16; ++j) { const unsigned c = xb_ld(&bar[XB_XCNT(j)]); sum += c; cnt += (c > 0u) ? 1u : 0u; mine = (j == x) ? c : mine; }
        if (sum == G) break;
        __builtin_amdgcn_s_sleep(1);
        if ((++sp & 255u) == 0u) { if (xb_ld(&bar[XB_TMO])) break; if (sp > XB_SPIN_CAP) { atomicAdd(&bar[XB_TMO], 1u); break; } }
    }
    nloc = mine > 0u ? mine : 1u; nx = cnt > 0u ? cnt : 1u;
}

__device__ __forceinline__ void xcd_barrier(const XcdBarrier& b) {
    asm volatile("s_waitcnt vmcnt(0)" ::: "memory");
    __syncthreads();
    if (threadIdx.x == 0) {
        unsigned* bar = b.bar;
        __builtin_amdgcn_s_waitcnt(0);
        unsigned nloc = b.st[0], nx = b.st[1];
        if (nloc == 0u) { xcd_barrier_complete(bar, b.x, nloc, nx); b.st[0] = nloc; b.st[1] = nx; }
        const unsigned old = xb_add(&bar[XB_XSUB(b.x)], 1u);
        const unsigned gen = old / nloc;
        if (old + 1u == (gen + 1u) * nloc) {
            __builtin_amdgcn_fence(__ATOMIC_RELEASE, "agent");
            asm volatile("s_waitcnt vmcnt(0)" ::: "memory");
            const unsigned og = xb_add(&bar[XB_TOP], 1u);
            const unsigned tg = og / nx;
            if (og + 1u == (tg + 1u) * nx) xb_add(&bar[XB_TOPGEN], 1u);
            else XB_SPIN(xb_ld(&bar[XB_TOPGEN]) == tg, bar);
            __builtin_amdgcn_fence(__ATOMIC_ACQUIRE, "agent");
            xb_add(&bar[XB_XGEN(b.x)], 1u);
            asm volatile("s_waitcnt vmcnt(0)" ::: "memory");
        } else {
            XB_SPIN(xb_ld(&bar[XB_XGEN(b.x)]) == gen, bar);
            __builtin_amdgcn_fence(__ATOMIC_ACQUIRE, "agent");
            asm volatile("s_waitcnt vmcnt(0)" ::: "memory");
        }
    }
    __syncthreads();
}


#ifndef EPIRES_ALIGN
#define EPIRES_ALIGN true
#endif
#ifndef FUSE_FINAL
#define FUSE_FINAL 0
#endif
#ifndef PROBE_SKIP
#define PROBE_SKIP 0
#endif
#ifndef PROBE_DUP
#define PROBE_DUP 0
#endif
#define REP(k) _Pragma("unroll 1") for (int rep_ = 0; rep_ < ((PROBE_DUP == (k)) ? 2 : 1); ++rep_)
#ifndef PH_MASK
#define PH_MASK 0xffff
#endif
#define PHM(b) ((PH_MASK >> (b)) & 1)
struct Frame {
    LAS unsigned char* lds;
    volatile LAS unsigned* MISC;
    gu32* ctl;
    int tid, lane, wave;
    int vcu, G;
    unsigned char* ws;
};
__device__ __forceinline__ const void* ld_arg(int i) {
    const void* ka = (const void*)__builtin_amdgcn_kernarg_segment_ptr(); unsigned long long p;
    asm volatile("s_load_dwordx2 %0, %1, %2\n\ts_waitcnt lgkmcnt(0)" : "=s"(p) : "s"(ka), "s"(i * 8) : "memory");
    return (const void*)p;
}
#define PHASE_FRAME Frame F = F0; { size_t z_ = 0; asm volatile("" : "+s"(z_)); F.ws = F0.ws + z_;     \
    int t_ = threadIdx.x; asm volatile("" : "+v"(t_)); F.tid = t_; F.lane = t_ & 63; F.wave = __builtin_amdgcn_readfirstlane(t_ >> 6); }
#define ARGP(T, i) ((T*)(F.ws + ((size_t)ld_arg(i) - (size_t)F.ws)))
#define INF(i) ARGP(const float, i)
#define WSF(off) ((float*)(F.ws + (off)))
#define WSB(off) ((bf16*)(F.ws + (off)))
__device__ __forceinline__ float wave_sum(float v) {
#pragma unroll
    for (int o = 1; o < 64; o <<= 1) v += __shfl_xor(v, o);
    return v;
}
__device__ __forceinline__ float bflo(unsigned w) { return __uint_as_float(w << 16); }
__device__ __forceinline__ float bfhi(unsigned w) { return __uint_as_float(w & 0xffff0000u); }
typedef unsigned u32x2 __attribute__((ext_vector_type(2)));

typedef float f32x16_sg __attribute__((ext_vector_type(16)));
constexpr int SG_AP = 1028;
template <bool SILU>
__device__ __forceinline__ void small_gemm_unit(Frame& F, const float* A, int lda, const float* W, int ldw, int N, int n0, const float* bias, float* out, int ldo) {
    LAS float* As = (LAS float*)(F.lds + RING_OFF);
    int tl_ = F.tid; asm volatile("" : "+v"(tl_)); const int tidl = tl_, lanel = tl_ & 63, r = tl_ & 31, hi = (tl_ >> 5) & 1;
    for (int i = tidl; i < 8192; i += NWAVES * 64) { const int b = i >> 8, k4 = (i & 255) * 4;
        f32x4 v = *(const f32x4*)(A + (size_t)b * lda + k4);
        if (SILU) {
#pragma unroll
            for (int e = 0; e < 4; ++e) v[e] = v[e] / (1.0f + expf(-v[e])); }
        *(LAS f32x4*)(As + b * SG_AP + k4) = v; }
    __syncthreads();
    const int c0 = n0 + r, c1 = n0 + 32 + r;
    const unsigned wstride = (unsigned)ldw * 4u;
    unsigned woff0 = ((unsigned)(F.wave * 128 + 4 * hi) * (unsigned)ldw + (unsigned)(c0 < N ? c0 : n0)) * 4u;
    const unsigned wd1 = (unsigned)((c1 < N ? c1 : n0) - (c0 < N ? c0 : n0)) * 4u;
    f32x16_sg acc0 = {}, acc1 = {};
    float ba[32], bb[32];
#define SG_LD(bx) do { _Pragma("unroll") for (int s_ = 0; s_ < 4; ++s_) { _Pragma("unroll") for (int i_ = 0; i_ < 4; ++i_) { const unsigned o_ = woff0 + (unsigned)i_ * wstride; \
        bx[s_ * 8 + i_] = __builtin_nontemporal_load((const float*)((const char*)W + o_)); bx[s_ * 8 + 4 + i_] = __builtin_nontemporal_load((const float*)((const char*)W + (unsigned)(o_ + wd1))); } woff0 += 8u * wstride; } } while (0)
    SG_LD(ba);
#pragma unroll 1
    for (int g = 0; g < 4; ++g) {
        if (g < 3) SG_LD(bb);
        const LAS float* ap = As + r * SG_AP + F.wave * 128 + g * 32 + 4 * hi;
#pragma unroll
        for (int s_ = 0; s_ < 4; ++s_) { const f32x4 a4 = *(const LAS f32x4*)(ap + s_ * 8);
#pragma unroll
            for (int i_ = 0; i_ < 4; ++i_) { acc0 = __builtin_amdgcn_mfma_f32_32x32x2f32(a4[i_], ba[s_ * 8 + i_], acc0, 0, 0, 0); acc1 = __builtin_amdgcn_mfma_f32_32x32x2f32(a4[i_], ba[s_ * 8 + 4 + i_], acc1, 0, 0, 0); } }
#pragma unroll
        for (int j = 0; j < 32; ++j) ba[j] = bb[j];
    }
#undef SG_LD
    __syncthreads();
    LAS float* red = As;
#pragma unroll
    for (int i = 0; i < 16; ++i) { const int b = (i & 3) + 8 * (i >> 2) + 4 * hi; red[(F.wave * 32 + b) * 64 + r] = acc0[i]; red[(F.wave * 32 + b) * 64 + 32 + r] = acc1[i]; }
    __syncthreads();
#pragma unroll
    for (int j = 0; j < 4; ++j) { const int o = tidl + 512 * j, b = o >> 6, cc = o & 63; float s = 0.f;
#pragma unroll
        for (int w = 0; w < 8; ++w) s += red[(w * 32 + b) * 64 + cc];
        const int n = n0 + cc; if (n < N) out[(size_t)b * ldo + n] = s + (bias ? bias[n] : 0.f); }
    __syncthreads();
}
__device__ __forceinline__ void p0_transpose_item(const float* W, int ldw, int K, int ncols, bf16* WT, LAS float* scr, int item, int lane) {
    const int nblk = ncols / 32, kb = item / nblk, nb = item % nblk, k0 = 64 * kb, n0 = 32 * nb;
    float tv[32];
#pragma unroll
    for (int i = 0; i < 32; ++i) tv[i] = __builtin_nontemporal_load(W + (size_t)(k0 + 2 * i + (lane >> 5)) * ldw + n0 + (lane & 31));
#pragma unroll
    for (int i = 0; i < 32; ++i) scr[(2 * i + (lane >> 5)) * 33 + (lane & 31)] = tv[i];
    LDS_WAIT(); asm volatile("" ::: "memory");
    const int c = lane & 7;
#pragma unroll
    for (int j = 0; j < 4; ++j) { const int n = (lane >> 3) + 8 * j; const LAS float* s = scr + (8 * c) * 33 + n;
        v4u o; o.x = pk2(s[0 * 33], s[1 * 33]); o.y = pk2(s[2 * 33], s[3 * 33]); o.z = pk2(s[4 * 33], s[5 * 33]); o.w = pk2(s[6 * 33], s[7 * 33]);
        *(GAS v4u*)(WT + (size_t)(n0 + n) * K + k0 + 8 * c) = o; }
    LDS_WAIT(); asm volatile("" ::: "memory");
}
__device__ __forceinline__ void sincos_d(double a, double& s, double& c) {
    const double k = rint(a * 0.63661977236758134308);
    const double r = fma(-k, 6.123233995736766e-17, fma(-k, 1.5707963267948966, a));
    const int q = ((int)k) & 3;
    const double r2 = r * r;
    double sp = 1.0 / 6227020800.0; sp = sp * r2 - 1.0 / 39916800.0; sp = sp * r2 + 1.0 / 362880.0; sp = sp * r2 - 1.0 / 5040.0; sp = sp * r2 + 1.0 / 120.0; sp = sp * r2 - 1.0 / 6.0; sp = sp * r2 + 1.0;
    const double sr = r * sp;
    double cp = -1.0 / 87178291200.0; cp = cp * r2 + 1.0 / 479001600.0; cp = cp * r2 - 1.0 / 3628800.0; cp = cp * r2 + 1.0 / 40320.0; cp = cp * r2 - 1.0 / 720.0; cp = cp * r2 + 1.0 / 24.0; cp = cp * r2 - 0.5; cp = cp * r2 + 1.0;
    const double cr = cp;
    s = (q == 0) ? sr : (q == 1) ? cr : (q == 2) ? -sr : -cr;
    c = (q == 0) ? cr : (q == 1) ? -sr : (q == 2) ? -cr : sr;
}
__device__ __forceinline__ int tr_early(int k) { return k < 2048 ? k : k < 4096 ? 8192 + (k - 2048) : k < 5632 ? 16384 + (k - 4096) : 19456 + (k - 5632); }
__device__ __forceinline__ int tr_late(int k) { return k < 6144 ? 2048 + k : k < 12288 ? 10240 + (k - 6144) : k < 13824 ? 17920 + (k - 12288) : k < 14336 ? 19968 + (k - 13824) : 20480 + (k - 14336); }
__device__ __forceinline__ void transpose_range(Frame& F, int first, int stride, bool late) {
    const float* in_w_up = INF(7); const float* in_w_down = INF(8); const float* in_w_in = INF(9); const float* in_w_mo = INF(12); const float* in_kv_w = INF(16); const float* in_w_q = INF(17); const float* in_w_do = INF(20);
    LAS float* scr = (LAS float*)(F.lds + RING_OFF + F.wave * 16384);
    const int n = late ? 17408 : 6144;
    for (int k = first; k < n; k += stride) {
        const float* W; bf16* WT; int ldw, K, nc, r = late ? tr_late(k) : tr_early(k);
        if (r < 8192) { const int l = r >> 11; r &= 2047; W = in_w_up + (size_t)l * D * FF; WT = WSB(WS_WUP) + (size_t)l * D * FF; ldw = FF; K = D; nc = FF; }
        else if (r < 16384) { r -= 8192; const int l = r >> 11; r &= 2047; W = in_w_down + (size_t)l * D * FF; WT = WSB(WS_WDN) + (size_t)l * D * FF; ldw = D; K = FF; nc = D; }
        else if (r < 19456) { r -= 16384; const int l = r / 1536; r -= l * 1536; W = in_w_in + (size_t)l * D * A_IN; WT = WSB(WS_WIN) + (size_t)l * D * A_INP; ldw = A_IN; K = D; nc = A_INP; }
        else if (r < 20480) { r -= 19456; const int l = r >> 9; r &= 511; W = in_w_mo + (size_t)l * D * D; WT = WSB(WS_WMO) + (size_t)l * D * D; ldw = D; K = D; nc = D; }
        else if (r < 21504) { r -= 20480; W = in_kv_w; WT = WSB(WS_WKV); ldw = 2048; K = D; nc = 2048; }
        else if (r < 22528) { r -= 21504; const int l = r >> 9; r &= 511; W = in_w_q + (size_t)l * D * D; WT = WSB(WS_WQ) + (size_t)l * D * D; ldw = D; K = D; nc = D; }
        else { r -= 22528; const int l = r >> 9; r &= 511; W = in_w_do + (size_t)l * D * D; WT = WSB(WS_WDO) + (size_t)l * D * D; ldw = D; K = D; nc = D; }
        p0_transpose_item(W, ldw, K, nc, WT, scr, r, F.lane);
    }
}
__device__ __forceinline__ void bias_range(Frame& F, int first, int stride, bool late) {
    const float* in_w_in = INF(9); const float* in_w_up = INF(7); const float* in_kv_w = INF(16); const float* in_w_q = INF(17);
    const int n = late ? 305 : 113;
    for (int k = first; k < n; k += stride) {
        const int u = late ? (k < 49 ? 49 + k : 162 + (k - 49)) : (k < 49 ? k : 98 + (k - 49));
        const float *A, *W; float* out; int lda, ld, n0;
        if (u < 98) { const int l = u / 49, ch = u % 49; A = WSF(WS_MODS) + (size_t)l * 32 * 6144; lda = 6144; W = in_w_in + (size_t)l * D * A_IN; ld = A_IN; out = WSF(WS_B_IN) + (size_t)l * 32 * A_IN; n0 = ch * 64; }
        else if (u < 354) { const int l = (u - 98) >> 6, ch = (u - 98) & 63; A = WSF(WS_MODS) + (size_t)l * 32 * 6144 + 3072; lda = 6144; W = in_w_up + (size_t)l * D * FF; ld = FF; out = WSF(WS_B_UP) + (size_t)l * 32 * FF; n0 = ch * 64; }
        else if (u < 386) { A = WSF(WS_KVMOD); lda = 2048; W = in_kv_w; ld = 2048; out = WSF(WS_B_KV); n0 = (u - 354) * 64; }
        else { const int j = (u - 386) >> 4, ch = (u - 386) & 15; A = WSF(WS_MODS) + (size_t)(2 + j) * 32 * 6144; lda = 6144; W = in_w_q + (size_t)j * D * D; ld = D; out = WSF(WS_B_Q) + (size_t)j * 32 * D; n0 = ch * 64; }
        small_gemm_unit<false>(F, A, lda, W, ld, ld, n0, nullptr, out, ld);
    }
}
__device__ __forceinline__ void deferred_prologue(const Frame& F0) {
    PHASE_FRAME;
    const int v = (int)blockIdx.x - 128, NV = F.G - 128;
    bias_range(F, v, NV, true);
    transpose_range(F, v * NWAVES + F.wave, NV * NWAVES, true);
    const int* in_pos = ARGP(const int, 2); const float* in_lam_p = INF(18);
    const int gt = v * (NWAVES * 64) + F.tid, NGT = NV * NWAVES * 64;
    for (int i = gt; i < M * 8; i += NGT) { const int m = i >> 3, j = i & 7;
        const float inv = (j == 0) ? 1.0f : (j == 1) ? 0.1939227432012558f : (j == 2) ? 0.03760603070259094f : (j == 3) ? 0.007292664609849453f : (j == 4) ? 0.0014142135623842478f
                        : (j == 5) ? 0.00027424818836152554f : (j == 6) ? 5.318296098266728e-05f : 1.0313386155758053e-05f;
        const float ang = (float)in_pos[m] * inv; double s, c; sincos_d((double)ang, s, c);
        WSF(WS_ROPE)[(size_t)m * 16 + j] = (float)c; WSF(WS_ROPE)[(size_t)m * 16 + 8 + j] = (float)s; }
    if (v == 0 && F.tid < 2) { const float* lp = in_lam_p + F.tid * 256; float s1 = 0.f, s2 = 0.f;
        for (int i = 0; i < 64; ++i) { s1 += lp[i] * lp[64 + i]; s2 += lp[128 + i] * lp[192 + i]; }
        WSF(WS_LAM)[F.tid] = expf(s1) - expf(s2) + (F.tid == 0 ? 0.4707130183435842f : 0.5560582041556406f); }
}
__device__ __forceinline__ void p0a(const Frame& F0) {
    PHASE_FRAME;
    const float* in_c = INF(1); const float* in_ada_w = INF(3); const float* in_ada_b = INF(4); const float* in_kv_ada_w = INF(14); const float* in_kv_ada_b = INF(15); const float* in_w_up = INF(7); const float* in_w_down = INF(8); const float* in_w_in = INF(9); const float* in_w_mo = INF(12); const float* in_kv_w = INF(16); const float* in_w_q = INF(17); const float* in_w_do = INF(20); const int* in_pos = ARGP(const int, 2); const float* in_lam_p = INF(18);
    for (int u = F.vcu; u < 416; u += F.G) {
        const float *W, *bias; float* out; int ld, n0;
        if (u < 384) { const int l = u / 96, ch = u % 96; W = in_ada_w + (size_t)l * 1024 * 6144; bias = in_ada_b + l * 6144; out = WSF(WS_MODS) + (size_t)l * 32 * 6144; ld = 6144; n0 = ch * 64; }
        else { W = in_kv_ada_w; bias = in_kv_ada_b; out = WSF(WS_KVMOD); ld = 2048; n0 = (u - 384) * 64; }
        small_gemm_unit<true>(F, in_c, 1024, W, ld, ld, n0, bias, out, ld);
    }
    transpose_range(F, F.vcu * NWAVES + F.wave, F.G * NWAVES, false);
    const int gt = F.vcu * (NWAVES * 64) + F.tid, NGT = F.G * NWAVES * 64;
    for (int i = gt; i < 2 * 8 * 1024; i += NGT) { const int l = i >> 13, j = (i >> 10) & 7, k = i & 1023; WSF(WS_WG)[i] = in_w_in[(size_t)l * D * A_IN + (size_t)k * A_IN + A_INP + j]; }
}
__device__ __forceinline__ void p0b(const Frame& F0) {
    PHASE_FRAME;
    const float* in_w_in = INF(9); const float* in_w_up = INF(7); const float* in_kv_w = INF(16); const float* in_w_q = INF(17); const float* in_norm_mix_g = INF(5); const float* in_norm_mlp_g = INF(6); const float* in_kv_norm_g = INF(13); const float* in_x = INF(0); float* in_out = ARGP(float, 22);
    bias_range(F, F.vcu, F.G, false);
    const int gt = F.vcu * (NWAVES * 64) + F.tid, NGT = F.G * NWAVES * 64;
    for (int i = gt; i < 4 * 32 * 1024; i += NGT) { const int l = i >> 15, b = (i >> 10) & 31, k = i & 1023;
        WSF(WS_GM_MIX)[i] = in_norm_mix_g[l * 1024 + k] * (1.0f + WSF(WS_MODS)[(size_t)l * 32 * 6144 + (size_t)b * 6144 + 1024 + k]);
        WSF(WS_GM_MLP)[i] = in_norm_mlp_g[l * 1024 + k] * (1.0f + WSF(WS_MODS)[(size_t)l * 32 * 6144 + (size_t)b * 6144 + 4096 + k]); }
    for (int i = gt; i < 32 * 1024; i += NGT) { const int b = i >> 10, k = i & 1023; WSF(WS_GM_KV)[i] = in_kv_norm_g[k] * (1.0f + WSF(WS_KVMOD)[(size_t)b * 2048 + 1024 + k]); }
    const int gw = F.vcu * NWAVES + F.wave, NGW = F.G * NWAVES;
    for (int m0 = 4 * gw; m0 < M; m0 += 4 * NGW) {
        const int b = m0 >> 11; f32x4 v[4][4];
#pragma unroll
        for (int i = 0; i < 4; ++i)
#pragma unroll
            for (int j = 0; j < 4; ++j) v[i][j] = __builtin_nontemporal_load((const f32x4*)(in_x + (size_t)(m0 + i) * D + 4 * F.lane + 256 * j));
        f32x4 gmv[4];
#pragma unroll
        for (int j = 0; j < 4; ++j) { const int c = 4 * F.lane + 256 * j; const f32x4 g = *(const f32x4*)(in_norm_mix_g + c), sc = *(const f32x4*)(WSF(WS_MODS) + (size_t)b * 6144 + 1024 + c); gmv[j] = g * (sc + 1.0f); }
#pragma unroll
        for (int i = 0; i < 4; ++i) { const int m = m0 + i; bf16* orow = (bf16*)in_out + (size_t)m * D; bf16* gr = WSB(WS_XG) + (size_t)m * D; float ss = 0.f;
#pragma unroll
            for (int j = 0; j < 4; ++j) { const int c = 4 * F.lane + 256 * j; const f32x4 x = v[i][j];
                ss += (x[0] * x[0] + x[1] * x[1]) + (x[2] * x[2] + x[3] * x[3]);
                const f32x4 y = x * gmv[j]; u32x2 w; w.x = pk2(y[0], y[1]); w.y = pk2(y[2], y[3]); __builtin_nontemporal_store(w, (u32x2*)(gr + c)); }
            ss = wave_sum(ss);
            if (F.lane < 16) WSF(WS_SSQ)[(size_t)m * 16 + F.lane] = (F.lane == 0) ? ss : 0.f; }
    }
}
__device__ __forceinline__ void gates_phase(const Frame& F0, int l) {
    PHASE_FRAME;
    const float* in_b_gates = INF(10);
    const float* WGl = WSF(WS_WG) + l * 8192;
    const float* bg = in_b_gates + l * 8;
    const float* bin = WSF(WS_B_IN) + (size_t)l * 32 * A_IN;
    constexpr int GWP = 2064;
    LAS unsigned char* Wl = F.lds + RING_OFF;
    for (int i = F.tid; i < 2 * 9 * (GWP / 4); i += NWAVES * 64) ((LAS unsigned*)Wl)[i] = 0u;
    __syncthreads();
    for (int i = F.tid; i < 8 * 512; i += NWAVES * 64) { const int g = i >> 9, k2 = (i & 511) * 2;
        const float w0 = WGl[g * 1024 + k2], w1 = WGl[g * 1024 + k2 + 1];
        const unsigned h0 = f2bf(w0), h1 = f2bf(w1);
        const float r0 = w0 - __uint_as_float(h0 << 16), r1 = w1 - __uint_as_float(h1 << 16);
        *(LAS unsigned*)(Wl + g * GWP + k2 * 2) = h0 | (h1 << 16);
        *(LAS unsigned*)(Wl + (9 + g) * GWP + k2 * 2) = f2bf(r0) | (f2bf(r1) << 16); }
    __syncthreads();
    const int r = F.lane & 31, hi = F.lane >> 5;
    const int m = (F.vcu * NWAVES + F.wave) * 32 + r;
    const bf16* xrow = WSB(WS_XG) + (size_t)m * D + 8 * hi;
    const LAS unsigned char* wa = Wl + (r < 8 ? r : 8) * GWP + 16 * hi;
    typedef float f32x16_g __attribute__((ext_vector_type(16)));
    f32x16_g acc = {};
    bf16x8 xa[16], xb[16];
#define GT_LD(xs, s0) do { _Pragma("unroll") for (int s_ = 0; s_ < 16; ++s_) xs[s_] = *(const bf16x8*)(xrow + ((s0) + s_) * 16); } while (0)
#define GT_MM(xs, s0) do { _Pragma("unroll") for (int s_ = 0; s_ < 16; ++s_) { const bf16x8 ah = *(const LAS bf16x8*)(wa + ((s0) + s_) * 32), al = *(const LAS bf16x8*)(wa + 9 * GWP + ((s0) + s_) * 32); \
        acc = __builtin_amdgcn_mfma_f32_32x32x16_bf16(ah, xs[s_], acc, 0, 0, 0); acc = __builtin_amdgcn_mfma_f32_32x32x16_bf16(al, xs[s_], acc, 0, 0, 0); } } while (0)
    GT_LD(xa, 0); __builtin_amdgcn_sched_barrier(0);
    GT_LD(xb, 16); __builtin_amdgcn_sched_barrier(0); GT_MM(xa, 0); __builtin_amdgcn_sched_barrier(0);
    GT_LD(xa, 32); __builtin_amdgcn_sched_barrier(0); GT_MM(xb, 16); __builtin_amdgcn_sched_barrier(0);
    GT_LD(xb, 48); __builtin_amdgcn_sched_barrier(0); GT_MM(xa, 32); __builtin_amdgcn_sched_barrier(0);
    GT_MM(xb, 48);
#undef GT_LD
#undef GT_MM
    const f32x4 q0 = *(const f32x4*)(WSF(WS_SSQ) + (size_t)m * 16 + 8 * hi), q1 = *(const f32x4*)(WSF(WS_SSQ) + (size_t)m * 16 + 8 * hi + 4);
    float spt = ((q0[0] + q0[1]) + (q0[2] + q0[3])) + ((q1[0] + q1[1]) + (q1[2] + q1[3])); spt += __shfl_xor(spt, 32);
    const float rstd = rsqrtf(spt * (1.0f / 1024.0f) + 1e-6f);
    const f32x4 bv = *(const f32x4*)(bin + (size_t)(m >> 11) * A_IN + A_INP + 4 * hi), gv = *(const f32x4*)(bg + 4 * hi);
    f32x4 o;
#pragma unroll
    for (int i = 0; i < 4; ++i) { const float pre = rstd * acc[i] + bv[i] + gv[i];
        const float ls = fminf(pre, 0.f) - log1pf(expf(-fabsf(pre)));
        o[i] = hi ? ls : pre; }
    *(f32x4*)(WSF(WS_GATES) + (size_t)m * 8 + 4 * hi) = o;
    __syncthreads();
}
namespace ml {
typedef short bf16x8 __attribute__((ext_vector_type(8)));
typedef short s16x4 __attribute__((ext_vector_type(4)));
typedef float f32x16 __attribute__((ext_vector_type(16)));
typedef float f32x2_t __attribute__((ext_vector_type(2))); typedef __bf16 bf16x2_t __attribute__((ext_vector_type(2)));
constexpr int QP = 272, KWP = 320, VP = 576, PP = 144, HP = 528;
constexpr int L_QS = 0, L_KS = L_QS + 64 * QP, L_KW = L_KS + 64 * QP, L_VS = L_KW + 64 * KWP, L_P = L_VS + 64 * VP, L_HST = L_P + 64 * PP, L_TAB = L_HST + 64 * HP;
constexpr int T_US = L_TAB, T_MT = T_US + 256, T_WI = T_MT + 256, T_FL = T_WI + 256, T_D0 = T_FL + 256, T_D1 = T_D0 + 256, T_QN = T_D1 + 256, T_N = T_QN + 256, T_SSQ = T_N + 1024, L_END = T_SSQ + 2048;
__device__ __forceinline__ int crow(int r, int hi) { return (r & 3) + 8 * (r >> 2) + 4 * hi; }
__device__ __forceinline__ unsigned cvtpk(float lo, float hi) { f32x2_t v = {lo, hi}; bf16x2_t b = __builtin_convertvector(v, bf16x2_t); return __builtin_bit_cast(unsigned, b); }
__device__ __forceinline__ s16x4 vtr(const LAS unsigned char* p) { typedef short v4i16_t __attribute__((ext_vector_type(4))); return __builtin_bit_cast(s16x4, __builtin_amdgcn_ds_read_tr16_b64_v4i16((LAS v4i16_t*)p)); }
__device__ __forceinline__ bf16x8 cat(s16x4 lo, s16x4 hi) { return (bf16x8){lo[0], lo[1], lo[2], lo[3], hi[0], hi[1], hi[2], hi[3]}; }
#define ML_MFMA(a, b, c) __builtin_amdgcn_mfma_f32_32x32x16_bf16((a), (b), (c), 0, 0, 0)
}
__device__ __forceinline__ void mlstm_mfma_phase(const Frame& F0, int l, const int skip = 0) {
    using namespace ml;
    PHASE_FRAME;
    LAS unsigned char* L = F.lds;
    const int w = F.wave;
    LAS float* us = (LAS float*)(L + T_US); LAS float* Mt = (LAS float*)(L + T_MT); LAS float* wi = (LAS float*)(L + T_WI); LAS float* fl = (LAS float*)(L + T_FL);
    LAS float* d0 = (LAS float*)(L + T_D0); LAS float* d1 = (LAS float*)(L + T_D1); LAS float* qn = (LAS float*)(L + T_QN); LAS float* nb = (LAS float*)(L + T_N); LAS float* ssqp = (LAS float*)(L + T_SSQ);
    const bf16* QKVO = WSB(WS_QKVO); const float* GATES = WSF(WS_GATES); bf16* HN = WSB(WS_HN);
    for (int u = blockIdx.x; u < 128; u += F.G) {
        const int b = u >> 2, hd = u & 3; const size_t rowbase = (size_t)b * SEQ;
        int tid = F.tid; const int lane = tid & 63;
        for (int i = tid; i < 32 * 8; i += NWAVES * 64) { const int t = i >> 3, c8 = i & 7; *(LAS u32x2*)(L + L_P + t * PP + 64 + c8 * 8) = (u32x2){0u, 0u}; }
        if (tid < 256) nb[tid] = 0.f;
        f32x16 Cst[4];
#pragma unroll
        for (int kt = 0; kt < 4; ++kt)
#pragma unroll
            for (int i = 0; i < 16; ++i) Cst[kt][i] = 0.f;
        float mst = 0.f;
        v4u pq[2], pk[2], pv[4]; float pig, plf;
        v4u nq[2], nk[2], nv[4]; float nig, nlf;
        const char* ubase = (const char*)QKVO + (size_t)u * 2048 * 1536;
#define ML_VOQ ((unsigned)((tid >> 4) * 1536 + (tid & 15) * 16))
#define ML_VOV ((unsigned)((tid >> 5) * 1536 + (tid & 31) * 16))
#define ML_PREFETCH(c) do { const char* cb_ = ubase + (size_t)(c) * (64 * 1536); const unsigned voq = ML_VOQ, vov = ML_VOV; \
            _Pragma("unroll") for (int ii = 0; ii < 2; ++ii) { pq[ii] = __builtin_nontemporal_load((const v4u*)(cb_ + ii * (32 * 1536) + voq)); pk[ii] = __builtin_nontemporal_load((const v4u*)(cb_ + ii * (32 * 1536) + 256 + voq)); } \
            _Pragma("unroll") for (int ii = 0; ii < 4; ++ii) pv[ii] = __builtin_nontemporal_load((const v4u*)(cb_ + ii * (16 * 1536) + 512 + vov)); \
            const float* gp_ = GATES + (rowbase + (size_t)(c) * 64) * 8 + hd; pig = gp_[lane * 8]; plf = gp_[lane * 8 + 4]; } while (0)
#define ML_PREFETCH2(c) do { const char* cb_ = ubase + (size_t)(c) * (64 * 1536); const unsigned voq = ML_VOQ, vov = ML_VOV; \
            _Pragma("unroll") for (int ii = 0; ii < 2; ++ii) { nq[ii] = __builtin_nontemporal_load((const v4u*)(cb_ + ii * (32 * 1536) + voq)); nk[ii] = __builtin_nontemporal_load((const v4u*)(cb_ + ii * (32 * 1536) + 256 + voq)); } \
            _Pragma("unroll") for (int ii = 0; ii < 4; ++ii) nv[ii] = __builtin_nontemporal_load((const v4u*)(cb_ + ii * (16 * 1536) + 512 + vov)); \
            const float* gp_ = GATES + (rowbase + (size_t)(c) * 64) * 8 + hd; nig = gp_[lane * 8]; nlf = gp_[lane * 8 + 4]; } while (0)
        ML_PREFETCH(0); ML_PREFETCH2(1);
        v4u po[4];
#define ML_T3(CC) do { if (!(skip & 4)) { \
              _Pragma("unroll") for (int ii = 0; ii < 4; ++ii) { const int i = tid + 512 * ii, rr = i >> 5, ch = i & 31; float ss = 0.f; \
                _Pragma("unroll") for (int ww = 0; ww < 8; ++ww) ss += ssqp[ww * 64 + rr]; \
                const float rstd = rsqrtf(ss * (1.0f / 256.0f) + 1e-6f); \
                const v4u hv = *(const LAS v4u*)(L + L_HST + rr * HP + ch * 16); v4u o; \
                _Pragma("unroll") for (int e = 0; e < 4; ++e) o[e] = cvtpk(bflo(hv[e]) * rstd * bflo(po[ii][e]), bfhi(hv[e]) * rstd * bfhi(po[ii][e])); \
                *(v4u*)(HN + (rowbase + (size_t)(CC) * 64 + rr) * 1024 + hd * 256 + ch * 8) = o; } } } while (0)
        for (int c = 0; c < 32; ++c) {
            asm volatile("" : "+v"(tid));
            const int lane = tid & 63, r = lane & 31, h = lane >> 5, blk = (lane >> 4) & 1, q4 = (lane & 15) >> 2, p4 = lane & 3;
            const size_t row0 = rowbase + (size_t)c * 64;
#define ML_DPP(idv, x, ctrl, rmask) __builtin_bit_cast(float, __builtin_amdgcn_update_dpp(__builtin_bit_cast(int, (float)(idv)), __builtin_bit_cast(int, (float)(x)), ctrl, rmask, 0xf, false))
            float gb = plf;
            if (!(skip & 1)) { gb += ML_DPP(0.f, gb, 0x111, 0xf); gb += ML_DPP(0.f, gb, 0x112, 0xf); gb += ML_DPP(0.f, gb, 0x114, 0xf); gb += ML_DPP(0.f, gb, 0x118, 0xf);
                gb += ML_DPP(0.f, gb, 0x142, 0xa); gb += ML_DPP(0.f, gb, 0x143, 0xc); }
            const float uu = pig - gb; float pm = uu;
            if (!(skip & 1)) { const float NI = -__builtin_inff();
                pm = fmaxf(pm, ML_DPP(NI, pm, 0x111, 0xf)); pm = fmaxf(pm, ML_DPP(NI, pm, 0x112, 0xf)); pm = fmaxf(pm, ML_DPP(NI, pm, 0x114, 0xf)); pm = fmaxf(pm, ML_DPP(NI, pm, 0x118, 0xf));
                pm = fmaxf(pm, ML_DPP(NI, pm, 0x142, 0xa)); pm = fmaxf(pm, ML_DPP(NI, pm, 0x143, 0xc)); }
#undef ML_DPP
            const float Mt_l = fmaxf(mst, pm);
            const float G = __shfl(gb, 63), M63 = __shfl(Mt_l, 63);
            const float w_old = __expf(mst - M63), ws_l = __expf(uu - M63), wi_l = __expf(mst - Mt_l), fl_l = __expf(-(gb + Mt_l));
            const int nsel = (c & 1) * 128;
            if (w == 0) { us[lane] = uu; Mt[lane] = Mt_l; wi[lane] = wi_l; fl[lane] = fl_l; }
#pragma unroll
            for (int ii = 0; ii < 2; ++ii) { const int i = tid + 512 * ii, rr = i >> 4, ch = i & 15;
                *(LAS v4u*)(L + L_QS + rr * QP + ch * 16) = pq[ii]; *(LAS v4u*)(L + L_KS + rr * QP + ch * 16) = pk[ii];
                const float wsr = __shfl(ws_l, rr & 63); v4u kw;
#pragma unroll
                for (int e = 0; e < 4; ++e) kw[e] = cvtpk(bflo(pk[ii][e]) * wsr, bfhi(pk[ii][e]) * wsr);
                *(LAS v4u*)(L + L_KW + rr * KWP + ch * 16) = kw; }
#pragma unroll
            for (int ii = 0; ii < 4; ++ii) { const int i = tid + 512 * ii, rr = i >> 5, ch = i & 31; *(LAS v4u*)(L + L_VS + rr * VP + ch * 16) = pv[ii]; }
            mst = G + M63;
            if (!(skip & 32)) {
#pragma unroll
                for (int ii = 0; ii < 2; ++ii) { pq[ii] = nq[ii]; pk[ii] = nk[ii]; }
#pragma unroll
                for (int ii = 0; ii < 4; ++ii) pv[ii] = nv[ii];
                pig = nig; plf = nlf;
                if (c + 2 < 32) ML_PREFETCH2(c + 2); }
            asm volatile("" ::: "memory");
            if (c > 0) ML_T3(c - 1);
            asm volatile("s_waitcnt lgkmcnt(0)\n\ts_barrier" ::: "memory");
            { const char* ob = ubase + (size_t)c * (64 * 1536) + 1024;
#pragma unroll
              for (int ii = 0; ii < 4; ++ii) po[ii] = (skip & 32) ? (v4u){0u, 0u, 0u, 0u} : __builtin_nontemporal_load((const v4u*)(ob + ii * (16 * 1536) + ML_VOV)); }
            if (skip & 2) {} else if (w < 3) {
                const int st = (w == 2) ? 1 : 0, tt = (w >= 1) ? 1 : 0;
                f32x16 s;
#pragma unroll
                for (int i = 0; i < 16; ++i) s[i] = 0.f;
#pragma unroll
                for (int ks = 0; ks < 8; ++ks) { const bf16x8 a = *(const LAS bf16x8*)(L + L_KS + (32 * st + r) * QP + (16 * ks + 8 * h) * 2), bq = *(const LAS bf16x8*)(L + L_QS + (32 * tt + r) * QP + (16 * ks + 8 * h) * 2);
                    s = ML_MFMA(a, bq, s); }
                const float mt = Mt[32 * tt + r]; float rs = 0.f;
#pragma unroll
                for (int i = 0; i < 16; ++i) { const int sl = crow(i, h); const float wgt = __expf(us[32 * st + sl] - mt); const bool keep = (st != tt) || (sl <= r);
                    s[i] = keep ? s[i] * wgt : 0.f; rs += s[i]; }
                rs += __shfl_xor(rs, 32);
                if (h == 0) { if (st == 0) d0[32 * tt + r] = rs; else d1[32 * tt + r] = rs; }
#pragma unroll
                for (int g = 0; g < 4; ++g) { u32x2 pw; pw.x = cvtpk(s[4 * g], s[4 * g + 1]); pw.y = cvtpk(s[4 * g + 2], s[4 * g + 3]);
                    *(LAS u32x2*)(L + L_P + (32 * tt + r) * PP + (32 * st + 8 * g + 4 * h) * 2) = pw; }
            } else if (w == 3) {
                float a = 0.f; const LAS float* np = nb + nsel;
#pragma unroll
                for (int j = 0; j < 16; ++j) { const v4u qw = *(const LAS v4u*)(L + L_QS + lane * QP + j * 16); const f32x4 n0 = *(const LAS f32x4*)(np + 8 * j), n1 = *(const LAS f32x4*)(np + 8 * j + 4);
                    a += (bflo(qw[0]) * n0[0] + bfhi(qw[0]) * n0[1]) + (bflo(qw[1]) * n0[2] + bfhi(qw[1]) * n0[3]) + (bflo(qw[2]) * n1[0] + bfhi(qw[2]) * n1[1]) + (bflo(qw[3]) * n1[2] + bfhi(qw[3]) * n1[3]); }
                qn[lane] = a;
            } else if (w < 6) {
                const int dk = tid - 256; float a = w_old * nb[nsel + dk];
#pragma unroll 8
                for (int s = 0; s < 64; ++s) a += __uint_as_float((unsigned)(*(const LAS unsigned short*)(L + L_KW + s * KWP + dk * 2)) << 16);
                nb[(128 - nsel) + dk] = a;
            }
            f32x16 hq[2];
#pragma unroll
            for (int tt = 0; tt < 2; ++tt)
#pragma unroll
                for (int i = 0; i < 16; ++i) hq[tt][i] = 0.f;
            if (!(skip & 8))
#pragma unroll
            for (int kt = 0; kt < 4; ++kt)
#pragma unroll
                for (int ss = 0; ss < 2; ++ss) {
                    v4u cp;
#pragma unroll
                    for (int e = 0; e < 4; ++e) cp[e] = cvtpk(Cst[kt][8 * ss + 2 * e], Cst[kt][8 * ss + 2 * e + 1]);
                    const bf16x8 ca = __builtin_bit_cast(bf16x8, cp);
#pragma unroll
                    for (int tt = 0; tt < 2; ++tt) { const LAS unsigned char* qp = L + L_QS + (32 * tt + r) * QP + (32 * kt + 16 * ss + 4 * h) * 2;
                        const s16x4 lo = *(const LAS s16x4*)(qp), hi = *(const LAS s16x4*)(qp + 16);
                        hq[tt] = ML_MFMA(ca, cat(lo, hi), hq[tt]); }
                }
            __syncthreads();
#pragma unroll
            for (int tt = 0; tt < 2; ++tt) { const float wt = wi[32 * tt + r];
#pragma unroll
                for (int i = 0; i < 16; ++i) hq[tt][i] *= wt; }
#pragma unroll
            for (int kt = 0; kt < 4; ++kt)
#pragma unroll
                for (int i = 0; i < 16; ++i) Cst[kt][i] *= w_old;
            if (!(skip & 16))
#pragma unroll
            for (int ks = 0; ks < 4; ++ks) {
                const LAS unsigned char* vp = L + L_VS + (16 * ks + 8 * h + q4) * VP + (32 * w + 16 * blk + 4 * p4) * 2; const bf16x8 vf = cat(vtr(vp), vtr(vp + 4 * VP));
#pragma unroll
                for (int tt = 0; tt < 2; ++tt) { const bf16x8 pb = *(const LAS bf16x8*)(L + L_P + (32 * tt + r) * PP + (16 * ks + 8 * h) * 2); hq[tt] = ML_MFMA(vf, pb, hq[tt]); }
#pragma unroll
                for (int kt = 0; kt < 4; ++kt) { const LAS unsigned char* kp = L + L_KW + (16 * ks + 8 * h + q4) * KWP + (32 * kt + 16 * blk + 4 * p4) * 2; Cst[kt] = ML_MFMA(cat(vtr(kp), vtr(kp + 4 * KWP)), vf, Cst[kt]); }
            }
            if (!(skip & 64))
#pragma unroll
            for (int tt = 0; tt < 2; ++tt) { const int t = 32 * tt + r;
                const float den = d0[t] + (tt ? d1[t] : 0.f) + wi[t] * qn[t], inv = __builtin_amdgcn_rcpf(fmaxf(fabsf(den), fl[t])); float ss = 0.f;
#pragma unroll
                for (int i = 0; i < 16; ++i) { hq[tt][i] *= inv; ss += hq[tt][i] * hq[tt][i]; }
                ss += __shfl_xor(ss, 32);
                if (h == 0) ssqp[w * 64 + t] = ss;
#pragma unroll
                for (int g = 0; g < 4; ++g) { u32x2 hw; hw.x = cvtpk(hq[tt][4 * g], hq[tt][4 * g + 1]); hw.y = cvtpk(hq[tt][4 * g + 2], hq[tt][4 * g + 3]);
                    *(LAS u32x2*)(L + L_HST + t * HP + (32 * w + 8 * g + 4 * h) * 2) = hw; } }
            __syncthreads();
        }
        ML_T3(31);
        __syncthreads();
#undef ML_T3
#undef ML_PREFETCH
#undef ML_PREFETCH2
    }
}
static_assert(ml::L_END <= LDSCTL_OFF, "mLSTM LDS map");

__device__ __forceinline__ void combine_local(const Frame& F, int j, int b, int h) {
    const float* in_subln_g = INF(19);
    const float lam = WSF(WS_LAM)[j], post = 1.0f - (j == 0 ? 0.4707130183435842f : 0.5560582041556406f);
    const int cg = F.lane & 7; const float* sg = in_subln_g + j * 128 + 16 * cg;
    for (int s0 = 0; s0 < 32; s0 += 4) {
        v4u a0[4], a1[4], b0[4], b1[4];
#pragma unroll
        for (int i = 0; i < 4; ++i) { const size_t row = (size_t)b * SEQ + (s0 + i) * 64 + F.wave * 8 + (F.lane >> 3); const bf16* o1 = WSB(WS_O) + row * 2048 + h * 128 + 16 * cg; const bf16* o2 = o1 + 1024;
            a0[i] = *(const v4u*)(o1); a1[i] = *(const v4u*)(o1 + 8); b0[i] = *(const v4u*)(o2); b1[i] = *(const v4u*)(o2 + 8); }
#pragma unroll
        for (int i = 0; i < 4; ++i) { const size_t row = (size_t)b * SEQ + (s0 + i) * 64 + F.wave * 8 + (F.lane >> 3);
            float o[16]; float ss = 0.f;
#pragma unroll
            for (int e = 0; e < 4; ++e) { o[2 * e] = bflo(a0[i][e]) - lam * bflo(b0[i][e]); o[2 * e + 1] = bfhi(a0[i][e]) - lam * bfhi(b0[i][e]); o[8 + 2 * e] = bflo(a1[i][e]) - lam * bflo(b1[i][e]); o[8 + 2 * e + 1] = bfhi(a1[i][e]) - lam * bfhi(b1[i][e]); }
#pragma unroll
            for (int k = 0; k < 16; ++k) ss += o[k] * o[k];
            ss += __shfl_xor(ss, 1); ss += __shfl_xor(ss, 2); ss += __shfl_xor(ss, 4);
            const float rstd = rsqrtf(ss * (1.0f / 128.0f) + 1e-5f) * post;
            v4u r0, r1;
#pragma unroll
            for (int e = 0; e < 4; ++e) { r0[e] = pk2(o[2 * e] * rstd * sg[2 * e], o[2 * e + 1] * rstd * sg[2 * e + 1]); r1[e] = pk2(o[8 + 2 * e] * rstd * sg[8 + 2 * e], o[8 + 2 * e + 1] * rstd * sg[8 + 2 * e + 1]); }
            bf16* dst = WSB(WS_HN) + row * 1024 + h * 128 + 16 * cg; *(v4u*)(dst) = r0; *(v4u*)(dst + 8) = r1; }
    }
}
__device__ __forceinline__ void final_phase(const Frame& F0, float fill, const XcdBarrier& bar) {
    PHASE_FRAME;
    const float* in_final_g = INF(21); unsigned char* ob = ARGP(unsigned char, 22);
    const bf16* X16 = (const bf16*)ob; float* out = (float*)ob;
    const int gw = F.vcu * NWAVES + F.wave, NGW = F.G * NWAVES;
    f32x4 gv[4];
#pragma unroll
    for (int j = 0; j < 4; ++j) gv[j] = *(const f32x4*)(in_final_g + 4 * F.lane + 256 * j);
#define FIN_ROW(xw, spv, m) do { const float rstd_ = rsqrtf(wave_sum(spv) * (1.0f / 1024.0f) + 1e-6f); float* xr_ = out + (size_t)(m) * D; \
        _Pragma("unroll") for (int j = 0; j < 4; ++j) { const f32x4 x_ = {bflo((xw)[j].x), bfhi((xw)[j].x), bflo((xw)[j].y), bfhi((xw)[j].y)}; f32x4 y_ = x_ * rstd_ * gv[j]; \
            if (fill != 0.f) y_ = (f32x4){fill, fill, fill, fill}; __builtin_nontemporal_store(y_, (f32x4*)(xr_ + 4 * F.lane + 256 * j)); } } while (0)
    u32x2 lo[16][4]; float lsp[16];
#pragma unroll
    for (int i = 0; i < 16; ++i) { const int m = gw + i * NGW; lsp[i] = (F.lane < 16) ? WSF(WS_SSQ)[(size_t)m * 16 + F.lane] : 0.f;
#pragma unroll
        for (int j = 0; j < 4; ++j) lo[i][j] = *(const u32x2*)(X16 + (size_t)m * D + 4 * F.lane + 256 * j); }
    for (int m0 = M / 2 + 4 * gw; m0 < M; m0 += 4 * NGW) {
        u32x2 v[4][4]; float sp[4];
#pragma unroll
        for (int i = 0; i < 4; ++i) { sp[i] = (F.lane < 16) ? WSF(WS_SSQ)[(size_t)(m0 + i) * 16 + F.lane] : 0.f;
#pragma unroll
            for (int j = 0; j < 4; ++j) v[i][j] = *(const u32x2*)(X16 + (size_t)(m0 + i) * D + 4 * F.lane + 256 * j); }
#pragma unroll
        for (int i = 0; i < 4; ++i) FIN_ROW(v[i], sp[i], m0 + i);
    }
    xcd_barrier(bar);
#pragma unroll
    for (int i = 0; i < 16; ++i) FIN_ROW(lo[i], lsp[i], gw + i * NGW);
#undef FIN_ROW
}

#define IN(k) true
#define SEAM(k) do { xcd_barrier(bar); if (PROBE_DUP == 20) xcd_barrier(bar); } while (0)
template <int l> __device__ __forceinline__ void layer_phases(const Frame& F0, const XcdBarrier& bar, const int lo, const int hi, unsigned char* lds) {
        const int pb = 2 + 10 * l;
        if constexpr (l < 2) {
            REP(2) if (IN(pb + 0)) { PHASE_FRAME;
                if (PHM(2)) { gates_phase(F, l); if (PROBE_DUP == 21) gates_phase(F, l); }
                pg8::Gemm g{WSB(WS_XG), WSB(WS_WIN) + (size_t)l * D * A_INP, M, A_INP, D}; pg8::StaticOrder S; S.init(M, A_INP, F.G, (int)blockIdx.x);
                pg8::EpiLin<0> E{F.ws, WS_QKVO, A_INP, WS_B_IN + (size_t)l * 32 * A_IN * 4, A_IN, 0, 0, 1.0f, INF(11) + l * 1024};
                if (PHM(3)) pg8::gemm_phase<pg8::EpiLin<0>, pg8::StaticOrder, PG8_ALIGN, PG8_SP2>(F.lds + RING_OFF, g, S, E);
                SEAM(pb + 0);
            }
            REP(3) if (IN(pb + 1)) { PHASE_FRAME; if (l == 0 && blockIdx.x >= 128) deferred_prologue(F); else if (PHM(4)) mlstm_mfma_phase(F, l, (PROBE_DUP == 3 && rep_ == 0) ? PROBE_SKIP : 0); SEAM(pb + 1); }
        } else {
            const int j = l - 2;
            REP(4) if (IN(pb + 0)) { PHASE_FRAME;
                pg8::Gemm g{WSB(WS_XG), WSB(WS_WQ) + (size_t)j * D * D, M, D, D}; pg8::StaticOrder S; S.init(M, D, F.G, (int)blockIdx.x);
                pg8::EpiLin<2> E{F.ws, WS_Q, D, WS_B_Q + (size_t)j * 32 * D * 4, D, 0, 4, at2::C2, nullptr};
                if (PHM(5)) pg8::gemm_phase<pg8::EpiLin<2>, pg8::StaticOrder, PG8_ALIGN, PG8_SP2>(F.lds + RING_OFF, g, S, E);
                SEAM(pb + 0);
            }
            REP(5) if (IN(pb + 1)) { PHASE_FRAME;
                if (PHM(6)) {
                    const at2::bf16* Q0 = (const at2::bf16*)WSB(WS_Q); const at2::bf16* K0 = (const at2::bf16*)WSB(WS_KV); at2::bf16* O0 = (at2::bf16*)WSB(WS_HN);
                    const float lam = WSF(WS_LAM)[j], post = 1.0f - (j == 0 ? 0.4707130183435842f : 0.5560582041556406f); const float* sg = INF(19) + j * 128;
                    const int vq = F.vcu;
#define AT2_REF(R, g) do { const int bh_ = (((g) >> 2) * 256 + vq) >> 2, p_ = vq & 3, k_ = (g) & 3, comp_ = k_ & 1, qb_ = (k_ < 2) ? p_ : 7 - p_; \
                           const size_t rb_ = (size_t)(bh_ >> 3) * SEQ; const int hc_ = (bh_ & 7) * 128; \
                           R.Q = Q0 + (rb_ + (size_t)qb_ * 256) * 1024 + hc_ + comp_ * 64; R.K = K0 + rb_ * 2048 + hc_ + comp_ * 64; R.V = K0 + rb_ * 2048 + 1024 + hc_; \
                           R.O = O0 + (rb_ + (size_t)qb_ * 256) * 1024 + hc_; R.P0 = qb_ * 256; } while (0)
                    at2::Seam S; at2::BlockRef cur, nxt; AT2_REF(cur, 0);
                    at2::prime(cur, (char*)lds + RING_OFF, S);
#pragma unroll 1
                    for (int g = 0; g < 16; g += 2) {
                        AT2_REF(nxt, g + 1); at2::block<0>(cur, nxt, (char*)lds + RING_OFF, S, lam, post, sg); cur = nxt;
                        if (g + 2 < 16) AT2_REF(nxt, g + 2);
                        at2::block<1>(cur, nxt, (char*)lds + RING_OFF, S, lam, post, sg); cur = nxt; }
#undef AT2_REF
                }
                SEAM(pb + 1);
            }
        }
        REP(9) if (IN(pb + 3)) { PHASE_FRAME;
            const bf16* W = (l < 2) ? WSB(WS_WMO) + (size_t)l * D * D : WSB(WS_WDO) + (size_t)(l - 2) * D * D;
            pg8::Gemm g{WSB(WS_HN), W, M, D, D}; pg8::StaticOrder S; S.init(M, D, F.G, (int)blockIdx.x);
            bf16* x16 = ARGP(bf16, 22); pg8::EpiRes E{F.ws, x16, WS_MODS + ((size_t)l * 32 * 6144 + 2048) * 4, WS_GM_MLP + (size_t)l * 32 * 1024 * 4, 0, 0, WS_GM_MIX + (size_t)l * 32 * 1024 * 4};
            if (PHM(8)) pg8::gemm_phase<pg8::EpiRes, pg8::StaticOrder, EPIRES_ALIGN, PG8_SP2>(F.lds + RING_OFF, g, S, E);
            SEAM(pb + 3);
        }
        constexpr int NHM = 1, MHL = M / NHM;
        constexpr size_t HOFF = (l < 2) ? WS_H : WS_HA;
#pragma unroll 1
        for (int hm = 0; hm < NHM; ++hm) {
            REP(7) if (IN(pb + 4 + 2 * hm)) { PHASE_FRAME;
                pg8::Gemm g{WSB(WS_XG) + (size_t)hm * MHL * D, WSB(WS_WUP) + (size_t)l * D * FF, MHL, FF, D}; pg8::StaticOrder S; S.init(MHL, FF, F.G, (int)blockIdx.x);
                pg8::EpiLin<1> E{F.ws, HOFF, FF, WS_B_UP + (size_t)l * 32 * FF * 4, FF, hm * MHL, 0, 1.0f, nullptr};
                if (PHM(9)) pg8::gemm_phase<pg8::EpiLin<1>, pg8::StaticOrder, PG8_ALIGN, PG8_SP2>(F.lds + RING_OFF, g, S, E);
                SEAM(pb + 4 + 2 * hm);
            }
            REP(10) if (IN(pb + 5 + 2 * hm)) { PHASE_FRAME;
                pg8::Gemm g{WSB(HOFF), WSB(WS_WDN) + (size_t)l * D * FF, MHL, D, FF}; pg8::StaticOrder S; S.init(MHL, D, F.G, (int)blockIdx.x);
                bf16* x16 = ARGP(bf16, 22); pg8::EpiRes E{F.ws, x16, WS_MODS + ((size_t)l * 32 * 6144 + 5120) * 4, (l < 3) ? WS_GM_MIX + (size_t)(l + 1) * 32 * 1024 * 4 : 0, (l == 1) ? WS_GM_KV : 0, hm * MHL, WS_GM_MLP + (size_t)l * 32 * 1024 * 4};
                if constexpr (l == 3 && FUSE_FINAL) {
                    pg8::EpiFinal EF{F.ws, ARGP(float, 22), WS_MODS + ((size_t)l * 32 * 6144 + 5120) * 4, WS_GM_MLP + (size_t)l * 32 * 1024 * 4, INF(21), F.ctl + CW_FIN, F.ctl + CW_TMO};
                    if (PHM(10)) pg8::gemm_phase<pg8::EpiFinal, pg8::StaticOrder, true, PG8_SP2>(F.lds + RING_OFF, g, S, EF);
                } else
                if (PHM(10)) pg8::gemm_phase<pg8::EpiRes, pg8::StaticOrder, EPIRES_ALIGN, PG8_SP2>(F.lds + RING_OFF, g, S, E);
                SEAM(pb + 5 + 2 * hm);
            }
        }
        if constexpr (l == 1) REP(8) if (IN(pb + 8)) { PHASE_FRAME;
            pg8::Gemm g{WSB(WS_HN), WSB(WS_WKV), M, 2048, D}; pg8::StaticOrder S; S.init(M, 2048, F.G, (int)blockIdx.x);
            pg8::EpiLin<2> E{F.ws, WS_KV, 2048, WS_B_KV, 2048, 0, 4, 1.0f, nullptr};
            if (PHM(11)) pg8::gemm_phase<pg8::EpiLin<2>, pg8::StaticOrder, PG8_ALIGN, PG8_SP2>(F.lds + RING_OFF, g, S, E);
        }
}
#undef IN
#undef SEAM
struct Args { const void* in[22]; float* out; unsigned char* ws; int ph_lo, ph_hi; };
__global__ void __launch_bounds__(NWAVES * 64, 2) yoco_fwd(Args args) {
    extern __shared__ __attribute__((aligned(16))) unsigned char lds[];
    Frame F;
    F.lds = (LAS unsigned char*)lds;
    F.MISC = (volatile LAS unsigned*)(F.lds + MISC_OFF);
    F.tid = threadIdx.x; F.lane = F.tid & 63; F.wave = __builtin_amdgcn_readfirstlane(F.tid >> 6);
    F.G = gridDim.x; { const int bx = blockIdx.x; F.vcu = (F.G % 8 == 0) ? (bx % 8) * (F.G / 8) + bx / 8 : bx; }
    unsigned char* ws = args.ws;
    F.ctl = (gu32*)(ws + WS_CTL);
    F.ws = ws;
    for (int u = F.tid; u < (LDS_BYTES - LDSCTL_OFF) / 4; u += NWAVES * 64) ((LAS unsigned*)(F.lds + LDSCTL_OFF))[u] = 0u;
    __syncthreads();
    XcdBarrier bar = xcd_barrier_post((unsigned*)(F.ctl + CW_BAR), F.MISC + 8);
    const int lo = 0, hi = 43;
#define IN(k) true
#define SEAM(k) do { xcd_barrier(bar); if (PROBE_DUP == 20) xcd_barrier(bar); } while (0)

    REP(1) { REP(11) if (PHM(0) && IN(0)) { p0a(F); SEAM(0); }
    REP(12) if (PHM(1) && IN(1)) { p0b(F); SEAM(1); } }
    layer_phases<0>(F, bar, lo, hi, lds); layer_phases<1>(F, bar, lo, hi, lds); layer_phases<2>(F, bar, lo, hi, lds); layer_phases<3>(F, bar, lo, hi, lds);
    if (IN(42)) {
        float fill = __uint_as_float(__hip_atomic_load(F.ctl + CW_DIAG, RLX_AGENT));
        if (__hip_atomic_load(F.ctl + CW_TMO, RLX_AGENT) != 0u || __hip_atomic_load((gu32*)((unsigned*)(F.ctl + CW_BAR) + XB_TMO), RLX_AGENT) != 0u) fill = 5000.0f;
        if (PHM(12) && !FUSE_FINAL) final_phase(F, fill, bar);
    }
#undef IN
#undef SEAM
}

extern "C" void kernel_launch(void* const* d_in, const int* in_sizes, int n_in, void* d_out, int out_size, void* d_ws, size_t ws_size, hipStream_t stream) {
    static int grid = 0;
    if (grid == 0) {
        if (n_in != 22 || in_sizes[0] != M * D || out_size != M * D || ws_size < WS_END) { fprintf(stderr, "kernel_launch: unexpected problem (n_in %d, in0 %d, out %d, ws %zu); nothing launched\n", n_in, n_in > 0 ? in_sizes[0] : -1, out_size, ws_size); grid = -1; return; }
        int dev = 0, cus = 0, per_cu = 0;
        if (hipGetDevice(&dev) != hipSuccess || hipDeviceGetAttribute(&cus, hipDeviceAttributeMultiprocessorCount, dev) != hipSuccess) { grid = -1; return; }
        if (hipFuncSetAttribute((const void*)yoco_fwd, hipFuncAttributeMaxDynamicSharedMemorySize, LDS_BYTES) != hipSuccess) { fprintf(stderr, "kernel_launch: hipFuncSetAttribute failed\n"); grid = -1; return; }
        if (hipOccupancyMaxActiveBlocksPerMultiprocessor(&per_cu, (const void*)yoco_fwd, NWAVES * 64, LDS_BYTES) != hipSuccess || per_cu < 1)
            fprintf(stderr, "kernel_launch: note: occupancy query reports %d workgroups per CU\n", per_cu);
        (void)hipGetLastError();
        grid = cus;
        if (grid != 256) { fprintf(stderr, "kernel_launch: %d CUs; the attention and final phases are laid out for a grid of exactly 256 workgroups; nothing launched\n", cus); grid = -1; return; }
    }
    if (grid < 0) return;
    if (hipMemsetAsync((char*)d_ws + WS_CTL, 0, CTL_ZERO_BYTES, stream) != hipSuccess) return;
    Args a{};
    for (int i = 0; i < 22; ++i) a.in[i] = d_in[i];
    a.out = (float*)d_out; a.ws = (unsigned char*)d_ws;
    a.ph_lo = 0; a.ph_hi = 43;
    hipLaunchKernelGGL(yoco_fwd, dim3(grid), dim3(NWAVES * 64), LDS_BYTES, stream, a);
    const hipError_t le = hipPeekAtLastError();
    if (le != hipSuccess) fprintf(stderr, "kernel_launch: launch failed: %s\n", hipGetErrorName(le));
}
```
